# Optimizing an MI355X kernel written in HIP

```python
import jax, jax.numpy as jnp
from jax import lax
import numpy as np

D_MODEL = 1024
BATCH = 2
SEQ = 16384
DEPTH = 4

HEAD_DIM = 64
A_Q_HEADS = 4
A_KV_HEADS = 2
A_WINDOW = 128
B_HEADS = 6
B_BRANCHES = ((128, 1), (512, 4), (2048, 16))
C_WIDTH = 384
C_BLOCKS = 6
C_CONV = 4
C_EXP = 8.0
D_FF = 2816
BLOCK = 128
ROPE_THETA = 10000.0
EPS = 1e-6
SCALE = HEAD_DIM ** -0.5

A_WIDTH = A_Q_HEADS * HEAD_DIM
A_KV_WIDTH = A_KV_HEADS * HEAD_DIM
B_WIDTH = B_HEADS * HEAD_DIM
MIX_WIDTH = A_WIDTH + B_WIDTH + C_WIDTH
IN_SPLIT_SIZES = (A_WIDTH, A_KV_WIDTH, A_KV_WIDTH, B_WIDTH, B_WIDTH, B_WIDTH, C_WIDTH, C_WIDTH)
IN_COLS = A_WIDTH + 2 * A_KV_WIDTH + 3 * B_WIDTH + 2 * C_WIDTH

kernel_name = "hymba_style_swa_dilated_rglru_macaron"


def rms_norm(x, g):
    xf = x.astype(jnp.float32)
    y = xf * lax.rsqrt(jnp.mean(xf * xf, axis=-1, keepdims=True) + EPS)
    return (y * g.astype(jnp.float32)).astype(x.dtype)


def swiglu(x, w_gate, w_up, w_down):
    return (jax.nn.silu(x @ w_gate) * (x @ w_up)) @ w_down


def rope_tables(positions):
    inv = 1.0 / (ROPE_THETA ** (jnp.arange(0, HEAD_DIM, 2, dtype=jnp.float32) / HEAD_DIM))
    ang = positions.astype(jnp.float32)[..., None] * inv
    return jnp.cos(ang), jnp.sin(ang)


def apply_rope(x, cos, sin):
    x1, x2 = jnp.split(x.astype(jnp.float32), 2, axis=-1)
    c = cos[:, :, None, :]
    s = sin[:, :, None, :]
    return jnp.concatenate([x1 * c - x2 * s, x2 * c + x1 * s], axis=-1).astype(x.dtype)


def banded_attention(q, k, v, max_dist):
    n, g, L, hd = q.shape
    n_prev = -(-max_dist // BLOCK)
    nb = -(-L // BLOCK)
    Lp = nb * BLOCK
    qb = jnp.pad(q, ((0, 0), (0, 0), (0, Lp - L), (0, 0))).reshape(n, g, nb, BLOCK, hd)
    pad = ((0, 0), (n_prev * BLOCK, Lp - L), (0, 0))
    kp = jnp.pad(k, pad)
    vp = jnp.pad(v, pad)
    kb = jnp.concatenate([kp[:, j * BLOCK:j * BLOCK + Lp].reshape(n, nb, BLOCK, hd) for j in range(n_prev + 1)], axis=2)
    vb = jnp.concatenate([vp[:, j * BLOCK:j * BLOCK + Lp].reshape(n, nb, BLOCK, hd) for j in range(n_prev + 1)], axis=2)
    q_pos = jnp.arange(Lp).reshape(nb, BLOCK, 1)
    k_pos = (jnp.arange(nb)[:, None] * BLOCK + jnp.arange((n_prev + 1) * BLOCK)[None, :] - n_prev * BLOCK)[:, None, :]
    dist = q_pos - k_pos
    mask = (dist >= 0) & (dist <= max_dist) & (k_pos >= 0)
    s = jnp.einsum('ngbqd,nbkd->ngbqk', qb, kb).astype(jnp.float32) * SCALE
    s = jnp.where(mask, s, -jnp.inf)
    m = jnp.max(s, axis=-1, keepdims=True)
    p = jnp.exp(s - m)
    l = jnp.sum(p, axis=-1, keepdims=True)
    o = jnp.einsum('ngbqk,nbkd->ngbqd', p.astype(v.dtype), vb).astype(jnp.float32) / l
    lse = (m + jnp.log(l))[..., 0]
    o = o.reshape(n, g, Lp, hd)[:, :, :L].astype(v.dtype)
    lse = lse.reshape(n, g, Lp)[:, :, :L]
    return o, lse


def swa_sink_mixer(q, k, v, sinks):
    b, s = q.shape[:2]
    g = A_Q_HEADS // A_KV_HEADS
    qh = q.reshape(b, s, A_KV_HEADS, g, HEAD_DIM).transpose(0, 2, 3, 1, 4).reshape(b * A_KV_HEADS, g, s, HEAD_DIM)
    kh = k.transpose(0, 2, 1, 3).reshape(b * A_KV_HEADS, s, HEAD_DIM)
    vh = v.transpose(0, 2, 1, 3).reshape(b * A_KV_HEADS, s, HEAD_DIM)
    o, lse = banded_attention(qh, kh, vh, A_WINDOW - 1)
    sink = jnp.tile(sinks.astype(jnp.float32).reshape(A_KV_HEADS, g), (b, 1))[:, :, None]
    o = o * jax.nn.sigmoid(lse - sink)[..., None].astype(o.dtype)
    return o.reshape(b, A_KV_HEADS, g, s, HEAD_DIM).transpose(0, 3, 1, 2, 4).reshape(b, s, A_WIDTH)


def dilated_mixer(q, k, v):
    b, s, h, hd = q.shape
    outs, lses = [], []
    for window, d in B_BRANCHES:
        def gather(t):
            return t.reshape(b, s // d, d, h, hd).transpose(0, 3, 2, 1, 4).reshape(b * h * d, s // d, hd)
        o, lse = banded_attention(gather(q)[:, None], gather(k), gather(v), window // d)
        outs.append(o[:, 0].reshape(b, h, d, s // d, hd).transpose(0, 3, 2, 1, 4).reshape(b, s, h, hd))
        lses.append(lse[:, 0].reshape(b, h, d, s // d).transpose(0, 3, 2, 1).reshape(b, s, h))
    w = jax.nn.softmax(jnp.stack(lses, axis=-1), axis=-1)
    o = outs[0] * w[..., 0:1].astype(q.dtype)
    for i in range(1, len(B_BRANCHES)):
        o = o + outs[i] * w[..., i:i + 1].astype(q.dtype)
    return o.reshape(b, s, B_WIDTH)


def _lru_combine(left, right):
    a1, b1 = left
    a2, b2 = right
    return a1 * a2, a2 * b1 + b2


def rglru_mixer(xc, gate, conv_w, conv_b, w_r, b_r, w_i, b_i, lam, positions):
    b, s, c = xc.shape
    xp = jnp.pad(xc, ((0, 0), (C_CONV - 1, 0), (0, 0)))
    y = conv_b + conv_w[0] * xp[:, C_CONV - 1:C_CONV - 1 + s]
    for j in range(1, C_CONV):
        y = y + conv_w[j] * xp[:, C_CONV - 1 - j:C_CONV - 1 - j + s]
    yb = y.reshape(b, s, C_BLOCKS, c // C_BLOCKS)
    r = jax.nn.sigmoid(jnp.einsum('bshi,hij->bshj', yb, w_r) + b_r).reshape(b, s, c)
    ig = jax.nn.sigmoid(jnp.einsum('bshi,hij->bshj', yb, w_i) + b_i).reshape(b, s, c)
    log_a = -C_EXP * r.astype(jnp.float32) * jax.nn.softplus(-lam.astype(jnp.float32))
    reset = (positions == 0)[..., None]
    a = jnp.where(reset, 0.0, jnp.exp(log_a))
    mult = jnp.where(reset, 1.0, jnp.sqrt(-jnp.expm1(2.0 * log_a)))
    bx = mult * (ig * y).astype(jnp.float32)
    _, hs = lax.associative_scan(_lru_combine, (a, bx), axis=1)
    return (hs * jax.nn.gelu(gate.astype(jnp.float32))).astype(xc.dtype)


def _split_cols(proj):
    out, start = [], 0
    for size in IN_SPLIT_SIZES:
        out.append(proj[..., start:start + size])
        start += size
    return out


def setup_inputs(seed: int = 0) -> dict:
    key = jax.random.key(seed)
    ks = jax.random.split(key, 24)
    f32 = jnp.float32
    L = DEPTH
    nrm = lambda k, shape, scale: jax.random.normal(k, shape, f32) * scale
    a0 = jax.random.uniform(ks[14], (L, C_WIDTH), f32, minval=0.9, maxval=0.999)
    return {
        "x": jax.random.normal(ks[0], (BATCH, SEQ, D_MODEL), f32),
        "positions": jnp.broadcast_to(jnp.arange(SEQ, dtype=jnp.int32), (BATCH, SEQ)),
        "norm_ffn1": 1.0 + nrm(ks[1], (L, D_MODEL), 0.02),
        "ffn1_gate": nrm(ks[2], (L, D_MODEL, D_FF), D_MODEL ** -0.5),
        "ffn1_up": nrm(ks[3], (L, D_MODEL, D_FF), D_MODEL ** -0.5),
        "ffn1_down": nrm(ks[4], (L, D_FF, D_MODEL), D_FF ** -0.5),
        "norm_mix": 1.0 + nrm(ks[5], (L, D_MODEL), 0.02),
        "w_in": nrm(ks[6], (L, D_MODEL, IN_COLS), D_MODEL ** -0.5),
        "attn_sinks": nrm(ks[7], (L, A_Q_HEADS), 1.0),
        "conv_w": nrm(ks[8], (L, C_CONV, C_WIDTH), C_CONV ** -0.5),
        "conv_b": nrm(ks[9], (L, C_WIDTH), 0.01),
        "rg_w_r": nrm(ks[10], (L, C_BLOCKS, C_WIDTH // C_BLOCKS, C_WIDTH // C_BLOCKS), (C_WIDTH // C_BLOCKS) ** -0.5),
        "rg_b_r": nrm(ks[11], (L, C_BLOCKS, C_WIDTH // C_BLOCKS), 0.01),
        "rg_w_i": nrm(ks[12], (L, C_BLOCKS, C_WIDTH // C_BLOCKS, C_WIDTH // C_BLOCKS), (C_WIDTH // C_BLOCKS) ** -0.5),
        "rg_b_i": nrm(ks[13], (L, C_BLOCKS, C_WIDTH // C_BLOCKS), 0.01),
        "rg_lambda": jnp.log(a0) - jnp.log1p(-a0),
        "w_out": nrm(ks[15], (L, MIX_WIDTH, D_MODEL), MIX_WIDTH ** -0.5),
        "norm_ffn2": 1.0 + nrm(ks[16], (L, D_MODEL), 0.02),
        "ffn2_gate": nrm(ks[17], (L, D_MODEL, D_FF), D_MODEL ** -0.5),
        "ffn2_up": nrm(ks[18], (L, D_MODEL, D_FF), D_MODEL ** -0.5),
        "ffn2_down": nrm(ks[19], (L, D_FF, D_MODEL), D_FF ** -0.5),
        "norm_final": 1.0 + nrm(ks[20], (D_MODEL,), 0.02),
    }


def reference(x, positions, norm_ffn1, ffn1_gate, ffn1_up, ffn1_down, norm_mix, w_in, attn_sinks,
              conv_w, conv_b, rg_w_r, rg_b_r, rg_w_i, rg_b_i, rg_lambda, w_out,
              norm_ffn2, ffn2_gate, ffn2_up, ffn2_down, norm_final):
    b, s, _ = x.shape
    cos, sin = rope_tables(positions)
    for l in range(DEPTH):
        x = x + 0.5 * swiglu(rms_norm(x, norm_ffn1[l]), ffn1_gate[l], ffn1_up[l], ffn1_down[l])
        h = rms_norm(x, norm_mix[l])
        qa, ka, va, qb, kb, vb, xc, gc = _split_cols(h @ w_in[l])
        qa = apply_rope(qa.reshape(b, s, A_Q_HEADS, HEAD_DIM), cos, sin)
        ka = apply_rope(ka.reshape(b, s, A_KV_HEADS, HEAD_DIM), cos, sin)
        va = va.reshape(b, s, A_KV_HEADS, HEAD_DIM)
        out_a = swa_sink_mixer(qa, ka, va, attn_sinks[l])
        qb = apply_rope(qb.reshape(b, s, B_HEADS, HEAD_DIM), cos, sin)
        kb = apply_rope(kb.reshape(b, s, B_HEADS, HEAD_DIM), cos, sin)
        vb = vb.reshape(b, s, B_HEADS, HEAD_DIM)
        out_b = dilated_mixer(qb, kb, vb)
        out_c = rglru_mixer(xc, gc, conv_w[l], conv_b[l], rg_w_r[l], rg_b_r[l], rg_w_i[l], rg_b_i[l],
                            rg_lambda[l], positions)
        x = x + jnp.concatenate([out_a, out_b, out_c], axis=-1) @ w_out[l]
        x = x + 0.5 * swiglu(rms_norm(x, norm_ffn2[l]), ffn2_gate[l], ffn2_up[l], ffn2_down[l])
    return rms_norm(x, norm_final)
```

```cpp
#include <hip/hip_runtime.h>
#include <hip/hip_cooperative_groups.h>
#include <cstdio>
#include <cstdint>
#include <cmath>
namespace cg = cooperative_groups;
namespace pg8 {
#define PG8_LAS __attribute__((address_space(3)))
typedef unsigned short bf16_t;
typedef short bf16x8 __attribute__((ext_vector_type(8)));
typedef float f32x4 __attribute__((ext_vector_type(4)));
typedef unsigned u32x4 __attribute__((ext_vector_type(4)));
constexpr int BM = 256, BK = 64, HALF = 128, HTB = HALF * BK * 2  , STAGE_BYTES = 8 * HTB, NXCD = 8, WGM = 8;

__host__ __device__ __forceinline__ int lds_byte(int r, int c) { const int st = (r >> 4) * 2 + (c >> 5), rr = r & 15, cc = c & 31, ob = rr * 64 + cc * 2; return st * 1024 + (ob ^ (((ob >> 9) & 1) << 5)); }
__host__ __device__ __forceinline__ void stage_rc(int b, int& R, int& C) { const int st = b / 1024, sb = b % 1024, swz = sb ^ (((sb >> 9) & 1) << 5); R = (st >> 1) * 16 + swz / 64; C = (st & 1) * 32 + (swz % 64) / 2; }
__host__ __device__ __forceinline__ int perm32(int rho) { const int n = rho >> 4, i = rho & 15; return 8 * (i >> 2) + 4 * n + (i & 3); }

struct Unit { int pm, pn; };
struct Gemm { const bf16_t* A; const bf16_t* Bt; int M, N, K; };

struct StaticOrder {
    int nM, nN, nwg, G, c;
    __host__ __device__ void init(int M, int N, int G_, int c_) { nM = M / BM; nN = N / BM; nwg = nM * nN; G = G_; c = c_; }
    __host__ __device__ bool next(int i, Unit& u) const {
        const long L = (long)i * G + c; if (L >= nwg) return false;
        int wgid = (int)L; { const int q = nwg / NXCD, r = nwg % NXCD, xcd = wgid % NXCD, off = wgid / NXCD; wgid = (xcd < r ? xcd * (q + 1) : r * (q + 1) + (xcd - r) * q) + off; }
        const int nig = WGM * nN, gid = wgid / nig, fm = gid * WGM, gsz = (nM - fm) < WGM ? (nM - fm) : WGM;
        u.pm = fm + ((wgid % nig) % gsz); u.pn = (wgid % nig) / gsz; return true;
    }
    __device__ __forceinline__ void a_ready(const Unit&) const {}
    __device__ __forceinline__ void done(const Unit&) const {}
};
}

constexpr int DM = 1024, BATCH = 2, SEQ = 16384, MTOK = BATCH * SEQ, DEPTH = 4, FF = 2816, NGU = 2 * FF, NIN = 2560, INC = 2432;
constexpr int PC_QA = 0, PC_KA = 256, PC_VA = 384, PC_QB = 512, PC_KB = 896, PC_VB = 1280, PC_XC = 1792, PC_GC = 2176;
constexpr int PP = 2696;
constexpr float EPS = 1e-6f;
constexpr float QSCALE = 0.125f * 1.4426950408889634f;

#define LAS __attribute__((address_space(3)))
typedef unsigned short bf16_t;
typedef short bf16x8 __attribute__((ext_vector_type(8)));
typedef short s16x4 __attribute__((ext_vector_type(4)));
typedef float f32x4 __attribute__((ext_vector_type(4)));
typedef float f32x2 __attribute__((ext_vector_type(2)));
typedef float f32x16 __attribute__((ext_vector_type(16)));
typedef unsigned u32x4 __attribute__((ext_vector_type(4)));
typedef unsigned u32x2 __attribute__((ext_vector_type(2)));
typedef __bf16 nbf16x2 __attribute__((ext_vector_type(2)));

__device__ __forceinline__ unsigned pk2(float lo, float hi) { f32x2 v = {lo, hi}; nbf16x2 r = __builtin_convertvector(v, nbf16x2); return __builtin_bit_cast(unsigned, r); }
__device__ __forceinline__ float bf2f(unsigned short h) { return __builtin_bit_cast(float, (unsigned)h << 16); }
__device__ __forceinline__ float bflo(unsigned w) { return __builtin_bit_cast(float, w << 16); }
__device__ __forceinline__ float bfhi(unsigned w) { return __builtin_bit_cast(float, w & 0xffff0000u); }
__device__ __forceinline__ float fast_rcp(float x) { return __builtin_amdgcn_rcpf(x); }
__device__ __forceinline__ float fast_exp2(float x) { return __builtin_amdgcn_exp2f(x); }
__device__ __forceinline__ float sigmoidf_(float x) { return fast_rcp(1.0f + __expf(-x)); }

__device__ __forceinline__ float ssq_row(const float* part, int row) {
    const f32x4* p = (const f32x4*)(part + (size_t)row * 16);
    const f32x4 a = p[0], b = p[1], c = p[2], d = p[3];
    return (((a[0] + a[1]) + (a[2] + a[3])) + ((b[0] + b[1]) + (b[2] + b[3]))) + (((c[0] + c[1]) + (c[2] + c[3])) + ((d[0] + d[1]) + (d[2] + d[3])));
}

namespace pg8 {
__device__ __forceinline__ void rstd8(const float* ssq, int row0, int fq, float (&rstd)[8]) {
    f32x4 q[8];
#pragma unroll
    for (int i = 0; i < 8; ++i) q[i] = *(const f32x4*)(ssq + (size_t)(row0 + (i >> 2) * HALF + (i & 3) * 16) * 16 + 4 * fq);
#pragma unroll
    for (int i = 0; i < 8; ++i) { float s = (q[i][0] + q[i][1]) + (q[i][2] + q[i][3]); s += __shfl_xor(s, 16); s += __shfl_xor(s, 32); rstd[i] = rsqrtf(s * (1.0f / DM) + EPS); }
}
struct EpiGateUp {
    static constexpr bool PERM = true, AFTER_DRAIN = false;
    const float* ssq; bf16_t* act;
    __device__ __forceinline__ void operator()(const f32x4 (&acc)[2][2][4][2], const Unit& u, int wr, int wc, int fr, int fq) const {
        float rstd[8]; rstd8(ssq, u.pm * BM + wr * 64 + fr, fq, rstd);
#pragma unroll
        for (int ai = 0; ai < 2; ++ai)
#pragma unroll
            for (int m = 0; m < 4; ++m) {
                const int row = u.pm * BM + ai * HALF + wr * 64 + m * 16 + fr;
                const float rs = rstd[ai * 4 + m];
                float a[8];
#pragma unroll
                for (int n = 0; n < 2; ++n) {
                    const f32x4 g = acc[ai][0][m][n] * rs, up = acc[ai][1][m][n] * rs;
#pragma unroll
                    for (int e = 0; e < 4; ++e) a[4 * n + e] = g[e] * fast_rcp(1.0f + __expf(-g[e])) * up[e];
                }
                u32x4 w; w.x = pk2(a[0], a[1]); w.y = pk2(a[2], a[3]); w.z = pk2(a[4], a[5]); w.w = pk2(a[6], a[7]);
                *(u32x4*)(act + (size_t)row * FF + u.pn * 128 + wc * 32 + fq * 8) = w;
            }
    }
};
struct EpiResidual {
    static constexpr bool PERM = true, AFTER_DRAIN = false;
    bf16_t* xb; float* ssq_out; float scale;
    __device__ __forceinline__ void operator()(const f32x4 (&acc)[2][2][4][2], const Unit& u, int wr, int wc, int fr, int fq) const {
        bf16_t* p0 = xb + (size_t)(u.pm * BM + wr * 64 + fr) * DM + u.pn * BM + wc * 32 + fq * 8;
        u32x4 b[8][2];
#pragma unroll
        for (int i = 0; i < 2; ++i)
#pragma unroll
            for (int bj = 0; bj < 2; ++bj) b[i][bj] = *(const u32x4*)(p0 + (size_t)((i >> 2) * HALF + (i & 3) * 16) * DM + bj * HALF);
#pragma unroll
        for (int i = 0; i < 8; ++i) {
            if (i + 2 < 8) {
#pragma unroll
                for (int bj = 0; bj < 2; ++bj) b[i + 2][bj] = *(const u32x4*)(p0 + (size_t)(((i + 2) >> 2) * HALF + ((i + 2) & 3) * 16) * DM + bj * HALF);
            }
            const int ai = i >> 2, m = i & 3;
            const int row = u.pm * BM + ai * HALF + wr * 64 + m * 16 + fr;
            float sq = 0.f;
#pragma unroll
            for (int bj = 0; bj < 2; ++bj) {
                const u32x4 bb = b[i][bj];
                const f32x4 a0 = acc[ai][bj][m][0] * scale, a1 = acc[ai][bj][m][1] * scale;
                const float o0 = bflo(bb.x) + a0[0], o1 = bfhi(bb.x) + a0[1], o2 = bflo(bb.y) + a0[2], o3 = bfhi(bb.y) + a0[3];
                const float o4 = bflo(bb.z) + a1[0], o5 = bfhi(bb.z) + a1[1], o6 = bflo(bb.w) + a1[2], o7 = bfhi(bb.w) + a1[3];
                sq += ((o0 * o0 + o1 * o1) + (o2 * o2 + o3 * o3)) + ((o4 * o4 + o5 * o5) + (o6 * o6 + o7 * o7));
                u32x4 w; w.x = pk2(o0, o1); w.y = pk2(o2, o3); w.z = pk2(o4, o5); w.w = pk2(o6, o7);
                *(u32x4*)(p0 + (size_t)(ai * HALF + m * 16) * DM + bj * HALF) = w;
            }
            sq += __shfl_xor(sq, 16); sq += __shfl_xor(sq, 32);
            if (fq == 0) ssq_out[(size_t)row * 16 + u.pn * 4 + wc] = sq;
            asm volatile("" ::: "memory");
        }
    }
};
struct EpiProj {
    static constexpr bool PERM = true, AFTER_DRAIN = false;
    const float* ssq; const float* cosT; const float* sinT; bf16_t* P;
    __device__ __forceinline__ void operator()(const f32x4 (&acc)[2][2][4][2], const Unit& u, int wr, int wc, int fr, int fq) const {
        const int row0 = u.pm * BM + wr * 64 + fr;
        float rstd[8]; rstd8(ssq, row0, fq, rstd);
        const int d1 = 16 * (wc & 1) + 4 * fq;
        const bool rope0 = (u.pn * BM + wc * 32 < PC_VA) || (u.pn * BM + wc * 32 >= PC_QB && u.pn * BM + wc * 32 < PC_VB);
        f32x4 c4[8], s4[8];
#pragma unroll
        for (int i = 0; i < 2; ++i) { const size_t to = (size_t)(row0 + (i >> 2) * HALF + (i & 3) * 16) * 32 + d1; c4[i] = *(const f32x4*)(cosT + to); s4[i] = *(const f32x4*)(sinT + to); }
#pragma unroll
        for (int i = 0; i < 8; ++i) {
            if (i + 2 < 8) { const size_t to = (size_t)(row0 + ((i + 2) >> 2) * HALF + ((i + 2) & 3) * 16) * 32 + d1; c4[i + 2] = *(const f32x4*)(cosT + to); s4[i + 2] = *(const f32x4*)(sinT + to); }
            const int ai = i >> 2, m = i & 3;
            const int row = row0 + ai * HALF + m * 16;
            const float rs = rstd[i];
#pragma unroll
            for (int bj = 0; bj < 2; ++bj) {
                const int cb = u.pn * BM + bj * HALF + wc * 32;
                f32x4 v0 = acc[ai][bj][m][0] * rs, v1 = acc[ai][bj][m][1] * rs;
                const bool rope = (cb < PC_VA) || (cb >= PC_QB && cb < PC_VB);
                const bool isq = (cb < PC_KA) || (cb >= PC_QB && cb < PC_KB);
                if (rope) {
                    const f32x4 o0 = v0 * c4[i] - v1 * s4[i], o1 = v1 * c4[i] + v0 * s4[i];
                    const float qs = isq ? QSCALE : 1.0f;
                    v0 = o0 * qs; v1 = o1 * qs;
                }
                u32x4 w; w.x = pk2(v0[0], v0[1]); w.y = pk2(v0[2], v0[3]); w.z = pk2(v1[0], v1[1]); w.w = pk2(v1[2], v1[3]);
                *(u32x4*)(P + (size_t)row * PP + cb + fq * 8) = w;
            }
            asm volatile("" ::: "memory");
        }
        (void)rope0;
    }
};
}
namespace pg8 {
template <class Epi, class Sched, bool ALIGN_EPI = false, bool SP2 = false>
__device__ __forceinline__ void gemm_phase(PG8_LAS unsigned char* lds, const Gemm g, const Sched& S, const Epi& E, int tid_in) {
    int tid_ = tid_in; asm volatile("" : "+v"(tid_));
    const int tid = tid_, wid = __builtin_amdgcn_readfirstlane(tid >> 6), lane = tid & 63, wr = wid >> 2, wc = wid & 3, fr = lane & 15, fq = lane >> 4;
    const int K = g.K, nt = K / BK;
    unsigned voffA[2], voffB[2];
#pragma unroll
    for (int i = 0; i < 2; ++i) { int R, C; stage_rc(tid * 16 + i * 8192, R, C); const int Rb = Epi::PERM ? ((R & ~31) + perm32(R & 31)) : R;
        voffA[i] = (unsigned)(R * K + C) * 2u; voffB[i] = (unsigned)(Rb * K + C) * 2u; }
    const size_t kstep = (size_t)(BK * 2);
    const size_t hstep = (size_t)HALF * K * 2;
    const size_t tstep = 2 * hstep;
    const unsigned ldsw = (unsigned)wid * 1024u;
    const int aoff = lds_byte(wr * 64 + fr, fq * 8), boff = lds_byte(wc * 32 + fr, fq * 8);
#define PG8_SA(b, h) (((b) * 2 + (h)) * HTB)
#define PG8_SB(b, h) ((4 + (b) * 2 + (h)) * HTB)
#define PG8_STAGE(bufoff, gbase, voff) do { _Pragma("unroll") for (int _i = 0; _i < 2; ++_i) \
        __builtin_amdgcn_global_load_lds((const unsigned*)((const char*)(gbase) + (voff)[_i]), (PG8_LAS unsigned*)(lds + (bufoff) + ldsw + _i * 8192), 16, 0, 0); } while (0)
#define PG8_LDA(dst, b, h) do { _Pragma("unroll") for (int m = 0; m < 4; ++m) _Pragma("unroll") for (int k = 0; k < 2; ++k) dst[m][k] = *(const PG8_LAS bf16x8*)(lds + PG8_SA(b, h) + aoff + m * 2048 + k * 1024); } while (0)
#define PG8_LDB(dst, b, h) do { _Pragma("unroll") for (int n = 0; n < 2; ++n) _Pragma("unroll") for (int k = 0; k < 2; ++k) dst[n][k] = *(const PG8_LAS bf16x8*)(lds + PG8_SB(b, h) + boff + n * 2048 + k * 1024); } while (0)
#define PG8_MMA(ai, bj, At, Bt) do { __builtin_amdgcn_s_setprio(1); _Pragma("unroll") for (int m = 0; m < 4; ++m) _Pragma("unroll") for (int n = 0; n < 2; ++n) _Pragma("unroll") for (int k = 0; k < 2; ++k) \
        acc[ai][bj][m][n] = __builtin_amdgcn_mfma_f32_16x16x32_bf16(Bt[n][k], At[m][k], acc[ai][bj][m][n], 0, 0, 0); __builtin_amdgcn_s_setprio(0); } while (0)
#define PG8_WAIT_V(n) asm volatile("s_waitcnt vmcnt(" #n ")" ::: "memory")
#define PG8_WAIT_L(n) asm volatile("s_waitcnt lgkmcnt(" #n ")" ::: "memory")
#define PG8_BAR __builtin_amdgcn_s_barrier()
#define PG8_SCHED __builtin_amdgcn_sched_barrier(0)
    Unit cur, nxt; int ui = 0;
    if (!S.next(0, cur)) return;
    f32x4 acc[2][2][4][2];
#pragma unroll
    for (int a = 0; a < 2; ++a)
#pragma unroll
        for (int b = 0; b < 2; ++b)
#pragma unroll
            for (int m = 0; m < 4; ++m)
#pragma unroll
                for (int n = 0; n < 2; ++n) acc[a][b][m][n] = (f32x4){0.f, 0.f, 0.f, 0.f};
    bf16x8 At[4][2], B0[2][2], B1[2][2];
    const char* cA = (const char*)g.A + (size_t)cur.pm * tstep; const char* cB = (const char*)g.Bt + (size_t)cur.pn * tstep;
    S.a_ready(cur);
    if constexpr (SP2) {
        PG8_STAGE(PG8_SB(0, 0), cB, voffB); PG8_STAGE(PG8_SB(0, 1), cB + hstep, voffB); PG8_STAGE(PG8_SA(0, 0), cA, voffA); PG8_STAGE(PG8_SA(0, 1), cA + hstep, voffA);
        if (wr == 1) PG8_BAR;
        PG8_WAIT_V(2); PG8_BAR;
        PG8_STAGE(PG8_SB(1, 0), cB + kstep, voffB); PG8_STAGE(PG8_SA(1, 0), cA + kstep, voffA); PG8_STAGE(PG8_SB(1, 1), cB + hstep + kstep, voffB);
        PG8_WAIT_V(6); PG8_BAR;
    } else {
        PG8_STAGE(PG8_SB(0, 0), cB, voffB); PG8_STAGE(PG8_SA(0, 0), cA, voffA); PG8_STAGE(PG8_SB(0, 1), cB + hstep, voffB); PG8_STAGE(PG8_SA(0, 1), cA + hstep, voffA);
        if (wr == 1) PG8_BAR;
        PG8_WAIT_V(4); PG8_BAR;
        PG8_STAGE(PG8_SB(1, 0), cB + kstep, voffB); PG8_STAGE(PG8_SA(1, 0), cA + kstep, voffA); PG8_STAGE(PG8_SB(1, 1), cB + hstep + kstep, voffB);
        PG8_WAIT_V(6); PG8_BAR;
    }
    for (;;) {
        const bool has_next = S.next(ui + 1, nxt);
        const char* nA = has_next ? (const char*)g.A + (size_t)nxt.pm * tstep : cA; const char* nB = has_next ? (const char*)g.Bt + (size_t)nxt.pn * tstep : cB;
        for (int t = 0; t < nt; t += 2) {
            const bool last = (t == nt - 2);
            const char* a1 = cA + (size_t)(t + 1) * kstep;
            const char* a2 = last ? nA : cA + (size_t)(t + 2) * kstep; const char* b2 = last ? nB : cB + (size_t)(t + 2) * kstep;
            const char* a3 = a2 + kstep; const char* b3 = b2 + kstep;
            if (last && has_next) S.a_ready(nxt);
            if constexpr (SP2) {
            PG8_LDB(B0, 0, 0); PG8_LDB(B1, 0, 1); PG8_SCHED; PG8_LDA(At, 0, 0); PG8_STAGE(PG8_SA(1, 1), a1 + hstep, voffA);
            PG8_WAIT_V(8); PG8_WAIT_L(0); PG8_BAR; PG8_MMA(0, 0, At, B0); PG8_MMA(0, 1, At, B1); PG8_BAR; PG8_SCHED;
            PG8_LDA(At, 0, 1); PG8_STAGE(PG8_SB(0, 0), b2, voffB); PG8_STAGE(PG8_SB(0, 1), b2 + hstep, voffB); PG8_STAGE(PG8_SA(0, 0), a2, voffA);
            PG8_WAIT_V(8); PG8_WAIT_L(0); PG8_BAR; PG8_MMA(1, 0, At, B0); PG8_MMA(1, 1, At, B1); PG8_BAR; PG8_SCHED;
            PG8_LDB(B0, 1, 0); PG8_LDB(B1, 1, 1); PG8_SCHED; PG8_LDA(At, 1, 0); PG8_STAGE(PG8_SA(0, 1), a2 + hstep, voffA);
            PG8_WAIT_V(8); PG8_WAIT_L(0); PG8_BAR; PG8_MMA(0, 0, At, B0); PG8_MMA(0, 1, At, B1); PG8_BAR; PG8_SCHED;
            PG8_LDA(At, 1, 1); PG8_STAGE(PG8_SB(1, 0), b3, voffB); PG8_STAGE(PG8_SB(1, 1), b3 + hstep, voffB); PG8_STAGE(PG8_SA(1, 0), a3, voffA);
            PG8_WAIT_V(8); PG8_WAIT_L(0); PG8_BAR; PG8_MMA(1, 0, At, B0); PG8_MMA(1, 1, At, B1); PG8_BAR; PG8_SCHED;
            } else {
            PG8_LDB(B0, 0, 0); PG8_SCHED; PG8_LDA(At, 0, 0); PG8_STAGE(PG8_SA(1, 1), a1 + hstep, voffA);
            PG8_WAIT_L(8); PG8_BAR; PG8_WAIT_L(0); PG8_MMA(0, 0, At, B0); PG8_BAR; PG8_SCHED;
            PG8_LDB(B1, 0, 1); PG8_STAGE(PG8_SB(0, 0), b2, voffB);
            PG8_BAR; PG8_WAIT_L(0); PG8_MMA(0, 1, At, B1); PG8_BAR;
            PG8_LDA(At, 0, 1); PG8_STAGE(PG8_SA(0, 0), a2, voffA);
            PG8_BAR; PG8_WAIT_L(0); PG8_MMA(1, 0, At, B0); PG8_BAR; PG8_SCHED;
            PG8_STAGE(PG8_SB(0, 1), b2 + hstep, voffB);
            PG8_WAIT_V(6); PG8_BAR; PG8_MMA(1, 1, At, B1); PG8_BAR;
            PG8_LDB(B0, 1, 0); PG8_SCHED; PG8_LDA(At, 1, 0); PG8_STAGE(PG8_SA(0, 1), a2 + hstep, voffA);
            PG8_WAIT_L(8); PG8_BAR; PG8_WAIT_L(0); PG8_MMA(0, 0, At, B0); PG8_BAR; PG8_SCHED;
            PG8_LDB(B1, 1, 1); PG8_STAGE(PG8_SB(1, 0), b3, voffB);
            PG8_BAR; PG8_WAIT_L(0); PG8_MMA(0, 1, At, B1); PG8_BAR;
            PG8_LDA(At, 1, 1); PG8_STAGE(PG8_SA(1, 0), a3, voffA);
            PG8_BAR; PG8_WAIT_L(0); PG8_MMA(1, 0, At, B0); PG8_BAR; PG8_SCHED;
            PG8_STAGE(PG8_SB(1, 1), b3 + hstep, voffB);
            PG8_WAIT_V(6); PG8_BAR; PG8_MMA(1, 1, At, B1); PG8_BAR;
            }
        }
        if constexpr (ALIGN_EPI) { if (wr == 0) PG8_BAR; }
        if constexpr (!Epi::AFTER_DRAIN) { E(acc, cur, wr, wc, fr, fq); S.done(cur); }
        if (!has_next) break;
#pragma unroll
        for (int a = 0; a < 2; ++a)
#pragma unroll
            for (int b = 0; b < 2; ++b)
#pragma unroll
                for (int m = 0; m < 4; ++m)
#pragma unroll
                    for (int n = 0; n < 2; ++n) acc[a][b][m][n] = (f32x4){0.f, 0.f, 0.f, 0.f};
        cur = nxt; cA = nA; cB = nB; ++ui;
        if constexpr (ALIGN_EPI) { if (wr == 1) PG8_BAR; }
    }
    PG8_WAIT_V(0);
    if constexpr (!ALIGN_EPI) { if (wr == 0) PG8_BAR; }
    PG8_BAR;
    if constexpr (Epi::AFTER_DRAIN) { E.fused(acc, cur, wr, wc, fr, fq, lds, wid, lane); S.done(cur); }
#undef PG8_SA
#undef PG8_SB
#undef PG8_STAGE
#undef PG8_LDA
#undef PG8_LDB
#undef PG8_MMA
#undef PG8_WAIT_V
#undef PG8_WAIT_L
#undef PG8_BAR
#undef PG8_SCHED
}
}

constexpr size_t MiB = 1u << 20;
constexpr size_t WS_W = 0, W_LAYER = 40 * MiB;
constexpr size_t WO_GU1 = 0, WO_D1 = 11 * MiB, WO_IN = WO_D1 + 11 * MiB / 2, WO_OUT = WO_IN + 5 * MiB, WO_GU2 = WO_OUT + 2 * MiB, WO_D2 = WO_GU2 + 11 * MiB;
static_assert(WO_D2 + 11 * MiB / 2 == W_LAYER, "weight map");
constexpr size_t WS_XB = 160 * MiB;
constexpr size_t WS_ACT = 224 * MiB;
constexpr size_t WS_MIX = 400 * MiB;
constexpr size_t WS_ROPE = 464 * MiB;
constexpr size_t WS_SSQ = 476 * MiB;
constexpr size_t SSQ_SLOT = (size_t)MTOK * 16;
constexpr size_t WS_RGW = 474 * MiB;
constexpr size_t WS_AGG = 475 * MiB;
constexpr size_t WS_TS = 502 * MiB;
constexpr size_t WS_BAR = 504 * MiB;
constexpr size_t WS_END = 505 * MiB;
constexpr size_t PO_BYTES = (size_t)MTOK * 384 * 2;
constexpr size_t OB_PO4 = 0, OB_PO16 = PO_BYTES, OB_LSE4 = 2 * PO_BYTES, OB_LSE16 = OB_LSE4 + MiB;
static_assert(OB_LSE16 + MiB <= (size_t)MTOK * DM * 4, "partials fit the output buffer");

constexpr int LDS_BYTES = 147456;
constexpr int VROW = 144;

struct Args { const void* in[22]; float* out; unsigned char* ws; };
__device__ const float INV_TAB[32] = {1.000000000e+00f, 7.498942018e-01f, 5.623413324e-01f, 4.216965139e-01f, 3.162277639e-01f, 2.371373773e-01f, 1.778279394e-01f, 1.333521456e-01f, 1.000000015e-01f, 7.498942316e-02f, 5.623413250e-02f, 4.216964915e-02f, 3.162277490e-02f, 2.371373773e-02f, 1.778279431e-02f, 1.333521400e-02f, 9.999999776e-03f, 7.498942316e-03f, 5.623413250e-03f, 4.216964822e-03f, 3.162277630e-03f, 2.371373819e-03f, 1.778279431e-03f, 1.333521446e-03f, 1.000000047e-03f, 7.498941850e-04f, 5.623413017e-04f, 4.216965172e-04f, 3.162277571e-04f, 2.371373703e-04f, 1.778279402e-04f, 1.333521504e-04f};

#define MFMA32(a, b, c) __builtin_amdgcn_mfma_f32_32x32x16_bf16((a), (b), (c), 0, 0, 0)
__device__ __forceinline__ int crow(int reg, int h) { return (reg & 3) + 8 * (reg >> 2) + 4 * h; }

struct AttnOut { bf16_t* mix; bf16_t* po; float* lse; const bf16_t* po4; const bf16_t* po16; const float* lse4; const float* lse16; float sink; };

__device__ __forceinline__ void store_row16(bf16_t* rowp  , const u32x2 (&wv)[4], int kh) {
#pragma unroll
    for (int gp = 0; gp < 2; ++gp) {
        const u32x2 keep = kh ? wv[2 * gp + 1] : wv[2 * gp], send = kh ? wv[2 * gp] : wv[2 * gp + 1];
        u32x2 recv; recv.x = (unsigned)__shfl_xor((int)send.x, 32); recv.y = (unsigned)__shfl_xor((int)send.y, 32);
        u32x4 w; if (kh) { w.x = recv.x; w.y = recv.y; w.z = keep.x; w.w = keep.y; } else { w.x = keep.x; w.y = keep.y; w.z = recv.x; w.w = recv.y; }
        *(u32x4*)(rowp + 8 * (2 * gp + kh)) = w;
    }
}
template <int MODE>
__device__ __forceinline__ void attn_finish(const f32x16& O0, const f32x16& O1, float m2, float lsum, int tok, int ocol, int hidx, int kh, const AttnOut& AO) {
    const float l = lsum + __shfl_xor(lsum, 32);
    const float lse = (m2 + __log2f(l)) * 0.6931471805599453f;
    const float rl = fast_rcp(l);
    if (MODE == 0) {
        const float gate = fast_rcp(1.0f + __expf(AO.sink - lse)) * rl;
        bf16_t* op = AO.mix + (size_t)tok * DM + ocol;
        u32x2 w0[4], w1[4];
#pragma unroll
        for (int g = 0; g < 4; ++g) {
            w0[g].x = pk2(O0[4 * g] * gate, O0[4 * g + 1] * gate); w0[g].y = pk2(O0[4 * g + 2] * gate, O0[4 * g + 3] * gate);
            w1[g].x = pk2(O1[4 * g] * gate, O1[4 * g + 1] * gate); w1[g].y = pk2(O1[4 * g + 2] * gate, O1[4 * g + 3] * gate);
        }
        store_row16(op, w0, kh); store_row16(op + 32, w1, kh);
    } else if (MODE == 1) {
        bf16_t* op = AO.po + (size_t)tok * 384 + hidx * 64;
        u32x2 w0[4], w1[4];
#pragma unroll
        for (int g = 0; g < 4; ++g) {
            w0[g].x = pk2(O0[4 * g] * rl, O0[4 * g + 1] * rl); w0[g].y = pk2(O0[4 * g + 2] * rl, O0[4 * g + 3] * rl);
            w1[g].x = pk2(O1[4 * g] * rl, O1[4 * g + 1] * rl); w1[g].y = pk2(O1[4 * g + 2] * rl, O1[4 * g + 3] * rl);
        }
        store_row16(op, w0, kh); store_row16(op + 32, w1, kh);
        if (kh == 0) AO.lse[(size_t)tok * 6 + hidx] = lse;
    } else {
        const float l4 = AO.lse4[(size_t)tok * 6 + hidx], l16 = AO.lse16[(size_t)tok * 6 + hidx];
        const float mxl = fmaxf(lse, fmaxf(l4, l16));
        float w1 = __expf(lse - mxl), w4 = __expf(l4 - mxl), w16 = __expf(l16 - mxl);
        const float rs = fast_rcp(w1 + w4 + w16);
        w1 *= rs * rl; w4 *= rs; w16 *= rs;
        const bf16_t* p4 = AO.po4 + (size_t)tok * 384 + hidx * 64 + 4 * kh;
        const bf16_t* p16 = AO.po16 + (size_t)tok * 384 + hidx * 64 + 4 * kh;
        bf16_t* op = AO.mix + (size_t)tok * DM + ocol;
        u32x2 wq[2][4];
#pragma unroll
        for (int g = 0; g < 4; ++g) {
#pragma unroll
            for (int mt = 0; mt < 2; ++mt) {
                const u32x2 a = *(const u32x2*)(p4 + 32 * mt + 8 * g), b = *(const u32x2*)(p16 + 32 * mt + 8 * g);
                float o[4];
#pragma unroll
                for (int e = 0; e < 4; ++e) o[e] = (mt ? O1[4 * g + e] : O0[4 * g + e]) * w1;
                o[0] += bflo(a.x) * w4 + bflo(b.x) * w16; o[1] += bfhi(a.x) * w4 + bfhi(b.x) * w16;
                o[2] += bflo(a.y) * w4 + bflo(b.y) * w16; o[3] += bfhi(a.y) * w4 + bfhi(b.y) * w16;
                wq[mt][g].x = pk2(o[0], o[1]); wq[mt][g].y = pk2(o[2], o[3]);
            }
        }
        store_row16(op, wq[0], kh); store_row16(op + 32, wq[1], kh);
    }
}

struct AttnGeom { int tokb, dil, u0, qcol, kcol, vcol, ocol, hidx, maxd, mode; float sink; bf16_t* po; float* lse; };
constexpr int KV_ROWS = 384, VIMG_OFF = KV_ROWS * VROW;

__device__ __forceinline__ void kv_fetch(const bf16_t* __restrict__ P, const AttnGeom& G, int tid, bf16x8 (&kv)[12], bf16x8 (&qn)[4], int wave, int lane) {
    const int piece = tid & 7, rb = tid >> 3;
#pragma unroll
    for (int i = 0; i < 12; ++i) {
        const int row = rb + 64 * (i % 6), u = G.u0 - 128 + row;
        if (u >= 0) kv[i] = *(const bf16x8*)(P + (size_t)(G.tokb + G.dil * u) * PP + (i < 6 ? G.kcol : G.vcol) + 8 * piece);
    }
    const bf16_t* qp = P + (size_t)(G.tokb + G.dil * (G.u0 + 32 * wave + (lane & 31))) * PP + G.qcol + 8 * (lane >> 5);
#pragma unroll
    for (int ks = 0; ks < 4; ++ks) qn[ks] = *(const bf16x8*)(qp + 16 * ks);
}
__device__ __forceinline__ void kv_store(LAS unsigned char* lds, int tid, const bf16x8 (&kv)[12]) {
    const int piece = tid & 7, rb = tid >> 3;
#pragma unroll
    for (int i = 0; i < 12; ++i) *(LAS bf16x8*)(lds + (i < 6 ? 0 : VIMG_OFF) + (rb + 64 * (i % 6)) * VROW + 16 * piece) = kv[i];
}

__device__ __forceinline__ void attn_wave(LAS unsigned char* lds, const AttnGeom& G, const bf16x8 (&qf)[4], int wave, int lane, const AttnOut& AO0) {
    const int r = lane & 31, kh = lane >> 5;
    const int u0w = G.u0 + 32 * wave;
    f32x16 O0, O1;
#pragma unroll
    for (int j = 0; j < 16; ++j) { O0[j] = 0.f; O1[j] = 0.f; }
    float m2 = -INFINITY, lsum = 0.f;
    const int trlane = ((4 * kh + ((lane & 15) >> 2)) * VROW + 32 * ((lane >> 4) & 1) + 8 * (lane & 3));
    for (int kt = (u0w >= 128 ? 0 : (128 - u0w) >> 5); kt < 5; ++kt) {
        const int ks0 = u0w - 128 + 32 * kt, lrow0 = 32 * wave + 32 * kt;
        bf16x8 kf[4];
        { const LAS unsigned char* kp = lds + (lrow0 + r) * VROW + 16 * kh;
#pragma unroll
          for (int ks = 0; ks < 4; ++ks) kf[ks] = *(const LAS bf16x8*)(kp + 32 * ks); }
        f32x16 S;
#pragma unroll
        for (int j = 0; j < 16; ++j) S[j] = 0.f;
        __builtin_amdgcn_s_setprio(1);
#pragma unroll
        for (int ks = 0; ks < 4; ++ks) S = MFMA32(kf[ks], qf[ks], S);
        __builtin_amdgcn_s_setprio(0);
        if (kt == 0 || kt == 4) {
            const int uq = u0w + r;
#pragma unroll
            for (int j = 0; j < 16; ++j) { const int diff = uq - (ks0 + crow(j, kh)); if (diff < 0 || diff > G.maxd) S[j] = -INFINITY; }
        }
        float mx = S[0];
#pragma unroll
        for (int j = 1; j < 16; ++j) mx = fmaxf(mx, S[j]);
        mx = fmaxf(mx, __shfl_xor(mx, 32));
        const float mnew = fmaxf(m2, mx);
        const float msafe = (mnew == -INFINITY) ? 0.f : mnew;
        const float alpha = fast_exp2(m2 - msafe);
        m2 = mnew;
        float ps = 0.f;
#pragma unroll
        for (int j = 0; j < 16; ++j) { S[j] = fast_exp2(S[j] - msafe); ps += S[j]; }
        lsum = lsum * alpha + ps;
#pragma unroll
        for (int j = 0; j < 16; ++j) { O0[j] *= alpha; O1[j] *= alpha; }
        bf16x8 pf[2];
#pragma unroll
        for (int s = 0; s < 2; ++s) { u32x4 w; w.x = pk2(S[8 * s], S[8 * s + 1]); w.y = pk2(S[8 * s + 2], S[8 * s + 3]); w.z = pk2(S[8 * s + 4], S[8 * s + 5]); w.w = pk2(S[8 * s + 6], S[8 * s + 7]); pf[s] = __builtin_bit_cast(bf16x8, w); }
        LAS s16x4* vt = (LAS s16x4*)(lds + VIMG_OFF + lrow0 * VROW + trlane);
#define TRR(BYTES) __builtin_amdgcn_ds_read_tr16_b64_v4i16(vt + (BYTES) / 8)
        const bf16x8 v00 = __builtin_shufflevector(TRR(0), TRR(1152), 0, 1, 2, 3, 4, 5, 6, 7), v01 = __builtin_shufflevector(TRR(2304), TRR(3456), 0, 1, 2, 3, 4, 5, 6, 7);
        const bf16x8 v10 = __builtin_shufflevector(TRR(64), TRR(1216), 0, 1, 2, 3, 4, 5, 6, 7), v11 = __builtin_shufflevector(TRR(2368), TRR(3520), 0, 1, 2, 3, 4, 5, 6, 7);
#undef TRR
        __builtin_amdgcn_s_setprio(1);
        O0 = MFMA32(v00, pf[0], O0); O0 = MFMA32(v01, pf[1], O0);
        O1 = MFMA32(v10, pf[0], O1); O1 = MFMA32(v11, pf[1], O1);
        __builtin_amdgcn_s_setprio(0);
    }
    AttnOut AO = AO0; AO.sink = G.sink; AO.po = G.po; AO.lse = G.lse;
    const int tok = G.tokb + G.dil * (u0w + r);
    if (G.mode == 0) attn_finish<0>(O0, O1, m2, lsum, tok, G.ocol, G.hidx, kh, AO);
    else if (G.mode == 1) attn_finish<1>(O0, O1, m2, lsum, tok, G.ocol, G.hidx, kh, AO);
    else attn_finish<2>(O0, O1, m2, lsum, tok, G.ocol, G.hidx, kh, AO);
}

struct RgParams { const bf16_t* P; const int* pos; const float* conv_w; const float* conv_b; const bf16_t* wrT; const bf16_t* wiT; const float* b_r; const float* b_i; const float* lam; float* agg; bf16_t* mix; };

template <bool FINAL>
__device__ __forceinline__ void rglru_item(const RgParams& R, int sc, int h, int nt, int lane, LAS unsigned char* yimg) {
    const int r = lane & 31, kh = lane >> 5;
    const int tok_sc = sc * 128, bstart = (sc >> 7) * 128;
    const int ncol = 32 * nt + r, cg = 64 * h + ncol;
    const float br = R.b_r[cg], bi = R.b_i[cg], sp8l = -8.0f * 1.4426950408889634f * log1pf(expf(-R.lam[cg]));
    float carry = 0.f, atot = 1.f;
    if (FINAL) {
        const float* ag = R.agg + (size_t)cg * 2; int s = bstart;
        for (; s + 8 <= sc; s += 8) {
            f32x2 ab[8];
#pragma unroll
            for (int i = 0; i < 8; ++i) ab[i] = *(const f32x2*)(ag + (size_t)(s + i) * 768);
#pragma unroll
            for (int i = 0; i < 8; ++i) carry = ab[i].x * carry + ab[i].y;
        }
        for (; s < sc; ++s) { const f32x2 ab = *(const f32x2*)(ag + (size_t)s * 768); carry = ab.x * carry + ab.y; }
    }
    const int cc = 64 * h + lane;
    const float cw0 = R.conv_w[cc], cw1 = R.conv_w[384 + cc], cw2 = R.conv_w[768 + cc], cw3 = R.conv_w[1152 + cc], cb = R.conv_b[cc];
    unsigned short xr[32];
    const unsigned goff = (unsigned)(4 * kh * PP + ncol);
    float xm1 = 0.f, xm2 = 0.f, xm3 = 0.f;
    { const bf16_t* xp = R.P + (size_t)tok_sc * PP + PC_XC + 64 * h;
      if ((tok_sc & (SEQ - 1)) != 0) { xm1 = bf2f((xp - 1 * PP)[lane]); xm2 = bf2f((xp - 2 * PP)[lane]); xm3 = bf2f((xp - 3 * PP)[lane]); }
#pragma unroll
      for (int t = 0; t < 32; ++t) xr[t] = (xp + (size_t)t * PP)[lane]; }
    for (int mt = 0; mt < 4; ++mt) {
        const int t0 = tok_sc + 32 * mt;
        bf16x8 yf[4];
        {
#pragma unroll
          for (int t = 0; t < 32; ++t) {
              const float x0 = bf2f(xr[t]);
              const float y = cb + cw0 * x0 + cw1 * xm1 + cw2 * xm2 + cw3 * xm3;
              *(LAS bf16_t*)(yimg + t * VROW + 2 * lane) = (bf16_t)(pk2(y, 0.f) & 0xffffu);
              xm3 = xm2; xm2 = xm1; xm1 = x0;
          }
          if (mt < 3) { const bf16_t* xp = R.P + (size_t)(t0 + 32) * PP + PC_XC + 64 * h;
#pragma unroll
              for (int t = 0; t < 32; ++t) xr[t] = (xp + (size_t)t * PP)[lane]; }
#pragma unroll
          for (int ks = 0; ks < 4; ++ks) yf[ks] = *(const LAS bf16x8*)(yimg + r * VROW + 32 * ks + 16 * kh);
        }
        unsigned short graw[16];
        if (FINAL) {
#pragma unroll
            for (int j = 0; j < 16; ++j) graw[j] = (R.P + (size_t)(t0 + (j & 3) + 8 * (j >> 2)) * PP + PC_GC + 64 * h)[goff];
        }
        unsigned rmask = 0u;
#pragma unroll
        for (int g = 0; g < 4; ++g) { const int4 p4 = *(const int4*)(R.pos + t0 + 8 * g + 4 * kh);
            rmask |= (p4.x == 0 ? 1u : 0u) << (4 * g); rmask |= (p4.y == 0 ? 1u : 0u) << (4 * g + 1); rmask |= (p4.z == 0 ? 1u : 0u) << (4 * g + 2); rmask |= (p4.w == 0 ? 1u : 0u) << (4 * g + 3); }
        f32x16 ra, ia, ya;
#pragma unroll
        for (int j = 0; j < 16; ++j) { ra[j] = 0.f; ia[j] = 0.f; ya[j] = 0.f; }
        int ncl = ncol; asm volatile("" : "+v"(ncl));
#pragma unroll
        for (int ks = 0; ks < 4; ++ks) {
            const size_t wo = ((size_t)h * 64 + ncl) * 64 + 16 * ks + 8 * kh;
            const bf16x8 wrf = *(const bf16x8*)(R.wrT + wo), wif = *(const bf16x8*)(R.wiT + wo);
            bf16x8 idf;
#pragma unroll
            for (int i = 0; i < 8; ++i) idf[i] = (16 * ks + 8 * kh + i == ncl) ? (short)0x3f80 : (short)0;
            ra = MFMA32(yf[ks], wrf, ra); ia = MFMA32(yf[ks], wif, ia); ya = MFMA32(yf[ks], idf, ya);
        }
        float av[16], bv[16];
#pragma unroll
        for (int j = 0; j < 16; ++j) {
            const float rr = sigmoidf_(ra[j] + br), ii = sigmoidf_(ia[j] + bi);
            const float a_ = fast_exp2(sp8l * rr);
            float a = a_, mult = __builtin_amdgcn_sqrtf(1.0f - a_ * a_);
            if ((rmask >> j) & 1u) { a = 0.f; mult = 1.f; }
            av[j] = a; bv[j] = mult * ii * ya[j];
        }
        float sa[4], sb[4], pa[4], pb[4];
#pragma unroll
        for (int g = 0; g < 4; ++g) {
            sa[g] = (av[4 * g] * av[4 * g + 1]) * (av[4 * g + 2] * av[4 * g + 3]);
            sb[g] = ((bv[4 * g] * av[4 * g + 1] + bv[4 * g + 1]) * av[4 * g + 2] + bv[4 * g + 2]) * av[4 * g + 3] + bv[4 * g + 3];
            pa[g] = __shfl_xor(sa[g], 32); pb[g] = __shfl_xor(sb[g], 32);
        }
        float c = carry, cin[4], apr = 1.f;
#pragma unroll
        for (int g = 0; g < 4; ++g) {
            const float a0 = kh ? pa[g] : sa[g], b0 = kh ? pb[g] : sb[g], a1 = kh ? sa[g] : pa[g], b1 = kh ? sb[g] : pb[g];
            const float ce = c; c = a0 * c + b0;
            const float co = c; c = a1 * c + b1;
            cin[g] = kh ? co : ce; apr *= a0 * a1;
        }
        carry = c; atot *= apr;
        if (FINAL) {
#pragma unroll
            for (int g = 0; g < 4; ++g) {
                float hp = cin[g];
#pragma unroll
                for (int e = 0; e < 4; ++e) {
                    const int j = 4 * g + e, tok = t0 + crow(j, kh);
                    hp = av[j] * hp + bv[j];
                    const float gt = bf2f(graw[j]);
                    const float z = 0.7978845608028654f * (gt + 0.044715f * gt * gt * gt);
                    const float th = 1.0f - 2.0f * fast_rcp(__expf(2.0f * z) + 1.0f);
                    const float o = hp * 0.5f * gt * (1.0f + th);
                    *(LAS bf16_t*)(yimg + 4608 + crow(j, kh) * 80 + 2 * r) = (bf16_t)(pk2(o, 0.f) & 0xffffu);
                    (void)tok;
                }
            }
#pragma unroll
            for (int q = 0; q < 2; ++q) {
                const int p = lane + 64 * q, tk = p >> 2, qu = p & 3;
                const u32x4 w = *(const LAS u32x4*)(yimg + 4608 + tk * 80 + 16 * qu);
                *(u32x4*)(R.mix + (size_t)(t0 + tk) * DM + 640 + 64 * h + 32 * nt + 8 * qu) = w;
            }
        }
    }
    if (!FINAL && kh == 0) { f32x2 ab = {atot, carry}; *(f32x2*)(R.agg + ((size_t)sc * 384 + cg) * 2) = ab; }
}

struct MapPlain { const float* w; int ld; __device__ __forceinline__ const float* operator()(int R) const { return w + R; } };
struct MapGU { const float* gate; const float* up; int ld;
    __device__ __forceinline__ const float* operator()(int R) const { const int j = 128 * (R >> 8) + (R & 127); const uintptr_t a = (uintptr_t)gate, b = (uintptr_t)up, sel = (uintptr_t)0 - (uintptr_t)((R >> 7) & 1); return (const float*)(a ^ ((a ^ b) & sel)) + j; } };
struct MapIN { const float* w; int ld;
    __device__ __forceinline__ const float* operator()(int R) const {
        int c = R;
        if (R < PC_VA || (R >= PC_QB && R < PC_VB)) { const int q = R & 63; c = (R & ~63) + 32 * ((q >> 2) & 1) + 16 * ((q >> 5) & 1) + 4 * ((q >> 3) & 3) + (q & 3); }
        if (c >= 1664 && c < PC_XC) return nullptr;
        if (c >= PC_XC) c -= 128;
        return w + c; } };

template <class Map>
__device__ __forceinline__ void transpose_item(const Map mp, int K, int N, bf16_t* WT, const float* gain, LAS float* scr, int item, int lane) {
    const int nblk = N / 32, kb = item / nblk, nb = item % nblk, k0 = 64 * kb, n0 = 32 * nb;
    const float* src = mp(n0 + (lane & 31));
    float v[32];
#pragma unroll
    for (int i = 0; i < 32; ++i) { const int kk = 2 * i + (lane >> 5); v[i] = src ? src[(size_t)(k0 + kk) * mp.ld] : 0.f; }
#pragma unroll
    for (int i = 0; i < 32; ++i) { const int kk = 2 * i + (lane >> 5); float t = v[i]; if (gain) t *= gain[k0 + kk]; scr[kk * 33 + (lane & 31)] = t; }
    asm volatile("s_waitcnt lgkmcnt(0)" ::: "memory");
    const int c = lane & 7;
#pragma unroll
    for (int j = 0; j < 4; ++j) { const int n = (lane >> 3) + 8 * j; const LAS float* s = scr + (8 * c) * 33 + n;
        u32x4 o; o.x = pk2(s[0 * 33], s[1 * 33]); o.y = pk2(s[2 * 33], s[3 * 33]); o.z = pk2(s[4 * 33], s[5 * 33]); o.w = pk2(s[6 * 33], s[7 * 33]);
        *(u32x4*)(WT + (size_t)(n0 + n) * K + k0 + 8 * c) = o; }
    asm volatile("s_waitcnt lgkmcnt(0)" ::: "memory");
}

__device__ __forceinline__ float wave_sum(float v) {
#pragma unroll
    for (int o = 1; o < 64; o <<= 1) v += __shfl_xor(v, o);
    return v;
}

__device__ __forceinline__ void sincos_d(double a, float& c, float& s) {
    const double n = rint(a * 0.6366197723675814);
    double t = fma(-n, 1.5707963267948966, a); t = fma(-n, 6.123233995736766e-17, t);
    const double t2 = t * t;
    double sp = -1.0 / 1307674368000.0; sp = sp * t2 + 1.0 / 6227020800.0; sp = sp * t2 - 1.0 / 39916800.0; sp = sp * t2 + 1.0 / 362880.0; sp = sp * t2 - 1.0 / 5040.0; sp = sp * t2 + 1.0 / 120.0; sp = sp * t2 - 1.0 / 6.0; sp = sp * t2 + 1.0;
    const double sn = sp * t;
    double cp = 1.0 / 20922789888000.0; cp = cp * t2 - 1.0 / 87178291200.0; cp = cp * t2 + 1.0 / 479001600.0; cp = cp * t2 - 1.0 / 3628800.0; cp = cp * t2 + 1.0 / 40320.0; cp = cp * t2 - 1.0 / 720.0; cp = cp * t2 + 1.0 / 24.0; cp = cp * t2 - 0.5; cp = cp * t2 + 1.0;
    const int q = (int)((long long)n & 3);
    const double cc = (q == 0) ? cp : (q == 1) ? -sn : (q == 2) ? -cp : sn;
    const double ss = (q == 0) ? sn : (q == 1) ? cp : (q == 2) ? -sn : -cp;
    c = (float)cc; s = (float)ss;
}

typedef const __attribute__((address_space(4))) Args* KArgs;
__device__ __forceinline__ KArgs kargs() { KArgs p = (KArgs)__builtin_amdgcn_kernarg_segment_ptr(); asm volatile("" : "+s"(p)); return p; }
#define IN_F(k) ((const float*)ap->in[k])
__device__ __forceinline__ int fresh_tid(int wave0) { int t = wave0 * 64 + (int)__builtin_amdgcn_mbcnt_hi(~0u, __builtin_amdgcn_mbcnt_lo(~0u, 0u)); asm volatile("" : "+v"(t)); return t; }

template <int WHICH>
__device__ __forceinline__ void gemm_stage(LAS unsigned char* lds, int l, int ffn, int wave0) {
    KArgs ap = kargs();
    unsigned char* ws = ap->ws; const int G = gridDim.x;
    unsigned char* wl = ws + WS_W + (size_t)l * W_LAYER;
    bf16_t* XB = (bf16_t*)(ws + WS_XB); bf16_t* ACT = (bf16_t*)(ws + WS_ACT); float* ssq0 = (float*)(ws + WS_SSQ) + (size_t)(3 * l) * SSQ_SLOT;
    if (WHICH == 0) {
        pg8::Gemm g{XB, (const bf16_t*)(wl + (ffn ? WO_GU2 : WO_GU1)), MTOK, NGU, DM}; pg8::StaticOrder S; S.init(MTOK, NGU, G, (int)blockIdx.x);
        pg8::EpiGateUp E{ssq0 + (ffn ? 2 * SSQ_SLOT : 0), ACT};
        pg8::gemm_phase<pg8::EpiGateUp, pg8::StaticOrder, true, true>(lds, g, S, E, fresh_tid(wave0));
    } else if (WHICH == 1) {
        pg8::Gemm g{ACT, (const bf16_t*)(wl + (ffn ? WO_D2 : WO_D1)), MTOK, DM, FF}; pg8::StaticOrder S; S.init(MTOK, DM, G, (int)blockIdx.x);
        pg8::EpiResidual E{XB, ssq0 + (ffn ? 3 * SSQ_SLOT : SSQ_SLOT), 0.5f};
        pg8::gemm_phase<pg8::EpiResidual, pg8::StaticOrder, true, true>(lds, g, S, E, fresh_tid(wave0));
    } else if (WHICH == 2) {
        float* cosT = (float*)(ws + WS_ROPE);
        pg8::Gemm g{XB, (const bf16_t*)(wl + WO_IN), MTOK, NIN, DM}; pg8::StaticOrder S; S.init(MTOK, NIN, G, (int)blockIdx.x);
        pg8::EpiProj E{ssq0 + SSQ_SLOT, cosT, cosT + (size_t)MTOK * 32, ACT};
        pg8::gemm_phase<pg8::EpiProj, pg8::StaticOrder, true, true>(lds, g, S, E, fresh_tid(wave0));
    } else {
        pg8::Gemm g{(const bf16_t*)(ws + WS_MIX), (const bf16_t*)(wl + WO_OUT), MTOK, DM, DM}; pg8::StaticOrder S; S.init(MTOK, DM, G, (int)blockIdx.x);
        pg8::EpiResidual E{XB, ssq0 + 2 * SSQ_SLOT, 1.0f};
        pg8::gemm_phase<pg8::EpiResidual, pg8::StaticOrder, true, true>(lds, g, S, E, fresh_tid(wave0));
    }
}

__device__ __forceinline__ void prologue_stage(LAS unsigned char* lds, int wave0) {
    KArgs ap = kargs(); const int tid = fresh_tid(wave0), lane = tid & 63, wave = __builtin_amdgcn_readfirstlane(tid >> 6);
    unsigned char* ws = ap->ws; const int G = gridDim.x, gw = blockIdx.x * 8 + wave, NGW = G * 8;
    LAS float* scr = (LAS float*)(lds + wave * 16384);
    constexpr int I_GU = (DM / 64) * (NGU / 32), I_D = (FF / 64) * (DM / 32), I_IN = (DM / 64) * (NIN / 32), I_OUT = (DM / 64) * (DM / 32);
    constexpr int I_LAYER = 2 * I_GU + 2 * I_D + I_IN + I_OUT;
    for (int it = gw; it < DEPTH * I_LAYER; it += NGW) {
        const int l = it / I_LAYER; int r = it % I_LAYER;
        unsigned char* wl = ws + WS_W + (size_t)l * W_LAYER;
        if (r < I_GU) { MapGU mp{IN_F(3) + (size_t)l * DM * FF, IN_F(4) + (size_t)l * DM * FF, FF};
            transpose_item(mp, DM, NGU, (bf16_t*)(wl + WO_GU1), IN_F(2) + l * DM, scr, r, lane); continue; } r -= I_GU;
        if (r < I_D) { MapPlain mp{IN_F(5) + (size_t)l * FF * DM, DM};
            transpose_item(mp, FF, DM, (bf16_t*)(wl + WO_D1), nullptr, scr, r, lane); continue; } r -= I_D;
        if (r < I_IN) { MapIN mp{IN_F(7) + (size_t)l * DM * INC, INC};
            transpose_item(mp, DM, NIN, (bf16_t*)(wl + WO_IN), IN_F(6) + l * DM, scr, r, lane); continue; } r -= I_IN;
        if (r < I_OUT) { MapPlain mp{IN_F(16) + (size_t)l * DM * DM, DM};
            transpose_item(mp, DM, DM, (bf16_t*)(wl + WO_OUT), nullptr, scr, r, lane); continue; } r -= I_OUT;
        if (r < I_GU) { MapGU mp{IN_F(18) + (size_t)l * DM * FF, IN_F(19) + (size_t)l * DM * FF, FF};
            transpose_item(mp, DM, NGU, (bf16_t*)(wl + WO_GU2), IN_F(17) + l * DM, scr, r, lane); continue; } r -= I_GU;
        { MapPlain mp{IN_F(20) + (size_t)l * FF * DM, DM};
            transpose_item(mp, FF, DM, (bf16_t*)(wl + WO_D2), nullptr, scr, r, lane); }
    }
    const int gt = blockIdx.x * 512 + tid, NGT = G * 512;
    { const int* positions = (const int*)ap->in[1]; float* cosT = (float*)(ws + WS_ROPE); float* sinT = cosT + (size_t)MTOK * 32;
      for (int i = gt; i < MTOK * 32; i += NGT) {
          const int tok = i >> 5, k = i & 31;
          const float ang = (float)positions[tok] * INV_TAB[k];
          float c, s; sincos_d((double)ang, c, s);
          cosT[i] = c; sinT[i] = s;
      } }
    { float* SSQ = (float*)(ws + WS_SSQ);
      const float* x_in = IN_F(0); bf16_t* XB = (bf16_t*)(ws + WS_XB);
      for (int m = gw; m < MTOK; m += NGW) {
          const f32x4* xr = (const f32x4*)(x_in + (size_t)m * DM) + lane; float s = 0.f;
          unsigned long long* o8 = (unsigned long long*)(XB + (size_t)m * DM) + lane;
#pragma unroll
          for (int j = 0; j < 4; ++j) { const f32x4 v = xr[64 * j]; s += (v.x * v.x + v.y * v.y) + (v.z * v.z + v.w * v.w);
              o8[64 * j] = (unsigned long long)pk2(v.x, v.y) | ((unsigned long long)pk2(v.z, v.w) << 32); }
          s = wave_sum(s);
          if (lane < 16) SSQ[(size_t)m * 16 + lane] = lane == 0 ? s : 0.f;
      } }
    { bf16_t* RGW = (bf16_t*)(ws + WS_RGW); const float* wr = IN_F(11); const float* wi = IN_F(13);
      for (int i = gt; i < DEPTH * 2 * 6 * 4096; i += NGT) {
          const int ii = i & 63, j = (i >> 6) & 63, h = (i >> 12) % 6, gl = i / (6 * 4096), g = gl & 1, l = gl >> 1;
          const size_t so = ((size_t)(l * 6 + h) * 64 + ii) * 64 + j;
          const float v = g ? wi[so] : wr[so];
          RGW[i] = (bf16_t)(pk2(v, 0.f) & 0xffffu);
      } }
}

template <int SUB>
__device__ __forceinline__ void mixer_rg(LAS unsigned char* lds, int l, int wave0) {
    KArgs ap = kargs(); const int tid = fresh_tid(wave0), lane = tid & 63, wave = __builtin_amdgcn_readfirstlane(tid >> 6);
    unsigned char* ws = ap->ws; const int gw = blockIdx.x * 8 + wave, NGW = gridDim.x * 8;
    bf16_t* RGW = (bf16_t*)(ws + WS_RGW);
    RgParams RP{(const bf16_t*)(ws + WS_ACT), (const int*)ap->in[1], IN_F(9) + (size_t)l * 4 * 384, IN_F(10) + l * 384,
                RGW + (size_t)(l * 2 + 0) * 6 * 4096, RGW + (size_t)(l * 2 + 1) * 6 * 4096,
                IN_F(12) + l * 384, IN_F(14) + l * 384, IN_F(15) + l * 384, (float*)(ws + WS_AGG), (bf16_t*)(ws + WS_MIX)};
    LAS unsigned char* yimg = lds + wave * 8192;
    constexpr int N_RG = 256 * 12;
    for (int it = gw; it < N_RG; it += NGW) rglru_item<SUB == 1>(RP, it / 12, (it % 12) >> 1, it & 1, lane, yimg);
}
template <int SUB>
__device__ __forceinline__ void mixer_attn(LAS unsigned char* lds, int l, int wave0) {
    KArgs ap = kargs(); const int tid = fresh_tid(wave0), lane = tid & 63, wave = __builtin_amdgcn_readfirstlane(tid >> 6);
    unsigned char* ws = ap->ws; const int G = gridDim.x;
    const bf16_t* PB = (const bf16_t*)(ws + WS_ACT);
    unsigned char* obp = (unsigned char*)ap->out;
    AttnOut AO{(bf16_t*)(ws + WS_MIX), nullptr, nullptr, (const bf16_t*)(obp + OB_PO4), (const bf16_t*)(obp + OB_PO16), (const float*)(obp + OB_LSE4), (const float*)(obp + OB_LSE16), 0.f};
    const float* sinks = IN_F(8) + l * 4;
    auto geom = [&](int j) -> AttnGeom {
        AttnGeom g; g.sink = 0.f; g.po = nullptr; g.lse = nullptr; g.ocol = 0;
        if (SUB == 0) {
            const int br = j / 768, rr = j % 768, dil = br ? 16 : 4, nblk = SEQ / dil / 256;
            const int qb = rr % nblk, rho = (rr / nblk) % dil, bh = rr / (nblk * dil), h = bh % 6, b = bh / 6;
            g.tokb = b * SEQ + rho; g.dil = dil; g.u0 = qb * 256; g.qcol = PC_QB + 64 * h; g.kcol = PC_KB + 64 * h; g.vcol = PC_VB + 64 * h; g.hidx = h; g.maxd = 128; g.mode = 1;
            g.po = (bf16_t*)(obp + (br ? OB_PO16 : OB_PO4)); g.lse = (float*)(obp + (br ? OB_LSE16 : OB_LSE4));
        } else if (j < 512) {
            const int qb = j % 64, bhq = j / 64, hq = bhq % 4, b = bhq / 4, kv = hq >> 1;
            g.tokb = b * SEQ; g.dil = 1; g.u0 = qb * 256; g.qcol = PC_QA + 64 * hq; g.kcol = PC_KA + 64 * kv; g.vcol = PC_VA + 64 * kv; g.ocol = 64 * hq; g.hidx = hq; g.maxd = 127; g.mode = 0;
            g.sink = sinks[hq];
        } else {
            const int rr = j - 512, qb = rr % 64, bh = rr / 64, h = bh % 6, b = bh / 6;
            g.tokb = b * SEQ; g.dil = 1; g.u0 = qb * 256; g.qcol = PC_QB + 64 * h; g.kcol = PC_KB + 64 * h; g.vcol = PC_VB + 64 * h; g.ocol = 256 + 64 * h; g.hidx = h; g.maxd = 128; g.mode = 2;
        }
        return g;
    };
    constexpr int N_ATT = SUB == 0 ? 1536 : 1280;
    asm volatile("s_waitcnt lgkmcnt(0)" ::: "memory"); __builtin_amdgcn_s_barrier();
    int j = blockIdx.x; asm volatile("" : "+s"(j));
    if (j < N_ATT) {
        bf16x8 kv[12], qn[4];
        AttnGeom g = geom(j);
        kv_fetch(PB, g, tid, kv, qn, wave, lane);
        for (;;) {
            kv_store(lds, tid, kv);
            bf16x8 qf[4];
#pragma unroll
            for (int i = 0; i < 4; ++i) qf[i] = qn[i];
            asm volatile("s_waitcnt lgkmcnt(0)" ::: "memory"); __builtin_amdgcn_s_barrier(); asm volatile("" ::: "memory");
            const int jn = j + G; const bool more = jn < N_ATT;
            AttnGeom gn = g;
            if (more) { gn = geom(jn); kv_fetch(PB, gn, tid, kv, qn, wave, lane); }
            attn_wave(lds, g, qf, wave, lane, AO);
            asm volatile("" ::: "memory"); __builtin_amdgcn_s_barrier(); asm volatile("" ::: "memory");
            if (!more) break;
            g = gn; j = jn;
        }
    }
}
template <int SUB>
__device__ __forceinline__ void mixer_stage(LAS unsigned char* lds, int l, int wave0) { mixer_rg<SUB>(lds, l, wave0); mixer_attn<SUB>(lds, l, wave0); }

#define XB_TMO      128
#define XB_XCNT(j)  (256  + 64 * (j))
#define XB_XSUB(j)  (1280 + 64 * (j))
#define XB_XGEN(j)  (2304 + 64 * (j))
#define XB_TOP      3328
#define XB_TOPGEN   3392
#define XCD_BAR_WORDS 3456
#define XB_SPIN_CAP (1u << 18)

__device__ __forceinline__ unsigned xb_ld(unsigned* p)              { return __hip_atomic_load(p, __ATOMIC_RELAXED, __HIP_MEMORY_SCOPE_AGENT); }
__device__ __forceinline__ unsigned xb_add(unsigned* p, unsigned v) { return __hip_atomic_fetch_add(p, v, __ATOMIC_RELAXED, __HIP_MEMORY_SCOPE_AGENT); }
__device__ __forceinline__ unsigned xb_xcc_id() { return (unsigned)__builtin_amdgcn_s_getreg((3 << 11) | 20) & 0xFu; }
#define XB_SPIN(cond, bar) do { unsigned _sp = 0; while (cond) { __builtin_amdgcn_s_sleep(1); \
    if ((++_sp & 255u) == 0u) { if (xb_ld(&(bar)[XB_TMO])) break; if (_sp > XB_SPIN_CAP) { atomicAdd(&(bar)[XB_TMO], 1u); break; } } } } while (0)

struct XcdBarrier {
    unsigned* bar; unsigned x; bool lead;
    volatile LAS unsigned* st;
};

__device__ __forceinline__ XcdBarrier xcd_barrier_post(unsigned* bar, volatile LAS unsigned* st, bool lead) {
    XcdBarrier b; b.bar = bar; b.x = xb_xcc_id(); b.st = st; b.lead = lead;
    if (lead) (void)xb_add(&bar[XB_XCNT(b.x)], 1u);
    return b;
}
__device__ __forceinline__ void xcd_barrier_complete(unsigned* bar, unsigned x, unsigned& nloc, unsigned& nx) {
    const unsigned G = gridDim.x * gridDim.y * gridDim.z;
    unsigned sum, cnt, mine, sp = 0u;
    for (;;) {
        sum = 0u; cnt = 0u; mine = 0u;
#pragma unroll
        for (unsigned j = 0; j < 16; ++j) { const unsigned c = xb_ld(&bar[XB_XCNT(j)]); sum += c; cnt += (c > 0u) ? 1u : 0u; mine = (j == x) ? c : mine; }
        if (sum == G) break;
        __builtin_amdgcn_s_sleep(1);
        if ((++sp & 255u) == 0u) { if (xb_ld(&bar[XB_TMO])) break; if (sp > XB_SPIN_CAP) { atomicAdd(&bar[XB_TMO], 1u); break; } }
    }
    nloc = mine > 0u ? mine : 1u; nx = cnt > 0u ? cnt : 1u;
}

__device__ __forceinline__ void xcd_barrier(const XcdBarrier& b) {
    asm volatile("s_waitcnt vmcnt(0)" ::: "memory");
    __syncthreads();
    if (b.lead) {
        unsigned* bar = b.bar;
        __builtin_amdgcn_s_waitcnt(0);
        unsigned nloc = b.st[0], nx = b.st[1];
        if (nloc == 0u) { xcd_barrier_complete(bar, b.x, nloc, nx); b.st[0] = nloc; b.st[1] = nx; }
        const unsigned old = xb_add(&bar[XB_XSUB(b.x)], 1u);
        const unsigned gen = old / nloc;
        if (old + 1u == (gen + 1u) * nloc) {
            __builtin_amdgcn_fence(__ATOMIC_RELEASE, "agent");
            asm volatile("s_waitcnt vmcnt(0)" ::: "memory");
            const unsigned og = xb_add(&bar[XB_TOP], 1u);
            const unsigned tg = og / nx;
            if (og + 1u == (tg + 1u) * nx) xb_add(&bar[XB_TOPGEN], 1u);
            else XB_SPIN(xb_ld(&bar[XB_TOPGEN]) == tg, bar);
            __builtin_amdgcn_fence(__ATOMIC_ACQUIRE, "agent");
            xb_add(&bar[XB_XGEN(b.x)], 1u);
            asm volatile("s_waitcnt vmcnt(0)" ::: "memory");
        } else {
            XB_SPIN(xb_ld(&bar[XB_XGEN(b.x)]) == gen, bar);
            __builtin_amdgcn_fence(__ATOMIC_ACQUIRE, "agent");
            asm volatile("s_waitcnt vmcnt(0)" ::: "memory");
        }
    }
    __syncthreads();
}

#define GRID_SYNC_CG() do { asm volatile("s_waitcnt vmcnt(0)" ::: "memory"); grid.sync(); __builtin_amdgcn_fence(__ATOMIC_ACQUIRE, "agent"); asm volatile("s_waitcnt vmcnt(0)" ::: "memory"); } while (0)
#define GRID_SYNC() do { XcdBarrier b_; b_.bar = (unsigned*)(kargs()->ws + WS_BAR); b_.x = xb_xcc_id(); b_.st = (volatile LAS unsigned*)(lds + 131072 + 64); b_.lead = fresh_tid(wave0) == 0; xcd_barrier(b_); } while (0)
__global__ void __launch_bounds__(512, 2) hymba_fwd(Args args) {
    extern __shared__ __attribute__((aligned(16))) unsigned char lds_raw[];
    cg::grid_group grid = cg::this_grid();
    LAS unsigned char* lds = (LAS unsigned char*)lds_raw;
    const int wave0 = __builtin_amdgcn_readfirstlane((int)threadIdx.x >> 6);
    volatile LAS unsigned* xst = (volatile LAS unsigned*)(lds + 131072 + 64);
    { const int t0_ = fresh_tid(wave0); if (t0_ < 2) xst[t0_] = 0u; __syncthreads(); (void)xcd_barrier_post((unsigned*)(kargs()->ws + WS_BAR), xst, t0_ == 0); }
    prologue_stage(lds, wave0);
    if (kargs()->out == nullptr) GRID_SYNC_CG();
    GRID_SYNC();
    for (int l = 0; l < DEPTH; ++l) {
        gemm_stage<0>(lds, l, 0, wave0); GRID_SYNC();
        gemm_stage<1>(lds, l, 0, wave0); GRID_SYNC();
        gemm_stage<2>(lds, l, 0, wave0); GRID_SYNC();
        mixer_stage<0>(lds, l, wave0); GRID_SYNC();
        mixer_stage<1>(lds, l, wave0); GRID_SYNC();
        gemm_stage<3>(lds, l, 0, wave0); GRID_SYNC();
        gemm_stage<0>(lds, l, 1, wave0); GRID_SYNC();
        gemm_stage<1>(lds, l, 1, wave0); GRID_SYNC();
    }
    {
        KArgs ap = kargs(); const int tid = fresh_tid(wave0), lane = tid & 63, wave = __builtin_amdgcn_readfirstlane(tid >> 6);
        const int gw = blockIdx.x * 8 + wave, NGW = gridDim.x * 8;
        float* out = ap->out; const bf16_t* XB = (const bf16_t*)(ap->ws + WS_XB); const float* gfin = IN_F(21); const float* ssqF = (const float*)(ap->ws + WS_SSQ) + (size_t)12 * SSQ_SLOT;
        for (int m = gw; m < MTOK; m += NGW) {
            const float rstd = rsqrtf(ssq_row(ssqF, m) * (1.0f / DM) + EPS);
            const u32x2* xr = (const u32x2*)(XB + (size_t)m * DM) + lane; f32x4* orow = (f32x4*)(out + (size_t)m * DM) + lane; const f32x4* gr = (const f32x4*)gfin + lane;
#pragma unroll
            for (int j = 0; j < 4; ++j) { const u32x2 v = xr[64 * j]; const f32x4 g = gr[64 * j];
                f32x4 o; o[0] = bflo(v.x) * rstd * g[0]; o[1] = bfhi(v.x) * rstd * g[1]; o[2] = bflo(v.y) * rstd * g[2]; o[3] = bfhi(v.y) * rstd * g[3];
                orow[64 * j] = o; }
        }
    }
}

extern "C" void kernel_launch(void* const* d_in, const int* in_sizes, int n_in, void* d_out, int out_size, void* d_ws, size_t ws_size, hipStream_t stream) {
    static int grid = 0;
    if (grid == 0) {
        if (n_in != 22 || out_size != MTOK * DM || ws_size < WS_END) { fprintf(stderr, "kernel_launch: unexpected shapes (n_in %d, out %d, ws %zu)\n", n_in, out_size, ws_size); grid = -1; return; }
        int dev = 0, cus = 0, per_cu = 0;
        (void)hipGetDevice(&dev); (void)hipDeviceGetAttribute(&cus, hipDeviceAttributeMultiprocessorCount, dev);
        if (hipFuncSetAttribute((const void*)hymba_fwd, hipFuncAttributeMaxDynamicSharedMemorySize, LDS_BYTES) != hipSuccess) { fprintf(stderr, "kernel_launch: hipFuncSetAttribute failed\n"); grid = -1; return; }
        if (hipOccupancyMaxActiveBlocksPerMultiprocessor(&per_cu, (const void*)hymba_fwd, 512, LDS_BYTES) != hipSuccess || per_cu < 1) { fprintf(stderr, "kernel_launch: occupancy query gave %d\n", per_cu); per_cu = 1; }
        (void)hipGetLastError();
        grid = cus * per_cu;
    }
    if (grid < 0) return;
    if (hipMemsetAsync((char*)d_ws + WS_BAR, 0, XCD_BAR_WORDS * 4, stream) != hipSuccess) { fprintf(stderr, "kernel_launch: hipMemsetAsync failed\n"); return; }
    Args a{};
    for (int i = 0; i < 22; ++i) a.in[i] = d_in[i];
    a.out = (float*)d_out; a.ws = (unsigned char*)d_ws;
    void* kargs[] = {&a};
    hipError_t e = hipLaunchCooperativeKernel((const void*)hymba_fwd, dim3(grid), dim3(512), kargs, LDS_BYTES, stream);
    if (e != hipSuccess) fprintf(stderr, "kernel_launch: cooperative launch failed: %s (grid %d)\n", hipGetErrorString(e), grid);
}
```

```cpp
#include <hip/hip_runtime.h>
#include <hip/hip_cooperative_groups.h>
#include <cstdio>
#include <cstdint>
#include <cmath>
namespace cg = cooperative_groups;
namespace pg8 {
#define PG8_LAS __attribute__((address_space(3)))
typedef unsigned short bf16_t;
typedef short bf16x8 __attribute__((ext_vector_type(8)));
typedef float f32x4 __attribute__((ext_vector_type(4)));
typedef unsigned u32x4 __attribute__((ext_vector_type(4)));
constexpr int BM = 256, BK = 64, HALF = 128, HTB = HALF * BK * 2  , STAGE_BYTES = 8 * HTB, NXCD = 8, WGM = 8;

__host__ __device__ __forceinline__ int lds_byte(int r, int c) { const int st = (r >> 4) * 2 + (c >> 5), rr = r & 15, cc = c & 31, ob = rr * 64 + cc * 2; return st * 1024 + (ob ^ (((ob >> 9) & 1) << 5)); }
__host__ __device__ __forceinline__ void stage_rc(int b, int& R, int& C) { const int st = b / 1024, sb = b % 1024, swz = sb ^ (((sb >> 9) & 1) << 5); R = (st >> 1) * 16 + swz / 64; C = (st & 1) * 32 + (swz % 64) / 2; }
__host__ __device__ __forceinline__ int perm32(int rho) { const int n = rho >> 4, i = rho & 15; return 8 * (i >> 2) + 4 * n + (i & 3); }

struct Unit { int pm, pn; };
struct Gemm { const bf16_t* A; const bf16_t* Bt; int M, N, K; };

struct StaticOrder {
    int nM, nN, nwg, G, c;
    __host__ __device__ void init(int M, int N, int G_, int c_) { nM = M / BM; nN = N / BM; nwg = nM * nN; G = G_; c = c_; }
    __host__ __device__ bool next(int i, Unit& u) const {
        const long L = (long)i * G + c; if (L >= nwg) return false;
        int wgid = (int)L; { const int q = nwg / NXCD, r = nwg % NXCD, xcd = wgid % NXCD, off = wgid / NXCD; wgid = (xcd < r ? xcd * (q + 1) : r * (q + 1) + (xcd - r) * q) + off; }
        const int nig = WGM * nN, gid = wgid / nig, fm = gid * WGM, gsz = (nM - fm) < WGM ? (nM - fm) : WGM;
        u.pm = fm + ((wgid % nig) % gsz); u.pn = (wgid % nig) / gsz; return true;
    }
    __device__ __forceinline__ void a_ready(const Unit&) const {}
    __device__ __forceinline__ void done(const Unit&) const {}
};
}

constexpr int DM = 1024, BATCH = 2, SEQ = 16384, MTOK = BATCH * SEQ, DEPTH = 4, FF = 2816, NGU = 2 * FF, NIN = 2560, INC = 2432;
constexpr int PC_QA = 0, PC_KA = 256, PC_VA = 384, PC_QB = 512, PC_KB = 896, PC_VB = 1280, PC_XC = 1792, PC_GC = 2176;
__device__ __forceinline__ size_t p_pos(bool perm, int tokabs) { const int s = tokabs & (SEQ - 1); return perm ? (size_t)((tokabs - s) + (s & 15) * (SEQ / 16) + (s >> 4)) : (size_t)tokabs; }
__device__ __forceinline__ size_t p_off(int g, bool perm, int tokabs) { return ((size_t)g * MTOK + p_pos(perm, tokabs)) * 64; }
constexpr float EPS = 1e-6f;
constexpr float QSCALE = 0.125f * 1.4426950408889634f;

#define LAS __attribute__((address_space(3)))
typedef unsigned short bf16_t;
typedef short bf16x8 __attribute__((ext_vector_type(8)));
typedef short s16x4 __attribute__((ext_vector_type(4)));
typedef float f32x4 __attribute__((ext_vector_type(4)));
typedef float f32x2 __attribute__((ext_vector_type(2)));
typedef float f32x16 __attribute__((ext_vector_type(16)));
typedef unsigned u32x4 __attribute__((ext_vector_type(4)));
typedef unsigned u32x2 __attribute__((ext_vector_type(2)));
typedef __bf16 nbf16x2 __attribute__((ext_vector_type(2)));

__device__ __forceinline__ unsigned pk2(float lo, float hi) { f32x2 v = {lo, hi}; nbf16x2 r = __builtin_convertvector(v, nbf16x2); return __builtin_bit_cast(unsigned, r); }
__device__ __forceinline__ float bf2f(unsigned short h) { return __builtin_bit_cast(float, (unsigned)h << 16); }
__device__ __forceinline__ float bflo(unsigned w) { return __builtin_bit_cast(float, w << 16); }
__device__ __forceinline__ float bfhi(unsigned w) { return __builtin_bit_cast(float, w & 0xffff0000u); }
__device__ __forceinline__ float fast_rcp(float x) { return __builtin_amdgcn_rcpf(x); }
__device__ __forceinline__ float fast_exp2(float x) { return __builtin_amdgcn_exp2f(x); }
__device__ __forceinline__ float sigmoidf_(float x) { return fast_rcp(1.0f + __expf(-x)); }

__device__ __forceinline__ float ssq_row(const float* part, int row) {
    const f32x4* p = (const f32x4*)(part + (size_t)row * 16);
    const f32x4 a = p[0], b = p[1], c = p[2], d = p[3];
    return (((a[0] + a[1]) + (a[2] + a[3])) + ((b[0] + b[1]) + (b[2] + b[3]))) + (((c[0] + c[1]) + (c[2] + c[3])) + ((d[0] + d[1]) + (d[2] + d[3])));
}

namespace pg8 {
__device__ __forceinline__ void rstd8(const float* ssq, int row0, int fq, float (&rstd)[8]) {
    f32x4 q[8];
#pragma unroll
    for (int i = 0; i < 8; ++i) q[i] = *(const f32x4*)(ssq + (size_t)(row0 + (i >> 2) * HALF + (i & 3) * 16) * 16 + 4 * fq);
#pragma unroll
    for (int i = 0; i < 8; ++i) { float s = (q[i][0] + q[i][1]) + (q[i][2] + q[i][3]); s += __shfl_xor(s, 16); s += __shfl_xor(s, 32); rstd[i] = rsqrtf(s * (1.0f / DM) + EPS); }
}
struct EpiGateUp {
    static constexpr bool PERM = true, AFTER_DRAIN = false;
    const float* ssq; bf16_t* act;
    __device__ __forceinline__ void operator()(const f32x4 (&acc)[2][2][4][2], const Unit& u, int wr, int wc, int fr, int fq) const {
        float rstd[8]; rstd8(ssq, u.pm * BM + wr * 64 + fr, fq, rstd);
#pragma unroll
        for (int ai = 0; ai < 2; ++ai)
#pragma unroll
            for (int m = 0; m < 4; ++m) {
                const int row = u.pm * BM + ai * HALF + wr * 64 + m * 16 + fr;
                const float rs = rstd[ai * 4 + m];
                float a[8];
#pragma unroll
                for (int n = 0; n < 2; ++n) {
                    const f32x4 g = acc[ai][0][m][n] * rs, up = acc[ai][1][m][n] * rs;
#pragma unroll
                    for (int e = 0; e < 4; ++e) a[4 * n + e] = g[e] * fast_rcp(1.0f + __expf(-g[e])) * up[e];
                }
                u32x4 w; w.x = pk2(a[0], a[1]); w.y = pk2(a[2], a[3]); w.z = pk2(a[4], a[5]); w.w = pk2(a[6], a[7]);
                *(u32x4*)(act + (size_t)row * FF + u.pn * 128 + wc * 32 + fq * 8) = w;
            }
    }
};
struct EpiResidual {
    static constexpr bool PERM = true, AFTER_DRAIN = false;
    bf16_t* xb; float* ssq_out; float scale;
    __device__ __forceinline__ void operator()(const f32x4 (&acc)[2][2][4][2], const Unit& u, int wr, int wc, int fr, int fq) const {
        bf16_t* p0 = xb + (size_t)(u.pm * BM + wr * 64 + fr) * DM + u.pn * BM + wc * 32 + fq * 8;
        u32x4 b[8][2];
#pragma unroll
        for (int i = 0; i < 2; ++i)
#pragma unroll
            for (int bj = 0; bj < 2; ++bj) b[i][bj] = *(const u32x4*)(p0 + (size_t)((i >> 2) * HALF + (i & 3) * 16) * DM + bj * HALF);
#pragma unroll
        for (int i = 0; i < 8; ++i) {
            if (i + 2 < 8) {
#pragma unroll
                for (int bj = 0; bj < 2; ++bj) b[i + 2][bj] = *(const u32x4*)(p0 + (size_t)(((i + 2) >> 2) * HALF + ((i + 2) & 3) * 16) * DM + bj * HALF);
            }
            const int ai = i >> 2, m = i & 3;
            const int row = u.pm * BM + ai * HALF + wr * 64 + m * 16 + fr;
            float sq = 0.f;
#pragma unroll
            for (int bj = 0; bj < 2; ++bj) {
                const u32x4 bb = b[i][bj];
                const f32x4 a0 = acc[ai][bj][m][0] * scale, a1 = acc[ai][bj][m][1] * scale;
                const float o0 = bflo(bb.x) + a0[0], o1 = bfhi(bb.x) + a0[1], o2 = bflo(bb.y) + a0[2], o3 = bfhi(bb.y) + a0[3];
                const float o4 = bflo(bb.z) + a1[0], o5 = bfhi(bb.z) + a1[1], o6 = bflo(bb.w) + a1[2], o7 = bfhi(bb.w) + a1[3];
                sq += ((o0 * o0 + o1 * o1) + (o2 * o2 + o3 * o3)) + ((o4 * o4 + o5 * o5) + (o6 * o6 + o7 * o7));
                u32x4 w; w.x = pk2(o0, o1); w.y = pk2(o2, o3); w.z = pk2(o4, o5); w.w = pk2(o6, o7);
                *(u32x4*)(p0 + (size_t)(ai * HALF + m * 16) * DM + bj * HALF) = w;
            }
            sq += __shfl_xor(sq, 16); sq += __shfl_xor(sq, 32);
            if (fq == 0) ssq_out[(size_t)row * 16 + u.pn * 4 + wc] = sq;
            asm volatile("" ::: "memory");
        }
    }
};
struct EpiProj {
    static constexpr bool PERM = true, AFTER_DRAIN = false;
    const float* ssq; const float* cosT; const float* sinT; bf16_t* P;
    __device__ __forceinline__ void operator()(const f32x4 (&acc)[2][2][4][2], const Unit& u, int wr, int wc, int fr, int fq) const {
        const int row0 = u.pm * BM + wr * 64 + fr;
        float rstd[8]; rstd8(ssq, row0, fq, rstd);
        const int d1 = 16 * (wc & 1) + 4 * fq;
        const bool rope0 = (u.pn * BM + wc * 32 < PC_VA) || (u.pn * BM + wc * 32 >= PC_QB && u.pn * BM + wc * 32 < PC_VB);
        f32x4 c4[8], s4[8];
#pragma unroll
        for (int i = 0; i < 2; ++i) { const size_t to = (size_t)(row0 + (i >> 2) * HALF + (i & 3) * 16) * 32 + d1; c4[i] = *(const f32x4*)(cosT + to); s4[i] = *(const f32x4*)(sinT + to); }
#pragma unroll
        for (int i = 0; i < 8; ++i) {
            if (i + 2 < 8) { const size_t to = (size_t)(row0 + ((i + 2) >> 2) * HALF + ((i + 2) & 3) * 16) * 32 + d1; c4[i + 2] = *(const f32x4*)(cosT + to); s4[i + 2] = *(const f32x4*)(sinT + to); }
            const int ai = i >> 2, m = i & 3;
            const int row = row0 + ai * HALF + m * 16;
            const float rs = rstd[i];
#pragma unroll
            for (int bj = 0; bj < 2; ++bj) {
                const int cb = u.pn * BM + bj * HALF + wc * 32;
                f32x4 v0 = acc[ai][bj][m][0] * rs, v1 = acc[ai][bj][m][1] * rs;
                const bool rope = (cb < PC_VA) || (cb >= PC_QB && cb < PC_VB);
                const bool isq = (cb < PC_KA) || (cb >= PC_QB && cb < PC_KB);
                if (rope) {
                    const f32x4 o0 = v0 * c4[i] - v1 * s4[i], o1 = v1 * c4[i] + v0 * s4[i];
                    const float qs = isq ? QSCALE : 1.0f;
                    v0 = o0 * qs; v1 = o1 * qs;
                }
                u32x4 w; w.x = pk2(v0[0], v0[1]); w.y = pk2(v0[2], v0[3]); w.z = pk2(v1[0], v1[1]); w.w = pk2(v1[2], v1[3]);
                *(u32x4*)(P + p_off(cb >> 6, cb >= PC_QB && cb < 1664, row) + (cb & 63) + fq * 8) = w;
            }
            asm volatile("" ::: "memory");
        }
        (void)rope0;
    }
};
}
namespace pg8 {
template <class Epi, class Sched, bool ALIGN_EPI = false, bool SP2 = false>
__device__ __forceinline__ void gemm_phase(PG8_LAS unsigned char* lds, const Gemm g, const Sched& S, const Epi& E, int tid_in) {
    int tid_ = tid_in; asm volatile("" : "+v"(tid_));
    const int tid = tid_, wid = __builtin_amdgcn_readfirstlane(tid >> 6), lane = tid & 63, wr = wid >> 2, wc = wid & 3, fr = lane & 15, fq = lane >> 4;
    const int K = g.K, nt = K / BK;
    unsigned voffA[2], voffB[2];
#pragma unroll
    for (int i = 0; i < 2; ++i) { int R, C; stage_rc(tid * 16 + i * 8192, R, C); const int Rb = Epi::PERM ? ((R & ~31) + perm32(R & 31)) : R;
        voffA[i] = (unsigned)(R * K + C) * 2u; voffB[i] = (unsigned)(Rb * K + C) * 2u; }
    const size_t kstep = (size_t)(BK * 2);
    const size_t hstep = (size_t)HALF * K * 2;
    const size_t tstep = 2 * hstep;
    const unsigned ldsw = (unsigned)wid * 1024u;
    const int aoff = lds_byte(wr * 64 + fr, fq * 8), boff = lds_byte(wc * 32 + fr, fq * 8);
#define PG8_SA(b, h) (((b) * 2 + (h)) * HTB)
#define PG8_SB(b, h) ((4 + (b) * 2 + (h)) * HTB)
#define PG8_STAGE(bufoff, gbase, voff) do { _Pragma("unroll") for (int _i = 0; _i < 2; ++_i) \
        __builtin_amdgcn_global_load_lds((const unsigned*)((const char*)(gbase) + (voff)[_i]), (PG8_LAS unsigned*)(lds + (bufoff) + ldsw + _i * 8192), 16, 0, 0); } while (0)
#define PG8_LDA(dst, b, h) do { _Pragma("unroll") for (int m = 0; m < 4; ++m) _Pragma("unroll") for (int k = 0; k < 2; ++k) dst[m][k] = *(const PG8_LAS bf16x8*)(lds + PG8_SA(b, h) + aoff + m * 2048 + k * 1024); } while (0)
#define PG8_LDB(dst, b, h) do { _Pragma("unroll") for (int n = 0; n < 2; ++n) _Pragma("unroll") for (int k = 0; k < 2; ++k) dst[n][k] = *(const PG8_LAS bf16x8*)(lds + PG8_SB(b, h) + boff + n * 2048 + k * 1024); } while (0)
#define PG8_MMA(ai, bj, At, Bt) do { __builtin_amdgcn_s_setprio(1); _Pragma("unroll") for (int m = 0; m < 4; ++m) _Pragma("unroll") for (int n = 0; n < 2; ++n) _Pragma("unroll") for (int k = 0; k < 2; ++k) \
        acc[ai][bj][m][n] = __builtin_amdgcn_mfma_f32_16x16x32_bf16(Bt[n][k], At[m][k], acc[ai][bj][m][n], 0, 0, 0); __builtin_amdgcn_s_setprio(0); } while (0)
#define PG8_WAIT_V(n) asm volatile("s_waitcnt vmcnt(" #n ")" ::: "memory")
#define PG8_WAIT_L(n) asm volatile("s_waitcnt lgkmcnt(" #n ")" ::: "memory")
#define PG8_BAR __builtin_amdgcn_s_barrier()
#define PG8_SCHED __builtin_amdgcn_sched_barrier(0)
    Unit cur, nxt; int ui = 0;
    if (!S.next(0, cur)) return;
    f32x4 acc[2][2][4][2];
#pragma unroll
    for (int a = 0; a < 2; ++a)
#pragma unroll
        for (int b = 0; b < 2; ++b)
#pragma unroll
            for (int m = 0; m < 4; ++m)
#pragma unroll
                for (int n = 0; n < 2; ++n) acc[a][b][m][n] = (f32x4){0.f, 0.f, 0.f, 0.f};
    bf16x8 At[4][2], B0[2][2], B1[2][2];
    const char* cA = (const char*)g.A + (size_t)cur.pm * tstep; const char* cB = (const char*)g.Bt + (size_t)cur.pn * tstep;
    S.a_ready(cur);
    if constexpr (SP2) {
        PG8_STAGE(PG8_SB(0, 0), cB, voffB); PG8_STAGE(PG8_SB(0, 1), cB + hstep, voffB); PG8_STAGE(PG8_SA(0, 0), cA, voffA); PG8_STAGE(PG8_SA(0, 1), cA + hstep, voffA);
        if (wr == 1) PG8_BAR;
        PG8_WAIT_V(2); PG8_BAR;
        PG8_STAGE(PG8_SB(1, 0), cB + kstep, voffB); PG8_STAGE(PG8_SA(1, 0), cA + kstep, voffA); PG8_STAGE(PG8_SB(1, 1), cB + hstep + kstep, voffB);
        PG8_WAIT_V(6); PG8_BAR;
    } else {
        PG8_STAGE(PG8_SB(0, 0), cB, voffB); PG8_STAGE(PG8_SA(0, 0), cA, voffA); PG8_STAGE(PG8_SB(0, 1), cB + hstep, voffB); PG8_STAGE(PG8_SA(0, 1), cA + hstep, voffA);
        if (wr == 1) PG8_BAR;
        PG8_WAIT_V(4); PG8_BAR;
        PG8_STAGE(PG8_SB(1, 0), cB + kstep, voffB); PG8_STAGE(PG8_SA(1, 0), cA + kstep, voffA); PG8_STAGE(PG8_SB(1, 1), cB + hstep + kstep, voffB);
        PG8_WAIT_V(6); PG8_BAR;
    }
    for (;;) {
        const bool has_next = S.next(ui + 1, nxt);
        const char* nA = has_next ? (const char*)g.A + (size_t)nxt.pm * tstep : cA; const char* nB = has_next ? (const char*)g.Bt + (size_t)nxt.pn * tstep : cB;
        for (int t = 0; t < nt; t += 2) {
            const bool last = (t == nt - 2);
            const char* a1 = cA + (size_t)(t + 1) * kstep;
            const char* a2 = last ? nA : cA + (size_t)(t + 2) * kstep; const char* b2 = last ? nB : cB + (size_t)(t + 2) * kstep;
            const char* a3 = a2 + kstep; const char* b3 = b2 + kstep;
            if (last && has_next) S.a_ready(nxt);
            if constexpr (SP2) {
            PG8_LDB(B0, 0, 0); PG8_LDB(B1, 0, 1); PG8_SCHED; PG8_LDA(At, 0, 0); PG8_STAGE(PG8_SA(1, 1), a1 + hstep, voffA);
            PG8_WAIT_V(8); PG8_WAIT_L(0); PG8_BAR; PG8_MMA(0, 0, At, B0); PG8_MMA(0, 1, At, B1); PG8_BAR; PG8_SCHED;
            PG8_LDA(At, 0, 1); PG8_STAGE(PG8_SB(0, 0), b2, voffB); PG8_STAGE(PG8_SB(0, 1), b2 + hstep, voffB); PG8_STAGE(PG8_SA(0, 0), a2, voffA);
            PG8_WAIT_V(8); PG8_WAIT_L(0); PG8_BAR; PG8_MMA(1, 0, At, B0); PG8_MMA(1, 1, At, B1); PG8_BAR; PG8_SCHED;
            PG8_LDB(B0, 1, 0); PG8_LDB(B1, 1, 1); PG8_SCHED; PG8_LDA(At, 1, 0); PG8_STAGE(PG8_SA(0, 1), a2 + hstep, voffA);
            PG8_WAIT_V(8); PG8_WAIT_L(0); PG8_BAR; PG8_MMA(0, 0, At, B0); PG8_MMA(0, 1, At, B1); PG8_BAR; PG8_SCHED;
            PG8_LDA(At, 1, 1); PG8_STAGE(PG8_SB(1, 0), b3, voffB); PG8_STAGE(PG8_SB(1, 1), b3 + hstep, voffB); PG8_STAGE(PG8_SA(1, 0), a3, voffA);
            PG8_WAIT_V(8); PG8_WAIT_L(0); PG8_BAR; PG8_MMA(1, 0, At, B0); PG8_MMA(1, 1, At, B1); PG8_BAR; PG8_SCHED;
            } else {
            PG8_LDB(B0, 0, 0); PG8_SCHED; PG8_LDA(At, 0, 0); PG8_STAGE(PG8_SA(1, 1), a1 + hstep, voffA);
            PG8_WAIT_L(8); PG8_BAR; PG8_WAIT_L(0); PG8_MMA(0, 0, At, B0); PG8_BAR; PG8_SCHED;
            PG8_LDB(B1, 0, 1); PG8_STAGE(PG8_SB(0, 0), b2, voffB);
            PG8_BAR; PG8_WAIT_L(0); PG8_MMA(0, 1, At, B1); PG8_BAR;
            PG8_LDA(At, 0, 1); PG8_STAGE(PG8_SA(0, 0), a2, voffA);
            PG8_BAR; PG8_WAIT_L(0); PG8_MMA(1, 0, At, B0); PG8_BAR; PG8_SCHED;
            PG8_STAGE(PG8_SB(0, 1), b2 + hstep, voffB);
            PG8_WAIT_V(6); PG8_BAR; PG8_MMA(1, 1, At, B1); PG8_BAR;
            PG8_LDB(B0, 1, 0); PG8_SCHED; PG8_LDA(At, 1, 0); PG8_STAGE(PG8_SA(0, 1), a2 + hstep, voffA);
            PG8_WAIT_L(8); PG8_BAR; PG8_WAIT_L(0); PG8_MMA(0, 0, At, B0); PG8_BAR; PG8_SCHED;
            PG8_LDB(B1, 1, 1); PG8_STAGE(PG8_SB(1, 0), b3, voffB);
            PG8_BAR; PG8_WAIT_L(0); PG8_MMA(0, 1, At, B1); PG8_BAR;
            PG8_LDA(At, 1, 1); PG8_STAGE(PG8_SA(1, 0), a3, voffA);
            PG8_BAR; PG8_WAIT_L(0); PG8_MMA(1, 0, At, B0); PG8_BAR; PG8_SCHED;
            PG8_STAGE(PG8_SB(1, 1), b3 + hstep, voffB);
            PG8_WAIT_V(6); PG8_BAR; PG8_MMA(1, 1, At, B1); PG8_BAR;
            }
        }
        if constexpr (ALIGN_EPI) { if (wr == 0) PG8_BAR; }
        if constexpr (!Epi::AFTER_DRAIN) { E(acc, cur, wr, wc, fr, fq); S.done(cur); }
        if (!has_next) break;
#pragma unroll
        for (int a = 0; a < 2; ++a)
#pragma unroll
            for (int b = 0; b < 2; ++b)
#pragma unroll
                for (int m = 0; m < 4; ++m)
#pragma unroll
                    for (int n = 0; n < 2; ++n) acc[a][b][m][n] = (f32x4){0.f, 0.f, 0.f, 0.f};
        cur = nxt; cA = nA; cB = nB; ++ui;
        if constexpr (ALIGN_EPI) { if (wr == 1) PG8_BAR; }
    }
    PG8_WAIT_V(0);
    if constexpr (!ALIGN_EPI) { if (wr == 0) PG8_BAR; }
    PG8_BAR;
    if constexpr (Epi::AFTER_DRAIN) { E.fused(acc, cur, wr, wc, fr, fq, lds, wid, lane); S.done(cur); }
#undef PG8_SA
#undef PG8_SB
#undef PG8_STAGE
#undef PG8_LDA
#undef PG8_LDB
#undef PG8_MMA
#undef PG8_WAIT_V
#undef PG8_WAIT_L
#undef PG8_BAR
#undef PG8_SCHED
}
}

constexpr size_t MiB = 1u << 20;
constexpr size_t WS_W = 0, W_LAYER = 40 * MiB;
constexpr size_t WO_GU1 = 0, WO_D1 = 11 * MiB, WO_IN = WO_D1 + 11 * MiB / 2, WO_OUT = WO_IN + 5 * MiB, WO_GU2 = WO_OUT + 2 * MiB, WO_D2 = WO_GU2 + 11 * MiB;
static_assert(WO_D2 + 11 * MiB / 2 == W_LAYER, "weight map");
constexpr size_t WS_XB = 160 * MiB;
constexpr size_t WS_ACT = 224 * MiB;
constexpr size_t WS_MIX = 400 * MiB;
constexpr size_t WS_ROPE = 464 * MiB;
constexpr size_t WS_SSQ = 476 * MiB;
constexpr size_t SSQ_SLOT = (size_t)MTOK * 16;
constexpr size_t WS_RGW = 474 * MiB;
constexpr size_t WS_AGG = 475 * MiB;
constexpr size_t WS_TS = 502 * MiB;
constexpr size_t WS_BAR = 504 * MiB;
constexpr size_t WS_END = 505 * MiB;
constexpr size_t PO_BYTES = (size_t)MTOK * 384 * 2;
constexpr size_t OB_PO4 = 0, OB_PO16 = PO_BYTES, OB_LSE4 = 2 * PO_BYTES, OB_LSE16 = OB_LSE4 + MiB;
static_assert(OB_LSE16 + MiB <= (size_t)MTOK * DM * 4, "partials fit the output buffer");

constexpr int LDS_BYTES = 147456;
constexpr int VROW = 144;

struct Args { const void* in[22]; float* out; unsigned char* ws; };
__device__ const float INV_TAB[32] = {1.000000000e+00f, 7.498942018e-01f, 5.623413324e-01f, 4.216965139e-01f, 3.162277639e-01f, 2.371373773e-01f, 1.778279394e-01f, 1.333521456e-01f, 1.000000015e-01f, 7.498942316e-02f, 5.623413250e-02f, 4.216964915e-02f, 3.162277490e-02f, 2.371373773e-02f, 1.778279431e-02f, 1.333521400e-02f, 9.999999776e-03f, 7.498942316e-03f, 5.623413250e-03f, 4.216964822e-03f, 3.162277630e-03f, 2.371373819e-03f, 1.778279431e-03f, 1.333521446e-03f, 1.000000047e-03f, 7.498941850e-04f, 5.623413017e-04f, 4.216965172e-04f, 3.162277571e-04f, 2.371373703e-04f, 1.778279402e-04f, 1.333521504e-04f};

#define MFMA32(a, b, c) __builtin_amdgcn_mfma_f32_32x32x16_bf16((a), (b), (c), 0, 0, 0)
__device__ __forceinline__ int crow(int reg, int h) { return (reg & 3) + 8 * (reg >> 2) + 4 * h; }

struct AttnOut { bf16_t* mix; bf16_t* po; float* lse; const bf16_t* po4; const bf16_t* po16; const float* lse4; const float* lse16; float sink; };

__device__ __forceinline__ void store_row16(bf16_t* rowp  , const u32x2 (&wv)[4], int kh) {
#pragma unroll
    for (int gp = 0; gp < 2; ++gp) {
        const u32x2 keep = kh ? wv[2 * gp + 1] : wv[2 * gp], send = kh ? wv[2 * gp] : wv[2 * gp + 1];
        u32x2 recv; recv.x = (unsigned)__shfl_xor((int)send.x, 32); recv.y = (unsigned)__shfl_xor((int)send.y, 32);
        u32x4 w; if (kh) { w.x = recv.x; w.y = recv.y; w.z = keep.x; w.w = keep.y; } else { w.x = keep.x; w.y = keep.y; w.z = recv.x; w.w = recv.y; }
        *(u32x4*)(rowp + 8 * (2 * gp + kh)) = w;
    }
}
template <int MODE>
__device__ __forceinline__ void attn_finish(const f32x16& O0, const f32x16& O1, float m2, float lsum, int tok, int ocol, int hidx, int kh, const AttnOut& AO) {
    const float l = lsum + __shfl_xor(lsum, 32);
    const float lse = (m2 + __log2f(l)) * 0.6931471805599453f;
    const float rl = fast_rcp(l);
    if (MODE == 0) {
        const float gate = fast_rcp(1.0f + __expf(AO.sink - lse)) * rl;
        bf16_t* op = AO.mix + (size_t)tok * DM + ocol;
        u32x2 w0[4], w1[4];
#pragma unroll
        for (int g = 0; g < 4; ++g) {
            w0[g].x = pk2(O0[4 * g] * gate, O0[4 * g + 1] * gate); w0[g].y = pk2(O0[4 * g + 2] * gate, O0[4 * g + 3] * gate);
            w1[g].x = pk2(O1[4 * g] * gate, O1[4 * g + 1] * gate); w1[g].y = pk2(O1[4 * g + 2] * gate, O1[4 * g + 3] * gate);
        }
        store_row16(op, w0, kh); store_row16(op + 32, w1, kh);
    } else if (MODE == 1) {
        bf16_t* op = AO.po + (size_t)tok * 384 + hidx * 64;
        u32x2 w0[4], w1[4];
#pragma unroll
        for (int g = 0; g < 4; ++g) {
            w0[g].x = pk2(O0[4 * g] * rl, O0[4 * g + 1] * rl); w0[g].y = pk2(O0[4 * g + 2] * rl, O0[4 * g + 3] * rl);
            w1[g].x = pk2(O1[4 * g] * rl, O1[4 * g + 1] * rl); w1[g].y = pk2(O1[4 * g + 2] * rl, O1[4 * g + 3] * rl);
        }
        store_row16(op, w0, kh); store_row16(op + 32, w1, kh);
        if (kh == 0) AO.lse[(size_t)tok * 6 + hidx] = lse;
    } else {
        const float l4 = AO.lse4[(size_t)tok * 6 + hidx], l16 = AO.lse16[(size_t)tok * 6 + hidx];
        const float mxl = fmaxf(lse, fmaxf(l4, l16));
        float w1 = __expf(lse - mxl), w4 = __expf(l4 - mxl), w16 = __expf(l16 - mxl);
        const float rs = fast_rcp(w1 + w4 + w16);
        w1 *= rs * rl; w4 *= rs; w16 *= rs;
        const bf16_t* p4 = AO.po4 + (size_t)tok * 384 + hidx * 64 + 4 * kh;
        const bf16_t* p16 = AO.po16 + (size_t)tok * 384 + hidx * 64 + 4 * kh;
        bf16_t* op = AO.mix + (size_t)tok * DM + ocol;
        u32x2 wq[2][4];
#pragma unroll
        for (int g = 0; g < 4; ++g) {
#pragma unroll
            for (int mt = 0; mt < 2; ++mt) {
                const u32x2 a = *(const u32x2*)(p4 + 32 * mt + 8 * g), b = *(const u32x2*)(p16 + 32 * mt + 8 * g);
                float o[4];
#pragma unroll
                for (int e = 0; e < 4; ++e) o[e] = (mt ? O1[4 * g + e] : O0[4 * g + e]) * w1;
                o[0] += bflo(a.x) * w4 + bflo(b.x) * w16; o[1] += bfhi(a.x) * w4 + bfhi(b.x) * w16;
                o[2] += bflo(a.y) * w4 + bflo(b.y) * w16; o[3] += bfhi(a.y) * w4 + bfhi(b.y) * w16;
                wq[mt][g].x = pk2(o[0], o[1]); wq[mt][g].y = pk2(o[2], o[3]);
            }
        }
        store_row16(op, wq[0], kh); store_row16(op + 32, wq[1], kh);
    }
}

struct AttnGeom { int tokb, dil, u0, qcol, kcol, vcol, ocol, hidx, maxd, mode; bool perm; float sink; bf16_t* po; float* lse; };
constexpr int KV_ROWS = 384, VIMG_OFF = KV_ROWS * VROW;

__device__ __forceinline__ void kv_fetch(const bf16_t* __restrict__ P, const AttnGeom& G, int tid, bf16x8 (&kv)[12], bf16x8 (&qn)[4], int wave, int lane) {
    const int piece = tid & 7, rb = tid >> 3;
#pragma unroll
    for (int i = 0; i < 12; ++i) {
        const int row = rb + 64 * (i % 6), u = G.u0 - 128 + row;
        if (u >= 0) kv[i] = *(const bf16x8*)(P + p_off((i < 6 ? G.kcol : G.vcol) >> 6, G.perm, G.tokb + G.dil * u) + 8 * piece);
    }
    const bf16_t* qp = P + p_off(G.qcol >> 6, G.perm, G.tokb + G.dil * (G.u0 + 32 * wave + (lane & 31))) + 8 * (lane >> 5);
#pragma unroll
    for (int ks = 0; ks < 4; ++ks) qn[ks] = *(const bf16x8*)(qp + 16 * ks);
}
__device__ __forceinline__ void kv_store(LAS unsigned char* lds, int tid, const bf16x8 (&kv)[12]) {
    const int piece = tid & 7, rb = tid >> 3;
#pragma unroll
    for (int i = 0; i < 12; ++i) *(LAS bf16x8*)(lds + (i < 6 ? 0 : VIMG_OFF) + (rb + 64 * (i % 6)) * VROW + 16 * piece) = kv[i];
}

__device__ __forceinline__ void attn_wave(LAS unsigned char* lds, const AttnGeom& G, const bf16x8 (&qf)[4], int wave, int lane, const AttnOut& AO0) {
    const int r = lane & 31, kh = lane >> 5;
    const int u0w = G.u0 + 32 * wave;
    f32x16 O0, O1;
#pragma unroll
    for (int j = 0; j < 16; ++j) { O0[j] = 0.f; O1[j] = 0.f; }
    float m2 = -INFINITY, lsum = 0.f;
    const int trlane = ((4 * kh + ((lane & 15) >> 2)) * VROW + 32 * ((lane >> 4) & 1) + 8 * (lane & 3));
    for (int kt = (u0w >= 128 ? 0 : (128 - u0w) >> 5); kt < 5; ++kt) {
        const int ks0 = u0w - 128 + 32 * kt, lrow0 = 32 * wave + 32 * kt;
        bf16x8 kf[4];
        { const LAS unsigned char* kp = lds + (lrow0 + r) * VROW + 16 * kh;
#pragma unroll
          for (int ks = 0; ks < 4; ++ks) kf[ks] = *(const LAS bf16x8*)(kp + 32 * ks); }
        f32x16 S;
#pragma unroll
        for (int j = 0; j < 16; ++j) S[j] = 0.f;
#pragma unroll
        for (int ks = 0; ks < 4; ++ks) S = MFMA32(kf[ks], qf[ks], S);
        if (kt == 0 || kt == 4) {
            const int uq = u0w + r;
#pragma unroll
            for (int j = 0; j < 16; ++j) { const int diff = uq - (ks0 + crow(j, kh)); if (diff < 0 || diff > G.maxd) S[j] = -INFINITY; }
        }
        float mx = S[0];
#pragma unroll
        for (int j = 1; j < 16; ++j) mx = fmaxf(mx, S[j]);
        mx = fmaxf(mx, __shfl_xor(mx, 32));
        const float mnew = fmaxf(m2, mx);
        const float msafe = (mnew == -INFINITY) ? 0.f : mnew;
        const float alpha = fast_exp2(m2 - msafe);
        m2 = mnew;
        float ps = 0.f;
#pragma unroll
        for (int j = 0; j < 16; ++j) { S[j] = fast_exp2(S[j] - msafe); ps += S[j]; }
        lsum = lsum * alpha + ps;
#pragma unroll
        for (int j = 0; j < 16; ++j) { O0[j] *= alpha; O1[j] *= alpha; }
        bf16x8 pf[2];
#pragma unroll
        for (int s = 0; s < 2; ++s) { u32x4 w; w.x = pk2(S[8 * s], S[8 * s + 1]); w.y = pk2(S[8 * s + 2], S[8 * s + 3]); w.z = pk2(S[8 * s + 4], S[8 * s + 5]); w.w = pk2(S[8 * s + 6], S[8 * s + 7]); pf[s] = __builtin_bit_cast(bf16x8, w); }
        LAS s16x4* vt = (LAS s16x4*)(lds + VIMG_OFF + lrow0 * VROW + trlane);
#define TRR(BYTES) __builtin_amdgcn_ds_read_tr16_b64_v4i16(vt + (BYTES) / 8)
        const bf16x8 v00 = __builtin_shufflevector(TRR(0), TRR(1152), 0, 1, 2, 3, 4, 5, 6, 7), v01 = __builtin_shufflevector(TRR(2304), TRR(3456), 0, 1, 2, 3, 4, 5, 6, 7);
        const bf16x8 v10 = __builtin_shufflevector(TRR(64), TRR(1216), 0, 1, 2, 3, 4, 5, 6, 7), v11 = __builtin_shufflevector(TRR(2368), TRR(3520), 0, 1, 2, 3, 4, 5, 6, 7);
#undef TRR
        O0 = MFMA32(v00, pf[0], O0); O0 = MFMA32(v01, pf[1], O0);
        O1 = MFMA32(v10, pf[0], O1); O1 = MFMA32(v11, pf[1], O1);
    }
    AttnOut AO = AO0; AO.sink = G.sink; AO.po = G.po; AO.lse = G.lse;
    const int tok = G.tokb + G.dil * (u0w + r);
    if (G.mode == 0) attn_finish<0>(O0, O1, m2, lsum, tok, G.ocol, G.hidx, kh, AO);
    else if (G.mode == 1) attn_finish<1>(O0, O1, m2, lsum, tok, G.ocol, G.hidx, kh, AO);
    else attn_finish<2>(O0, O1, m2, lsum, tok, G.ocol, G.hidx, kh, AO);
}

struct RgParams { const bf16_t* P; const int* pos; const float* conv_w; const float* conv_b; const bf16_t* wrT; const bf16_t* wiT; const float* b_r; const float* b_i; const float* lam; float* agg; bf16_t* mix; };

template <bool FINAL>
__device__ __forceinline__ void rglru_item(const RgParams& R, int sc, int h, int nt, int lane, LAS unsigned char* yimg) {
    const int r = lane & 31, kh = lane >> 5;
    const int tok_sc = sc * 128, bstart = (sc >> 7) * 128;
    const int ncol = 32 * nt + r, cg = 64 * h + ncol;
    const float br = R.b_r[cg], bi = R.b_i[cg], sp8l = -8.0f * 1.4426950408889634f * log1pf(expf(-R.lam[cg]));
    float carry = 0.f, atot = 1.f;
    if (FINAL) {
        const float* ag = R.agg + (size_t)cg * 2; int s = bstart;
        for (; s + 8 <= sc; s += 8) {
            f32x2 ab[8];
#pragma unroll
            for (int i = 0; i < 8; ++i) ab[i] = *(const f32x2*)(ag + (size_t)(s + i) * 768);
#pragma unroll
            for (int i = 0; i < 8; ++i) carry = ab[i].x * carry + ab[i].y;
        }
        for (; s < sc; ++s) { const f32x2 ab = *(const f32x2*)(ag + (size_t)s * 768); carry = ab.x * carry + ab.y; }
    }
    const int cc = 64 * h + lane;
    const float cw0 = R.conv_w[cc], cw1 = R.conv_w[384 + cc], cw2 = R.conv_w[768 + cc], cw3 = R.conv_w[1152 + cc], cb = R.conv_b[cc];
    unsigned short xr[32];
    const unsigned goff = (unsigned)(4 * kh * 64 + ncol);
    float xm1 = 0.f, xm2 = 0.f, xm3 = 0.f;
    { const bf16_t* xp = R.P + p_off(PC_XC / 64 + h, false, tok_sc);
      if ((tok_sc & (SEQ - 1)) != 0) { xm1 = bf2f((xp - 1 * 64)[lane]); xm2 = bf2f((xp - 2 * 64)[lane]); xm3 = bf2f((xp - 3 * 64)[lane]); }
#pragma unroll
      for (int t = 0; t < 32; ++t) xr[t] = (xp + (size_t)t * 64)[lane]; }
    for (int mt = 0; mt < 4; ++mt) {
        const int t0 = tok_sc + 32 * mt;
        bf16x8 yf[4];
        {
#pragma unroll
          for (int t = 0; t < 32; ++t) {
              const float x0 = bf2f(xr[t]);
              const float y = cb + cw0 * x0 + cw1 * xm1 + cw2 * xm2 + cw3 * xm3;
              *(LAS bf16_t*)(yimg + t * VROW + 2 * lane) = (bf16_t)(pk2(y, 0.f) & 0xffffu);
              xm3 = xm2; xm2 = xm1; xm1 = x0;
          }
          if (mt < 3) { const bf16_t* xp = R.P + p_off(PC_XC / 64 + h, false, t0 + 32);
#pragma unroll
              for (int t = 0; t < 32; ++t) xr[t] = (xp + (size_t)t * 64)[lane]; }
#pragma unroll
          for (int ks = 0; ks < 4; ++ks) yf[ks] = *(const LAS bf16x8*)(yimg + r * VROW + 32 * ks + 16 * kh);
        }
        unsigned short graw[16];
        if (FINAL) {
#pragma unroll
            for (int j = 0; j < 16; ++j) graw[j] = (R.P + p_off(PC_GC / 64 + h, false, t0 + (j & 3) + 8 * (j >> 2)))[goff];
        }
        unsigned rmask = 0u;
#pragma unroll
        for (int g = 0; g < 4; ++g) { const int4 p4 = *(const int4*)(R.pos + t0 + 8 * g + 4 * kh);
            rmask |= (p4.x == 0 ? 1u : 0u) << (4 * g); rmask |= (p4.y == 0 ? 1u : 0u) << (4 * g + 1); rmask |= (p4.z == 0 ? 1u : 0u) << (4 * g + 2); rmask |= (p4.w == 0 ? 1u : 0u) << (4 * g + 3); }
        f32x16 ra, ia, ya;
#pragma unroll
        for (int j = 0; j < 16; ++j) { ra[j] = 0.f; ia[j] = 0.f; ya[j] = 0.f; }
        int ncl = ncol; asm volatile("" : "+v"(ncl));
#pragma unroll
        for (int ks = 0; ks < 4; ++ks) {
            const size_t wo = ((size_t)h * 64 + ncl) * 64 + 16 * ks + 8 * kh;
            const bf16x8 wrf = *(const bf16x8*)(R.wrT + wo), wif = *(const bf16x8*)(R.wiT + wo);
            bf16x8 idf;
#pragma unroll
            for (int i = 0; i < 8; ++i) idf[i] = (16 * ks + 8 * kh + i == ncl) ? (short)0x3f80 : (short)0;
            ra = MFMA32(yf[ks], wrf, ra); ia = MFMA32(yf[ks], wif, ia); ya = MFMA32(yf[ks], idf, ya);
        }
        float av[16], bv[16];
#pragma unroll
        for (int j = 0; j < 16; ++j) {
            const float rr = sigmoidf_(ra[j] + br), ii = sigmoidf_(ia[j] + bi);
            const float a_ = fast_exp2(sp8l * rr);
            float a = a_, mult = __builtin_amdgcn_sqrtf(1.0f - a_ * a_);
            if ((rmask >> j) & 1u) { a = 0.f; mult = 1.f; }
            av[j] = a; bv[j] = mult * ii * ya[j];
        }
        float sa[4], sb[4], pa[4], pb[4];
#pragma unroll
        for (int g = 0; g < 4; ++g) {
            sa[g] = (av[4 * g] * av[4 * g + 1]) * (av[4 * g + 2] * av[4 * g + 3]);
            sb[g] = ((bv[4 * g] * av[4 * g + 1] + bv[4 * g + 1]) * av[4 * g + 2] + bv[4 * g + 2]) * av[4 * g + 3] + bv[4 * g + 3];
            pa[g] = __shfl_xor(sa[g], 32); pb[g] = __shfl_xor(sb[g], 32);
        }
        float c = carry, cin[4], apr = 1.f;
#pragma unroll
        for (int g = 0; g < 4; ++g) {
            const float a0 = kh ? pa[g] : sa[g], b0 = kh ? pb[g] : sb[g], a1 = kh ? sa[g] : pa[g], b1 = kh ? sb[g] : pb[g];
            const float ce = c; c = a0 * c + b0;
            const float co = c; c = a1 * c + b1;
            cin[g] = kh ? co : ce; apr *= a0 * a1;
        }
        carry = c; atot *= apr;
        if (FINAL) {
#pragma unroll
            for (int g = 0; g < 4; ++g) {
                float hp = cin[g];
#pragma unroll
                for (int e = 0; e < 4; ++e) {
                    const int j = 4 * g + e, tok = t0 + crow(j, kh);
                    hp = av[j] * hp + bv[j];
                    const float gt = bf2f(graw[j]);
                    const float z = 0.7978845608028654f * (gt + 0.044715f * gt * gt * gt);
                    const float th = 1.0f - 2.0f * fast_rcp(__expf(2.0f * z) + 1.0f);
                    const float o = hp * 0.5f * gt * (1.0f + th);
                    *(LAS bf16_t*)(yimg + 4608 + crow(j, kh) * 80 + 2 * r) = (bf16_t)(pk2(o, 0.f) & 0xffffu);
                    (void)tok;
                }
            }
#pragma unroll
            for (int q = 0; q < 2; ++q) {
                const int p = lane + 64 * q, tk = p >> 2, qu = p & 3;
                const u32x4 w = *(const LAS u32x4*)(yimg + 4608 + tk * 80 + 16 * qu);
                *(u32x4*)(R.mix + (size_t)(t0 + tk) * DM + 640 + 64 * h + 32 * nt + 8 * qu) = w;
            }
        }
    }
    if (!FINAL && kh == 0) { f32x2 ab = {atot, carry}; *(f32x2*)(R.agg + ((size_t)sc * 384 + cg) * 2) = ab; }
}

struct MapPlain { const float* w; int ld; __device__ __forceinline__ const float* operator()(int R) const { return w + R; } };
struct MapGU { const float* gate; const float* up; int ld;
    __device__ __forceinline__ const float* operator()(int R) const { const int j = 128 * (R >> 8) + (R & 127); const uintptr_t a = (uintptr_t)gate, b = (uintptr_t)up, sel = (uintptr_t)0 - (uintptr_t)((R >> 7) & 1); return (const float*)(a ^ ((a ^ b) & sel)) + j; } };
struct MapIN { const float* w; int ld;
    __device__ __forceinline__ const float* operator()(int R) const {
        int c = R;
        if (R < PC_VA || (R >= PC_QB && R < PC_VB)) { const int q = R & 63; c = (R & ~63) + 32 * ((q >> 2) & 1) + 16 * ((q >> 5) & 1) + 4 * ((q >> 3) & 3) + (q & 3); }
        if (c >= 1664 && c < PC_XC) return nullptr;
        if (c >= PC_XC) c -= 128;
        return w + c; } };

template <class Map>
__device__ __forceinline__ void transpose_item(const Map mp, int K, int N, bf16_t* WT, const float* gain, LAS float* scr, int item, int lane) {
    const int nblk = N / 32, kb = item / nblk, nb = item % nblk, k0 = 64 * kb, n0 = 32 * nb;
    const float* src = mp(n0 + (lane & 31));
    float v[32];
#pragma unroll
    for (int i = 0; i < 32; ++i) { const int kk = 2 * i + (lane >> 5); v[i] = src ? src[(size_t)(k0 + kk) * mp.ld] : 0.f; }
#pragma unroll
    for (int i = 0; i < 32; ++i) { const int kk = 2 * i + (lane >> 5); float t = v[i]; if (gain) t *= gain[k0 + kk]; scr[kk * 33 + (lane & 31)] = t; }
    asm volatile("s_waitcnt lgkmcnt(0)" ::: "memory");
    const int c = lane & 7;
#pragma unroll
    for (int j = 0; j < 4; ++j) { const int n = (lane >> 3) + 8 * j; const LAS float* s = scr + (8 * c) * 33 + n;
        u32x4 o; o.x = pk2(s[0 * 33], s[1 * 33]); o.y = pk2(s[2 * 33], s[3 * 33]); o.z = pk2(s[4 * 33], s[5 * 33]); o.w = pk2(s[6 * 33], s[7 * 33]);
        *(u32x4*)(WT + (size_t)(n0 + n) * K + k0 + 8 * c) = o; }
    asm volatile("s_waitcnt lgkmcnt(0)" ::: "memory");
}

__device__ __forceinline__ float wave_sum(float v) {
#pragma unroll
    for (int o = 1; o < 64; o <<= 1) v += __shfl_xor(v, o);
    return v;
}

__device__ __forceinline__ void sincos_d(double a, float& c, float& s) {
    const double n = rint(a * 0.6366197723675814);
    double t = fma(-n, 1.5707963267948966, a); t = fma(-n, 6.123233995736766e-17, t);
    const double t2 = t * t;
    double sp = -1.0 / 1307674368000.0; sp = sp * t2 + 1.0 / 6227020800.0; sp = sp * t2 - 1.0 / 39916800.0; sp = sp * t2 + 1.0 / 362880.0; sp = sp * t2 - 1.0 / 5040.0; sp = sp * t2 + 1.0 / 120.0; sp = sp * t2 - 1.0 / 6.0; sp = sp * t2 + 1.0;
    const double sn = sp * t;
    double cp = 1.0 / 20922789888000.0; cp = cp * t2 - 1.0 / 87178291200.0; cp = cp * t2 + 1.0 / 479001600.0; cp = cp * t2 - 1.0 / 3628800.0; cp = cp * t2 + 1.0 / 40320.0; cp = cp * t2 - 1.0 / 720.0; cp = cp * t2 + 1.0 / 24.0; cp = cp * t2 - 0.5; cp = cp * t2 + 1.0;
    const int q = (int)((long long)n & 3);
    const double cc = (q == 0) ? cp : (q == 1) ? -sn : (q == 2) ? -cp : sn;
    const double ss = (q == 0) ? sn : (q == 1) ? cp : (q == 2) ? -sn : -cp;
    c = (float)cc; s = (float)ss;
}

typedef const __attribute__((address_space(4))) Args* KArgs;
__device__ __forceinline__ KArgs kargs() { KArgs p = (KArgs)__builtin_amdgcn_kernarg_segment_ptr(); asm volatile("" : "+s"(p)); return p; }
#define IN_F(k) ((const float*)ap->in[k])
__device__ __forceinline__ int fresh_tid(int wave0) { int t = wave0 * 64 + (int)__builtin_amdgcn_mbcnt_hi(~0u, __builtin_amdgcn_mbcnt_lo(~0u, 0u)); asm volatile("" : "+v"(t)); return t; }

template <int WHICH>
__device__ __forceinline__ void gemm_stage(LAS unsigned char* lds, int l, int ffn, int wave0) {
    KArgs ap = kargs();
    unsigned char* ws = ap->ws; const int G = gridDim.x;
    unsigned char* wl = ws + WS_W + (size_t)l * W_LAYER;
    bf16_t* XB = (bf16_t*)(ws + WS_XB); bf16_t* ACT = (bf16_t*)(ws + WS_ACT); float* ssq0 = (float*)(ws + WS_SSQ) + (size_t)(3 * l) * SSQ_SLOT;
    if (WHICH == 0) {
        pg8::Gemm g{XB, (const bf16_t*)(wl + (ffn ? WO_GU2 : WO_GU1)), MTOK, NGU, DM}; pg8::StaticOrder S; S.init(MTOK, NGU, G, (int)blockIdx.x);
        pg8::EpiGateUp E{ssq0 + (ffn ? 2 * SSQ_SLOT : 0), ACT};
        pg8::gemm_phase<pg8::EpiGateUp, pg8::StaticOrder, true, true>(lds, g, S, E, fresh_tid(wave0));
    } else if (WHICH == 1) {
        pg8::Gemm g{ACT, (const bf16_t*)(wl + (ffn ? WO_D2 : WO_D1)), MTOK, DM, FF}; pg8::StaticOrder S; S.init(MTOK, DM, G, (int)blockIdx.x);
        pg8::EpiResidual E{XB, ssq0 + (ffn ? 3 * SSQ_SLOT : SSQ_SLOT), 0.5f};
        pg8::gemm_phase<pg8::EpiResidual, pg8::StaticOrder, true, true>(lds, g, S, E, fresh_tid(wave0));
    } else if (WHICH == 2) {
        float* cosT = (float*)(ws + WS_ROPE);
        pg8::Gemm g{XB, (const bf16_t*)(wl + WO_IN), MTOK, NIN, DM}; pg8::StaticOrder S; S.init(MTOK, NIN, G, (int)blockIdx.x);
        pg8::EpiProj E{ssq0 + SSQ_SLOT, cosT, cosT + (size_t)MTOK * 32, ACT};
        pg8::gemm_phase<pg8::EpiProj, pg8::StaticOrder, true, true>(lds, g, S, E, fresh_tid(wave0));
    } else {
        pg8::Gemm g{(const bf16_t*)(ws + WS_MIX), (const bf16_t*)(wl + WO_OUT), MTOK, DM, DM}; pg8::StaticOrder S; S.init(MTOK, DM, G, (int)blockIdx.x);
        pg8::EpiResidual E{XB, ssq0 + 2 * SSQ_SLOT, 1.0f};
        pg8::gemm_phase<pg8::EpiResidual, pg8::StaticOrder, true, true>(lds, g, S, E, fresh_tid(wave0));
    }
}

__device__ __forceinline__ void prologue_stage(LAS unsigned char* lds, int wave0) {
    KArgs ap = kargs(); const int tid = fresh_tid(wave0), lane = tid & 63, wave = __builtin_amdgcn_readfirstlane(tid >> 6);
    unsigned char* ws = ap->ws; const int G = gridDim.x, gw = blockIdx.x * 8 + wave, NGW = G * 8;
    LAS float* scr = (LAS float*)(lds + wave * 16384);
    constexpr int I_GU = (DM / 64) * (NGU / 32), I_D = (FF / 64) * (DM / 32), I_IN = (DM / 64) * (NIN / 32), I_OUT = (DM / 64) * (DM / 32);
    constexpr int I_LAYER = 2 * I_GU + 2 * I_D + I_IN + I_OUT;
    for (int it = gw; it < DEPTH * I_LAYER; it += NGW) {
        const int l = it / I_LAYER; int r = it % I_LAYER;
        unsigned char* wl = ws + WS_W + (size_t)l * W_LAYER;
        if (r < I_GU) { MapGU mp{IN_F(3) + (size_t)l * DM * FF, IN_F(4) + (size_t)l * DM * FF, FF};
            transpose_item(mp, DM, NGU, (bf16_t*)(wl + WO_GU1), IN_F(2) + l * DM, scr, r, lane); continue; } r -= I_GU;
        if (r < I_D) { MapPlain mp{IN_F(5) + (size_t)l * FF * DM, DM};
            transpose_item(mp, FF, DM, (bf16_t*)(wl + WO_D1), nullptr, scr, r, lane); continue; } r -= I_D;
        if (r < I_IN) { MapIN mp{IN_F(7) + (size_t)l * DM * INC, INC};
            transpose_item(mp, DM, NIN, (bf16_t*)(wl + WO_IN), IN_F(6) + l * DM, scr, r, lane); continue; } r -= I_IN;
        if (r < I_OUT) { MapPlain mp{IN_F(16) + (size_t)l * DM * DM, DM};
            transpose_item(mp, DM, DM, (bf16_t*)(wl + WO_OUT), nullptr, scr, r, lane); continue; } r -= I_OUT;
        if (r < I_GU) { MapGU mp{IN_F(18) + (size_t)l * DM * FF, IN_F(19) + (size_t)l * DM * FF, FF};
            transpose_item(mp, DM, NGU, (bf16_t*)(wl + WO_GU2), IN_F(17) + l * DM, scr, r, lane); continue; } r -= I_GU;
        { MapPlain mp{IN_F(20) + (size_t)l * FF * DM, DM};
            transpose_item(mp, FF, DM, (bf16_t*)(wl + WO_D2), nullptr, scr, r, lane); }
    }
    const int gt = blockIdx.x * 512 + tid, NGT = G * 512;
    { const int* positions = (const int*)ap->in[1]; float* cosT = (float*)(ws + WS_ROPE); float* sinT = cosT + (size_t)MTOK * 32;
      for (int i = gt; i < MTOK * 32; i += NGT) {
          const int tok = i >> 5, k = i & 31;
          const float ang = (float)positions[tok] * INV_TAB[k];
          float c, s; sincos_d((double)ang, c, s);
          cosT[i] = c; sinT[i] = s;
      } }
    { float* SSQ = (float*)(ws + WS_SSQ);
      const float* x_in = IN_F(0); bf16_t* XB = (bf16_t*)(ws + WS_XB);
      for (int m = gw; m < MTOK; m += NGW) {
          const f32x4* xr = (const f32x4*)(x_in + (size_t)m * DM) + lane; float s = 0.f;
          unsigned long long* o8 = (unsigned long long*)(XB + (size_t)m * DM) + lane;
#pragma unroll
          for (int j = 0; j < 4; ++j) { const f32x4 v = xr[64 * j]; s += (v.x * v.x + v.y * v.y) + (v.z * v.z + v.w * v.w);
              o8[64 * j] = (unsigned long long)pk2(v.x, v.y) | ((unsigned long long)pk2(v.z, v.w) << 32); }
          s = wave_sum(s);
          if (lane < 16) SSQ[(size_t)m * 16 + lane] = lane == 0 ? s : 0.f;
      } }
    { bf16_t* RGW = (bf16_t*)(ws + WS_RGW); const float* wr = IN_F(11); const float* wi = IN_F(13);
      for (int i = gt; i < DEPTH * 2 * 6 * 4096; i += NGT) {
          const int ii = i & 63, j = (i >> 6) & 63, h = (i >> 12) % 6, gl = i / (6 * 4096), g = gl & 1, l = gl >> 1;
          const size_t so = ((size_t)(l * 6 + h) * 64 + ii) * 64 + j;
          const float v = g ? wi[so] : wr[so];
          RGW[i] = (bf16_t)(pk2(v, 0.f) & 0xffffu);
      } }
}

template <int SUB>
__device__ __forceinline__ void mixer_rg(LAS unsigned char* lds, int l, int wave0) {
    KArgs ap = kargs(); const int tid = fresh_tid(wave0), lane = tid & 63, wave = __builtin_amdgcn_readfirstlane(tid >> 6);
    unsigned char* ws = ap->ws; const int gw = blockIdx.x * 8 + wave, NGW = gridDim.x * 8;
    bf16_t* RGW = (bf16_t*)(ws + WS_RGW);
    RgParams RP{(const bf16_t*)(ws + WS_ACT), (const int*)ap->in[1], IN_F(9) + (size_t)l * 4 * 384, IN_F(10) + l * 384,
                RGW + (size_t)(l * 2 + 0) * 6 * 4096, RGW + (size_t)(l * 2 + 1) * 6 * 4096,
                IN_F(12) + l * 384, IN_F(14) + l * 384, IN_F(15) + l * 384, (float*)(ws + WS_AGG), (bf16_t*)(ws + WS_MIX)};
    LAS unsigned char* yimg = lds + wave * 8192;
    constexpr int N_RG = 256 * 12;
    for (int it = gw; it < N_RG; it += NGW) rglru_item<SUB == 1>(RP, it / 12, (it % 12) >> 1, it & 1, lane, yimg);
}
template <int SUB>
__device__ __forceinline__ void mixer_attn(LAS unsigned char* lds, int l, int wave0) {
    KArgs ap = kargs(); const int tid = fresh_tid(wave0), lane = tid & 63, wave = __builtin_amdgcn_readfirstlane(tid >> 6);
    unsigned char* ws = ap->ws; const int G = gridDim.x;
    const bf16_t* PB = (const bf16_t*)(ws + WS_ACT);
    unsigned char* obp = (unsigned char*)ap->out;
    AttnOut AO{(bf16_t*)(ws + WS_MIX), nullptr, nullptr, (const bf16_t*)(obp + OB_PO4), (const bf16_t*)(obp + OB_PO16), (const float*)(obp + OB_LSE4), (const float*)(obp + OB_LSE16), 0.f};
    const float* sinks = IN_F(8) + l * 4;
    auto geom = [&](int j) -> AttnGeom {
        AttnGeom g; g.sink = 0.f; g.po = nullptr; g.lse = nullptr; g.ocol = 0;
        if (SUB == 0) {
            const int br = j / 768, rr = j % 768, dil = br ? 16 : 4, nblk = SEQ / dil / 256;
            const int qb = rr % nblk, rho = (rr / nblk) % dil, bh = rr / (nblk * dil), h = bh % 6, b = bh / 6;
            g.tokb = b * SEQ + rho; g.dil = dil; g.u0 = qb * 256; g.qcol = PC_QB + 64 * h; g.kcol = PC_KB + 64 * h; g.vcol = PC_VB + 64 * h; g.hidx = h; g.maxd = 128; g.mode = 1; g.perm = true;
            g.po = (bf16_t*)(obp + (br ? OB_PO16 : OB_PO4)); g.lse = (float*)(obp + (br ? OB_LSE16 : OB_LSE4));
        } else if (j < 512) {
            const int qb = j % 64, bhq = j / 64, hq = bhq % 4, b = bhq / 4, kv = hq >> 1;
            g.tokb = b * SEQ; g.dil = 1; g.u0 = qb * 256; g.qcol = PC_QA + 64 * hq; g.kcol = PC_KA + 64 * kv; g.vcol = PC_VA + 64 * kv; g.ocol = 64 * hq; g.hidx = hq; g.maxd = 127; g.mode = 0; g.perm = false;
            g.sink = sinks[hq];
        } else {
            const int rr = j - 512, qb = rr % 64, bh = rr / 64, h = bh % 6, b = bh / 6;
            g.tokb = b * SEQ; g.dil = 1; g.u0 = qb * 256; g.qcol = PC_QB + 64 * h; g.kcol = PC_KB + 64 * h; g.vcol = PC_VB + 64 * h; g.ocol = 256 + 64 * h; g.hidx = h; g.maxd = 128; g.mode = 2; g.perm = true;
        }
        return g;
    };
    constexpr int N_ATT = SUB == 0 ? 1536 : 1280;
    asm volatile("s_waitcnt lgkmcnt(0)" ::: "memory"); __builtin_amdgcn_s_barrier();
    int j = blockIdx.x; asm volatile("" : "+s"(j));
    if (j < N_ATT) {
        bf16x8 kv[12], qn[4];
        AttnGeom g = geom(j);
        kv_fetch(PB, g, tid, kv, qn, wave, lane);
        for (;;) {
            kv_store(lds, tid, kv);
            bf16x8 qf[4];
#pragma unroll
            for (int i = 0; i < 4; ++i) qf[i] = qn[i];
            asm volatile("s_waitcnt lgkmcnt(0)" ::: "memory"); __builtin_amdgcn_s_barrier(); asm volatile("" ::: "memory");
            const int jn = j + G; const bool more = jn < N_ATT;
            AttnGeom gn = g;
            if (more) { gn = geom(jn); kv_fetch(PB, gn, tid, kv, qn, wave, lane); }
            attn_wave(lds, g, qf, wave, lane, AO);
            asm volatile("" ::: "memory"); __builtin_amdgcn_s_barrier(); asm volatile("" ::: "memory");
            if (!more) break;
            g = gn; j = jn;
        }
    }
}
template <int SUB>
__device__ __forceinline__ void mixer_stage(LAS unsigned char* lds, int l, int wave0) { mixer_rg<SUB>(lds, l, wave0); mixer_attn<SUB>(lds, l, wave0); }

#define XB_TMO      128
#define XB_XCNT(j)  (256  + 64 * (j))
#define XB_XSUB(j)  (1280 + 64 * (j))
#define XB_XGEN(j)  (2304 + 64 * (j))
#define XB_TOP      3328
#define XB_TOPGEN   3392
#define XCD_BAR_WORDS 3456
#define XB_SPIN_CAP (1u << 18)

__device__ __forceinline__ unsigned xb_ld(unsigned* p)              { return __hip_atomic_load(p, __ATOMIC_RELAXED, __HIP_MEMORY_SCOPE_AGENT); }
__device__ __forceinline__ unsigned xb_add(unsigned* p, unsigned v) { return __hip_atomic_fetch_add(p, v, __ATOMIC_RELAXED, __HIP_MEMORY_SCOPE_AGENT); }
__device__ __forceinline__ unsigned xb_xcc_id() { return (unsigned)__builtin_amdgcn_s_getreg((3 << 11) | 20) & 0xFu; }
#define XB_SPIN(cond, bar) do { unsigned _sp = 0; while (cond) { __builtin_amdgcn_s_sleep(1); \
    if ((++_sp & 255u) == 0u) { if (xb_ld(&(bar)[XB_TMO])) break; if (_sp > XB_SPIN_CAP) { atomicAdd(&(bar)[XB_TMO], 1u); break; } } } } while (0)

struct XcdBarrier {
    unsigned* bar; unsigned x; bool lead;
    volatile LAS unsigned* st;
};

__device__ __forceinline__ XcdBarrier xcd_barrier_post(unsigned* bar, volatile LAS unsigned* st, bool lead) {
    XcdBarrier b; b.bar = bar; b.x = xb_xcc_id(); b.st = st; b.lead = lead;
    if (lead) (void)xb_add(&bar[XB_XCNT(b.x)], 1u);
    return b;
}
__device__ __forceinline__ void xcd_barrier_complete(unsigned* bar, unsigned x, unsigned& nloc, unsigned& nx) {
    const unsigned G = gridDim.x * gridDim.y * gridDim.z;
    unsigned sum, cnt, mine, sp = 0u;
    for (;;) {
        sum = 0u; cnt = 0u; mine = 0u;
#pragma unroll
        for (unsigned j = 0; j < 16; ++j) { const unsigned c = xb_ld(&bar[XB_XCNT(j)]); sum += c; cnt += (c > 0u) ? 1u : 0u; mine = (j == x) ? c : mine; }
        if (sum == G) break;
        __builtin_amdgcn_s_sleep(1);
        if ((++sp & 255u) == 0u) { if (xb_ld(&bar[XB_TMO])) break; if (sp > XB_SPIN_CAP) { atomicAdd(&bar[XB_TMO], 1u); break; } }
    }
    nloc = mine > 0u ? mine : 1u; nx = cnt > 0u ? cnt : 1u;
}

__device__ __forceinline__ void xcd_barrier(const XcdBarrier& b) {
    asm volatile("s_waitcnt vmcnt(0)" ::: "memory");
    __syncthreads();
    if (b.lead) {
        unsigned* bar = b.bar;
        __builtin_amdgcn_s_waitcnt(0);
        unsigned nloc = b.st[0], nx = b.st[1];
        if (nloc == 0u) { xcd_barrier_complete(bar, b.x, nloc, nx); b.st[0] = nloc; b.st[1] = nx; }
        const unsigned old = xb_add(&bar[XB_XSUB(b.x)], 1u);
        const unsigned gen = old / nloc;
        if (old + 1u == (gen + 1u) * nloc) {
            __builtin_amdgcn_fence(__ATOMIC_RELEASE, "agent");
            asm volatile("s_waitcnt vmcnt(0)" ::: "memory");
            const unsigned og = xb_add(&bar[XB_TOP], 1u);
            const unsigned tg = og / nx;
            if (og + 1u == (tg + 1u) * nx) xb_add(&bar[XB_TOPGEN], 1u);
            else XB_SPIN(xb_ld(&bar[XB_TOPGEN]) == tg, bar);
            __builtin_amdgcn_fence(__ATOMIC_ACQUIRE, "agent");
            xb_add(&bar[XB_XGEN(b.x)], 1u);
            asm volatile("s_waitcnt vmcnt(0)" ::: "memory");
        } else {
            XB_SPIN(xb_ld(&bar[XB_XGEN(b.x)]) == gen, bar);
            __builtin_amdgcn_fence(__ATOMIC_ACQUIRE, "agent");
            asm volatile("s_waitcnt vmcnt(0)" ::: "memory");
        }
    }
    __syncthreads();
}

#define GRID_SYNC_CG() do { asm volatile("s_waitcnt vmcnt(0)" ::: "memory"); grid.sync(); __builtin_amdgcn_fence(__ATOMIC_ACQUIRE, "agent"); asm volatile("s_waitcnt vmcnt(0)" ::: "memory"); } while (0)
#define GRID_SYNC() do { XcdBarrier b_; b_.bar = (unsigned*)(kargs()->ws + WS_BAR); b_.x = xb_xcc_id(); b_.st = (volatile LAS unsigned*)(lds + 131072 + 64); b_.lead = fresh_tid(wave0) == 0; xcd_barrier(b_); } while (0)
__global__ void __launch_bounds__(512, 2) hymba_fwd(Args args) {
    extern __shared__ __attribute__((aligned(16))) unsigned char lds_raw[];
    cg::grid_group grid = cg::this_grid();
    LAS unsigned char* lds = (LAS unsigned char*)lds_raw;
    const int wave0 = __builtin_amdgcn_readfirstlane((int)threadIdx.x >> 6);
    volatile LAS unsigned* xst = (volatile LAS unsigned*)(lds + 131072 + 64);
    { const int t0_ = fresh_tid(wave0); if (t0_ < 2) xst[t0_] = 0u; __syncthreads(); (void)xcd_barrier_post((unsigned*)(kargs()->ws + WS_BAR), xst, t0_ == 0); }
    prologue_stage(lds, wave0);
    if (kargs()->out == nullptr) GRID_SYNC_CG();
    GRID_SYNC();
    for (int l = 0; l < DEPTH; ++l) {
        gemm_stage<0>(lds, l, 0, wave0); GRID_SYNC();
        gemm_stage<1>(lds, l, 0, wave0); GRID_SYNC();
        gemm_stage<2>(lds, l, 0, wave0); GRID_SYNC();
        mixer_stage<0>(lds, l, wave0); GRID_SYNC();
        mixer_stage<1>(lds, l, wave0); GRID_SYNC();
        gemm_stage<3>(lds, l, 0, wave0); GRID_SYNC();
        gemm_stage<0>(lds, l, 1, wave0); GRID_SYNC();
        gemm_stage<1>(lds, l, 1, wave0); GRID_SYNC();
    }
    {
        KArgs ap = kargs(); const int tid = fresh_tid(wave0), lane = tid & 63, wave = __builtin_amdgcn_readfirstlane(tid >> 6);
        const int gw = blockIdx.x * 8 + wave, NGW = gridDim.x * 8;
        float* out = ap->out; const bf16_t* XB = (const bf16_t*)(ap->ws + WS_XB); const float* gfin = IN_F(21); const float* ssqF = (const float*)(ap->ws + WS_SSQ) + (size_t)12 * SSQ_SLOT;
        for (int m = gw; m < MTOK; m += NGW) {
            const float rstd = rsqrtf(ssq_row(ssqF, m) * (1.0f / DM) + EPS);
            const u32x2* xr = (const u32x2*)(XB + (size_t)m * DM) + lane; f32x4* orow = (f32x4*)(out + (size_t)m * DM) + lane; const f32x4* gr = (const f32x4*)gfin + lane;
#pragma unroll
            for (int j = 0; j < 4; ++j) { const u32x2 v = xr[64 * j]; const f32x4 g = gr[64 * j];
                f32x4 o; o[0] = bflo(v.x) * rstd * g[0]; o[1] = bfhi(v.x) * rstd * g[1]; o[2] = bflo(v.y) * rstd * g[2]; o[3] = bfhi(v.y) * rstd * g[3];
                orow[64 * j] = o; }
        }
    }
}

extern "C" void kernel_launch(void* const* d_in, const int* in_sizes, int n_in, void* d_out, int out_size, void* d_ws, size_t ws_size, hipStream_t stream) {
    static int grid = 0;
    if (grid == 0) {
        if (n_in != 22 || out_size != MTOK * DM || ws_size < WS_END) { fprintf(stderr, "kernel_launch: unexpected shapes (n_in %d, out %d, ws %zu)\n", n_in, out_size, ws_size); grid = -1; return; }
        int dev = 0, cus = 0, per_cu = 0;
        (void)hipGetDevice(&dev); (void)hipDeviceGetAttribute(&cus, hipDeviceAttributeMultiprocessorCount, dev);
        if (hipFuncSetAttribute((const void*)hymba_fwd, hipFuncAttributeMaxDynamicSharedMemorySize, LDS_BYTES) != hipSuccess) { fprintf(stderr, "kernel_launch: hipFuncSetAttribute failed\n"); grid = -1; return; }
        if (hipOccupancyMaxActiveBlocksPerMultiprocessor(&per_cu, (const void*)hymba_fwd, 512, LDS_BYTES) != hipSuccess || per_cu < 1) { fprintf(stderr, "kernel_launch: occupancy query gave %d\n", per_cu); per_cu = 1; }
        (void)hipGetLastError();
        grid = cus * per_cu;
    }
    if (grid < 0) return;
    if (hipMemsetAsync((char*)d_ws + WS_BAR, 0, XCD_BAR_WORDS * 4, stream) != hipSuccess) { fprintf(stderr, "kernel_launch: hipMemsetAsync failed\n"); return; }
    Args a{};
    for (int i = 0; i < 22; ++i) a.in[i] = d_in[i];
    a.out = (float*)d_out; a.ws = (unsigned char*)d_ws;
    void* kargs[] = {&a};
    hipError_t e = hipLaunchCooperativeKernel((const void*)hymba_fwd, dim3(grid), dim3(512), kargs, LDS_BYTES, stream);
    if (e != hipSuccess) fprintf(stderr, "kernel_launch: cooperative launch failed: %s (grid %d)\n", hipGetErrorString(e), grid);
}
```

```cpp
#include <hip/hip_runtime.h>
#include <hip/hip_cooperative_groups.h>
#include <cstdio>
#include <cstdint>
#include <cmath>
namespace cg = cooperative_groups;
namespace pg8 {
#define PG8_LAS __attribute__((address_space(3)))
typedef unsigned short bf16_t;
typedef short bf16x8 __attribute__((ext_vector_type(8)));
typedef float f32x4 __attribute__((ext_vector_type(4)));
typedef unsigned u32x4 __attribute__((ext_vector_type(4)));
constexpr int BM = 256, BK = 64, HALF = 128, HTB = HALF * BK * 2  , STAGE_BYTES = 8 * HTB, NXCD = 8, WGM = 8;

__host__ __device__ __forceinline__ int lds_byte(int r, int c) { const int st = (r >> 4) * 2 + (c >> 5), rr = r & 15, cc = c & 31, ob = rr * 64 + cc * 2; return st * 1024 + (ob ^ (((ob >> 9) & 1) << 5)); }
__host__ __device__ __forceinline__ void stage_rc(int b, int& R, int& C) { const int st = b / 1024, sb = b % 1024, swz = sb ^ (((sb >> 9) & 1) << 5); R = (st >> 1) * 16 + swz / 64; C = (st & 1) * 32 + (swz % 64) / 2; }
__host__ __device__ __forceinline__ int perm32(int rho) { const int n = rho >> 4, i = rho & 15; return 8 * (i >> 2) + 4 * n + (i & 3); }

struct Unit { int pm, pn; };
struct Gemm { const bf16_t* A; const bf16_t* Bt; int M, N, K; };

struct StaticOrder {
    int nM, nN, nwg, G, c;
    __host__ __device__ void init(int M, int N, int G_, int c_) { nM = M / BM; nN = N / BM; nwg = nM * nN; G = G_; c = c_; }
    __host__ __device__ bool next(int i, Unit& u) const {
        const long L = (long)i * G + c; if (L >= nwg) return false;
        int wgid = (int)L; { const int q = nwg / NXCD, r = nwg % NXCD, xcd = wgid % NXCD, off = wgid / NXCD; wgid = (xcd < r ? xcd * (q + 1) : r * (q + 1) + (xcd - r) * q) + off; }
        const int nig = WGM * nN, gid = wgid / nig, fm = gid * WGM, gsz = (nM - fm) < WGM ? (nM - fm) : WGM;
        u.pm = fm + ((wgid % nig) % gsz); u.pn = (wgid % nig) / gsz; return true;
    }
    __device__ __forceinline__ void a_ready(const Unit&) const {}
    __device__ __forceinline__ void done(const Unit&) const {}
};
}

constexpr int DM = 1024, BATCH = 2, SEQ = 16384, MTOK = BATCH * SEQ, DEPTH = 4, FF = 2816, NGU = 2 * FF, NIN = 2560, INC = 2432;
constexpr int PC_QA = 0, PC_KA = 256, PC_VA = 384, PC_QB = 512, PC_KB = 896, PC_VB = 1280, PC_XC = 1792, PC_GC = 2176;
__device__ __forceinline__ size_t p_pos(bool perm, int tokabs) { const int s = tokabs & (SEQ - 1); return perm ? (size_t)((tokabs - s) + (s & 15) * (SEQ / 16) + (s >> 4)) : (size_t)tokabs; }
__device__ __forceinline__ size_t p_off(int g, bool perm, int tokabs) { return ((size_t)g * MTOK + p_pos(perm, tokabs)) * 64; }
constexpr float EPS = 1e-6f;
constexpr float QSCALE = 0.125f * 1.4426950408889634f;

#define LAS __attribute__((address_space(3)))
typedef unsigned short bf16_t;
typedef short bf16x8 __attribute__((ext_vector_type(8)));
typedef short s16x4 __attribute__((ext_vector_type(4)));
typedef float f32x4 __attribute__((ext_vector_type(4)));
typedef float f32x2 __attribute__((ext_vector_type(2)));
typedef float f32x16 __attribute__((ext_vector_type(16)));
typedef unsigned u32x4 __attribute__((ext_vector_type(4)));
typedef unsigned u32x2 __attribute__((ext_vector_type(2)));
typedef __bf16 nbf16x2 __attribute__((ext_vector_type(2)));

__device__ __forceinline__ unsigned pk2(float lo, float hi) { f32x2 v = {lo, hi}; nbf16x2 r = __builtin_convertvector(v, nbf16x2); return __builtin_bit_cast(unsigned, r); }
__device__ __forceinline__ float bf2f(unsigned short h) { return __builtin_bit_cast(float, (unsigned)h << 16); }
__device__ __forceinline__ float bflo(unsigned w) { return __builtin_bit_cast(float, w << 16); }
__device__ __forceinline__ float bfhi(unsigned w) { return __builtin_bit_cast(float, w & 0xffff0000u); }
__device__ __forceinline__ float fast_rcp(float x) { return __builtin_amdgcn_rcpf(x); }
__device__ __forceinline__ float fast_exp2(float x) { return __builtin_amdgcn_exp2f(x); }
__device__ __forceinline__ float sigmoidf_(float x) { return fast_rcp(1.0f + __expf(-x)); }

__device__ __forceinline__ float ssq_row(const float* part, int row) {
    const f32x4* p = (const f32x4*)(part + (size_t)row * 16);
    const f32x4 a = p[0], b = p[1], c = p[2], d = p[3];
    return (((a[0] + a[1]) + (a[2] + a[3])) + ((b[0] + b[1]) + (b[2] + b[3]))) + (((c[0] + c[1]) + (c[2] + c[3])) + ((d[0] + d[1]) + (d[2] + d[3])));
}

namespace pg8 {
__device__ __forceinline__ void rstd8(const float* ssq, int row0, int fq, float (&rstd)[8]) {
    f32x4 q[8];
#pragma unroll
    for (int i = 0; i < 8; ++i) q[i] = *(const f32x4*)(ssq + (size_t)(row0 + (i >> 2) * HALF + (i & 3) * 16) * 16 + 4 * fq);
#pragma unroll
    for (int i = 0; i < 8; ++i) { float s = (q[i][0] + q[i][1]) + (q[i][2] + q[i][3]); s += __shfl_xor(s, 16); s += __shfl_xor(s, 32); rstd[i] = rsqrtf(s * (1.0f / DM) + EPS); }
}
struct EpiGateUp {
    static constexpr bool PERM = true, AFTER_DRAIN = false;
    const float* ssq; bf16_t* act;
    __device__ __forceinline__ void operator()(const f32x4 (&acc)[2][2][4][2], const Unit& u, int wr, int wc, int fr, int fq) const {
        float rstd[8]; rstd8(ssq, u.pm * BM + wr * 64 + fr, fq, rstd);
#pragma unroll
        for (int ai = 0; ai < 2; ++ai)
#pragma unroll
            for (int m = 0; m < 4; ++m) {
                const int row = u.pm * BM + ai * HALF + wr * 64 + m * 16 + fr;
                const float rs = rstd[ai * 4 + m];
                float a[8];
#pragma unroll
                for (int n = 0; n < 2; ++n) {
                    const f32x4 g = acc[ai][0][m][n] * rs, up = acc[ai][1][m][n] * rs;
#pragma unroll
                    for (int e = 0; e < 4; ++e) a[4 * n + e] = g[e] * fast_rcp(1.0f + __expf(-g[e])) * up[e];
                }
                u32x4 w; w.x = pk2(a[0], a[1]); w.y = pk2(a[2], a[3]); w.z = pk2(a[4], a[5]); w.w = pk2(a[6], a[7]);
                *(u32x4*)(act + (size_t)row * FF + u.pn * 128 + wc * 32 + fq * 8) = w;
            }
    }
};
struct EpiResidual {
    static constexpr bool PERM = true, AFTER_DRAIN = false;
    bf16_t* xb; float* ssq_out; float scale;
    __device__ __forceinline__ void operator()(const f32x4 (&acc)[2][2][4][2], const Unit& u, int wr, int wc, int fr, int fq) const {
        bf16_t* p0 = xb + (size_t)(u.pm * BM + wr * 64 + fr) * DM + u.pn * BM + wc * 32 + fq * 8;
        u32x4 b[8][2];
#pragma unroll
        for (int i = 0; i < 2; ++i)
#pragma unroll
            for (int bj = 0; bj < 2; ++bj) b[i][bj] = *(const u32x4*)(p0 + (size_t)((i >> 2) * HALF + (i & 3) * 16) * DM + bj * HALF);
#pragma unroll
        for (int i = 0; i < 8; ++i) {
            if (i + 2 < 8) {
#pragma unroll
                for (int bj = 0; bj < 2; ++bj) b[i + 2][bj] = *(const u32x4*)(p0 + (size_t)(((i + 2) >> 2) * HALF + ((i + 2) & 3) * 16) * DM + bj * HALF);
            }
            const int ai = i >> 2, m = i & 3;
            const int row = u.pm * BM + ai * HALF + wr * 64 + m * 16 + fr;
            float sq = 0.f;
#pragma unroll
            for (int bj = 0; bj < 2; ++bj) {
                const u32x4 bb = b[i][bj];
                const f32x4 a0 = acc[ai][bj][m][0] * scale, a1 = acc[ai][bj][m][1] * scale;
                const float o0 = bflo(bb.x) + a0[0], o1 = bfhi(bb.x) + a0[1], o2 = bflo(bb.y) + a0[2], o3 = bfhi(bb.y) + a0[3];
                const float o4 = bflo(bb.z) + a1[0], o5 = bfhi(bb.z) + a1[1], o6 = bflo(bb.w) + a1[2], o7 = bfhi(bb.w) + a1[3];
                sq += ((o0 * o0 + o1 * o1) + (o2 * o2 + o3 * o3)) + ((o4 * o4 + o5 * o5) + (o6 * o6 + o7 * o7));
                u32x4 w; w.x = pk2(o0, o1); w.y = pk2(o2, o3); w.z = pk2(o4, o5); w.w = pk2(o6, o7);
                *(u32x4*)(p0 + (size_t)(ai * HALF + m * 16) * DM + bj * HALF) = w;
            }
            sq += __shfl_xor(sq, 16); sq += __shfl_xor(sq, 32);
            if (fq == 0) ssq_out[(size_t)row * 16 + u.pn * 4 + wc] = sq;
            asm volatile("" ::: "memory");
        }
    }
};
struct EpiProj {
    static constexpr bool PERM = true, AFTER_DRAIN = false;
    const float* ssq; const float* cosT; const float* sinT; bf16_t* P;
    __device__ __forceinline__ void operator()(const f32x4 (&acc)[2][2][4][2], const Unit& u, int wr, int wc, int fr, int fq) const {
        const int row0 = u.pm * BM + wr * 64 + fr;
        float rstd[8]; rstd8(ssq, row0, fq, rstd);
        const int d1 = 16 * (wc & 1) + 4 * fq;
        const bool rope0 = (u.pn * BM + wc * 32 < PC_VA) || (u.pn * BM + wc * 32 >= PC_QB && u.pn * BM + wc * 32 < PC_VB);
        f32x4 c4[8], s4[8];
#pragma unroll
        for (int i = 0; i < 2; ++i) { const size_t to = (size_t)(row0 + (i >> 2) * HALF + (i & 3) * 16) * 32 + d1; c4[i] = *(const f32x4*)(cosT + to); s4[i] = *(const f32x4*)(sinT + to); }
#pragma unroll
        for (int i = 0; i < 8; ++i) {
            if (i + 2 < 8) { const size_t to = (size_t)(row0 + ((i + 2) >> 2) * HALF + ((i + 2) & 3) * 16) * 32 + d1; c4[i + 2] = *(const f32x4*)(cosT + to); s4[i + 2] = *(const f32x4*)(sinT + to); }
            const int ai = i >> 2, m = i & 3;
            const int row = row0 + ai * HALF + m * 16;
            const float rs = rstd[i];
#pragma unroll
            for (int bj = 0; bj < 2; ++bj) {
                const int cb = u.pn * BM + bj * HALF + wc * 32;
                f32x4 v0 = acc[ai][bj][m][0] * rs, v1 = acc[ai][bj][m][1] * rs;
                const bool rope = (cb < PC_VA) || (cb >= PC_QB && cb < PC_VB);
                const bool isq = (cb < PC_KA) || (cb >= PC_QB && cb < PC_KB);
                if (rope) {
                    const f32x4 o0 = v0 * c4[i] - v1 * s4[i], o1 = v1 * c4[i] + v0 * s4[i];
                    const float qs = isq ? QSCALE : 1.0f;
                    v0 = o0 * qs; v1 = o1 * qs;
                }
                u32x4 w; w.x = pk2(v0[0], v0[1]); w.y = pk2(v0[2], v0[3]); w.z = pk2(v1[0], v1[1]); w.w = pk2(v1[2], v1[3]);
                *(u32x4*)(P + p_off(cb >> 6, cb >= PC_QB && cb < 1664, row) + (cb & 63) + fq * 8) = w;
            }
            asm volatile("" ::: "memory");
        }
        (void)rope0;
    }
};
}
namespace pg8 {
template <class Epi, class Sched, bool ALIGN_EPI = false, bool SP2 = false>
__device__ __forceinline__ void gemm_phase(PG8_LAS unsigned char* lds, const Gemm g, const Sched& S, const Epi& E, int tid_in) {
    int tid_ = tid_in; asm volatile("" : "+v"(tid_));
    const int tid = tid_, wid = __builtin_amdgcn_readfirstlane(tid >> 6), lane = tid & 63, wr = wid >> 2, wc = wid & 3, fr = lane & 15, fq = lane >> 4;
    const int K = g.K, nt = K / BK;
    unsigned voffA[2], voffB[2];
#pragma unroll
    for (int i = 0; i < 2; ++i) { int R, C; stage_rc(tid * 16 + i * 8192, R, C); const int Rb = Epi::PERM ? ((R & ~31) + perm32(R & 31)) : R;
        voffA[i] = (unsigned)(R * K + C) * 2u; voffB[i] = (unsigned)(Rb * K + C) * 2u; }
    const size_t kstep = (size_t)(BK * 2);
    const size_t hstep = (size_t)HALF * K * 2;
    const size_t tstep = 2 * hstep;
    const unsigned ldsw = (unsigned)wid * 1024u;
    const int aoff = lds_byte(wr * 64 + fr, fq * 8), boff = lds_byte(wc * 32 + fr, fq * 8);
#define PG8_SA(b, h) (((b) * 2 + (h)) * HTB)
#define PG8_SB(b, h) ((4 + (b) * 2 + (h)) * HTB)
#define PG8_STAGE(bufoff, gbase, voff) do { _Pragma("unroll") for (int _i = 0; _i < 2; ++_i) \
        __builtin_amdgcn_global_load_lds((const unsigned*)((const char*)(gbase) + (voff)[_i]), (PG8_LAS unsigned*)(lds + (bufoff) + ldsw + _i * 8192), 16, 0, 0); } while (0)
#define PG8_LDA(dst, b, h) do { _Pragma("unroll") for (int m = 0; m < 4; ++m) _Pragma("unroll") for (int k = 0; k < 2; ++k) dst[m][k] = *(const PG8_LAS bf16x8*)(lds + PG8_SA(b, h) + aoff + m * 2048 + k * 1024); } while (0)
#define PG8_LDB(dst, b, h) do { _Pragma("unroll") for (int n = 0; n < 2; ++n) _Pragma("unroll") for (int k = 0; k < 2; ++k) dst[n][k] = *(const PG8_LAS bf16x8*)(lds + PG8_SB(b, h) + boff + n * 2048 + k * 1024); } while (0)
#define PG8_MMA(ai, bj, At, Bt) do { __builtin_amdgcn_s_setprio(1); _Pragma("unroll") for (int m = 0; m < 4; ++m) _Pragma("unroll") for (int n = 0; n < 2; ++n) _Pragma("unroll") for (int k = 0; k < 2; ++k) \
        acc[ai][bj][m][n] = __builtin_amdgcn_mfma_f32_16x16x32_bf16(Bt[n][k], At[m][k], acc[ai][bj][m][n], 0, 0, 0); __builtin_amdgcn_s_setprio(0); } while (0)
#define PG8_WAIT_V(n) asm volatile("s_waitcnt vmcnt(" #n ")" ::: "memory")
#define PG8_WAIT_L(n) asm volatile("s_waitcnt lgkmcnt(" #n ")" ::: "memory")
#define PG8_BAR __builtin_amdgcn_s_barrier()
#define PG8_SCHED __builtin_amdgcn_sched_barrier(0)
    Unit cur, nxt; int ui = 0;
    if (!S.next(0, cur)) return;
    f32x4 acc[2][2][4][2];
#pragma unroll
    for (int a = 0; a < 2; ++a)
#pragma unroll
        for (int b = 0; b < 2; ++b)
#pragma unroll
            for (int m = 0; m < 4; ++m)
#pragma unroll
                for (int n = 0; n < 2; ++n) acc[a][b][m][n] = (f32x4){0.f, 0.f, 0.f, 0.f};
    bf16x8 At[4][2], B0[2][2], B1[2][2];
    const char* cA = (const char*)g.A + (size_t)cur.pm * tstep; const char* cB = (const char*)g.Bt + (size_t)cur.pn * tstep;
    S.a_ready(cur);
    if constexpr (SP2) {
        PG8_STAGE(PG8_SB(0, 0), cB, voffB); PG8_STAGE(PG8_SB(0, 1), cB + hstep, voffB); PG8_STAGE(PG8_SA(0, 0), cA, voffA); PG8_STAGE(PG8_SA(0, 1), cA + hstep, voffA);
        if (wr == 1) PG8_BAR;
        PG8_WAIT_V(2); PG8_BAR;
        PG8_STAGE(PG8_SB(1, 0), cB + kstep, voffB); PG8_STAGE(PG8_SA(1, 0), cA + kstep, voffA); PG8_STAGE(PG8_SB(1, 1), cB + hstep + kstep, voffB);
        PG8_WAIT_V(6); PG8_BAR;
    } else {
        PG8_STAGE(PG8_SB(0, 0), cB, voffB); PG8_STAGE(PG8_SA(0, 0), cA, voffA); PG8_STAGE(PG8_SB(0, 1), cB + hstep, voffB); PG8_STAGE(PG8_SA(0, 1), cA + hstep, voffA);
        if (wr == 1) PG8_BAR;
        PG8_WAIT_V(4); PG8_BAR;
        PG8_STAGE(PG8_SB(1, 0), cB + kstep, voffB); PG8_STAGE(PG8_SA(1, 0), cA + kstep, voffA); PG8_STAGE(PG8_SB(1, 1), cB + hstep + kstep, voffB);
        PG8_WAIT_V(6); PG8_BAR;
    }
    for (;;) {
        const bool has_next = S.next(ui + 1, nxt);
        const char* nA = has_next ? (const char*)g.A + (size_t)nxt.pm * tstep : cA; const char* nB = has_next ? (const char*)g.Bt + (size_t)nxt.pn * tstep : cB;
        for (int t = 0; t < nt; t += 2) {
            const bool last = (t == nt - 2);
            const char* a1 = cA + (size_t)(t + 1) * kstep;
            const char* a2 = last ? nA : cA + (size_t)(t + 2) * kstep; const char* b2 = last ? nB : cB + (size_t)(t + 2) * kstep;
            const char* a3 = a2 + kstep; const char* b3 = b2 + kstep;
            if (last && has_next) S.a_ready(nxt);
            if constexpr (SP2) {
            PG8_LDB(B0, 0, 0); PG8_LDB(B1, 0, 1); PG8_SCHED; PG8_LDA(At, 0, 0); PG8_STAGE(PG8_SA(1, 1), a1 + hstep, voffA);
            PG8_WAIT_V(8); PG8_WAIT_L(0); PG8_BAR; PG8_MMA(0, 0, At, B0); PG8_MMA(0, 1, At, B1); PG8_BAR; PG8_SCHED;
            PG8_LDA(At, 0, 1); PG8_STAGE(PG8_SB(0, 0), b2, voffB); PG8_STAGE(PG8_SB(0, 1), b2 + hstep, voffB); PG8_STAGE(PG8_SA(0, 0), a2, voffA);
            PG8_WAIT_V(8); PG8_WAIT_L(0); PG8_BAR; PG8_MMA(1, 0, At, B0); PG8_MMA(1, 1, At, B1); PG8_BAR; PG8_SCHED;
            PG8_LDB(B0, 1, 0); PG8_LDB(B1, 1, 1); PG8_SCHED; PG8_LDA(At, 1, 0); PG8_STAGE(PG8_SA(0, 1), a2 + hstep, voffA);
            PG8_WAIT_V(8); PG8_WAIT_L(0); PG8_BAR; PG8_MMA(0, 0, At, B0); PG8_MMA(0, 1, At, B1); PG8_BAR; PG8_SCHED;
            PG8_LDA(At, 1, 1); PG8_STAGE(PG8_SB(1, 0), b3, voffB); PG8_STAGE(PG8_SB(1, 1), b3 + hstep, voffB); PG8_STAGE(PG8_SA(1, 0), a3, voffA);
            PG8_WAIT_V(8); PG8_WAIT_L(0); PG8_BAR; PG8_MMA(1, 0, At, B0); PG8_MMA(1, 1, At, B1); PG8_BAR; PG8_SCHED;
            } else {
            PG8_LDB(B0, 0, 0); PG8_SCHED; PG8_LDA(At, 0, 0); PG8_STAGE(PG8_SA(1, 1), a1 + hstep, voffA);
            PG8_WAIT_L(8); PG8_BAR; PG8_WAIT_L(0); PG8_MMA(0, 0, At, B0); PG8_BAR; PG8_SCHED;
            PG8_LDB(B1, 0, 1); PG8_STAGE(PG8_SB(0, 0), b2, voffB);
            PG8_BAR; PG8_WAIT_L(0); PG8_MMA(0, 1, At, B1); PG8_BAR;
            PG8_LDA(At, 0, 1); PG8_STAGE(PG8_SA(0, 0), a2, voffA);
            PG8_BAR; PG8_WAIT_L(0); PG8_MMA(1, 0, At, B0); PG8_BAR; PG8_SCHED;
            PG8_STAGE(PG8_SB(0, 1), b2 + hstep, voffB);
            PG8_WAIT_V(6); PG8_BAR; PG8_MMA(1, 1, At, B1); PG8_BAR;
            PG8_LDB(B0, 1, 0); PG8_SCHED; PG8_LDA(At, 1, 0); PG8_STAGE(PG8_SA(0, 1), a2 + hstep, voffA);
            PG8_WAIT_L(8); PG8_BAR; PG8_WAIT_L(0); PG8_MMA(0, 0, At, B0); PG8_BAR; PG8_SCHED;
            PG8_LDB(B1, 1, 1); PG8_STAGE(PG8_SB(1, 0), b3, voffB);
            PG8_BAR; PG8_WAIT_L(0); PG8_MMA(0, 1, At, B1); PG8_BAR;
            PG8_LDA(At, 1, 1); PG8_STAGE(PG8_SA(1, 0), a3, voffA);
            PG8_BAR; PG8_WAIT_L(0); PG8_MMA(1, 0, At, B0); PG8_BAR; PG8_SCHED;
            PG8_STAGE(PG8_SB(1, 1), b3 + hstep, voffB);
            PG8_WAIT_V(6); PG8_BAR; PG8_MMA(1, 1, At, B1); PG8_BAR;
            }
        }
        if constexpr (ALIGN_EPI) { if (wr == 0) PG8_BAR; }
        if constexpr (!Epi::AFTER_DRAIN) { E(acc, cur, wr, wc, fr, fq); S.done(cur); }
        if (!has_next) break;
#pragma unroll
        for (int a = 0; a < 2; ++a)
#pragma unroll
            for (int b = 0; b < 2; ++b)
#pragma unroll
                for (int m = 0; m < 4; ++m)
#pragma unroll
                    for (int n = 0; n < 2; ++n) acc[a][b][m][n] = (f32x4){0.f, 0.f, 0.f, 0.f};
        cur = nxt; cA = nA; cB = nB; ++ui;
        if constexpr (ALIGN_EPI) { if (wr == 1) PG8_BAR; }
    }
    PG8_WAIT_V(0);
    if constexpr (!ALIGN_EPI) { if (wr == 0) PG8_BAR; }
    PG8_BAR;
    if constexpr (Epi::AFTER_DRAIN) { E.fused(acc, cur, wr, wc, fr, fq, lds, wid, lane); S.done(cur); }
#undef PG8_SA
#undef PG8_SB
#undef PG8_STAGE
#undef PG8_LDA
#undef PG8_LDB
#undef PG8_MMA
#undef PG8_WAIT_V
#undef PG8_WAIT_L
#undef PG8_BAR
#undef PG8_SCHED
}
}

constexpr size_t MiB = 1u << 20;
constexpr size_t WS_W = 0, W_LAYER = 40 * MiB;
constexpr size_t WO_GU1 = 0, WO_D1 = 11 * MiB, WO_IN = WO_D1 + 11 * MiB / 2, WO_OUT = WO_IN + 5 * MiB, WO_GU2 = WO_OUT + 2 * MiB, WO_D2 = WO_GU2 + 11 * MiB;
static_assert(WO_D2 + 11 * MiB / 2 == W_LAYER, "weight map");
constexpr size_t WS_XB = 160 * MiB;
constexpr size_t WS_ACT = 224 * MiB;
constexpr size_t WS_MIX = 400 * MiB;
constexpr size_t WS_ROPE = 464 * MiB;
constexpr size_t WS_SSQ = 476 * MiB;
constexpr size_t SSQ_SLOT = (size_t)MTOK * 16;
constexpr size_t WS_RGW = 474 * MiB;
constexpr size_t WS_AGG = 475 * MiB;
constexpr size_t WS_TS = 502 * MiB;
constexpr size_t WS_BAR = 504 * MiB;
constexpr size_t WS_END = 505 * MiB;
constexpr size_t PO_BYTES = (size_t)MTOK * 384 * 2;
constexpr size_t OB_PO4 = 0, OB_PO16 = PO_BYTES, OB_LSE4 = 2 * PO_BYTES, OB_LSE16 = OB_LSE4 + MiB;
static_assert(OB_LSE16 + MiB <= (size_t)MTOK * DM * 4, "partials fit the output buffer");

constexpr int LDS_BYTES = 147456;
constexpr int VROW = 144;

struct Args { const void* in[22]; float* out; unsigned char* ws; };
__device__ const float INV_TAB[32] = {1.000000000e+00f, 7.498942018e-01f, 5.623413324e-01f, 4.216965139e-01f, 3.162277639e-01f, 2.371373773e-01f, 1.778279394e-01f, 1.333521456e-01f, 1.000000015e-01f, 7.498942316e-02f, 5.623413250e-02f, 4.216964915e-02f, 3.162277490e-02f, 2.371373773e-02f, 1.778279431e-02f, 1.333521400e-02f, 9.999999776e-03f, 7.498942316e-03f, 5.623413250e-03f, 4.216964822e-03f, 3.162277630e-03f, 2.371373819e-03f, 1.778279431e-03f, 1.333521446e-03f, 1.000000047e-03f, 7.498941850e-04f, 5.623413017e-04f, 4.216965172e-04f, 3.162277571e-04f, 2.371373703e-04f, 1.778279402e-04f, 1.333521504e-04f};

#define MFMA32(a, b, c) __builtin_amdgcn_mfma_f32_32x32x16_bf16((a), (b), (c), 0, 0, 0)
__device__ __forceinline__ int crow(int reg, int h) { return (reg & 3) + 8 * (reg >> 2) + 4 * h; }

struct AttnOut { bf16_t* mix; bf16_t* po; float* lse; const bf16_t* po4; const bf16_t* po16; const float* lse4; const float* lse16; float sink; };

__device__ __forceinline__ void store_row16(bf16_t* rowp  , const u32x2 (&wv)[4], int kh) {
#pragma unroll
    for (int gp = 0; gp < 2; ++gp) {
        const u32x2 keep = kh ? wv[2 * gp + 1] : wv[2 * gp], send = kh ? wv[2 * gp] : wv[2 * gp + 1];
        u32x2 recv; recv.x = (unsigned)__shfl_xor((int)send.x, 32); recv.y = (unsigned)__shfl_xor((int)send.y, 32);
        u32x4 w; if (kh) { w.x = recv.x; w.y = recv.y; w.z = keep.x; w.w = keep.y; } else { w.x = keep.x; w.y = keep.y; w.z = recv.x; w.w = recv.y; }
        *(u32x4*)(rowp + 8 * (2 * gp + kh)) = w;
    }
}
template <int MODE>
__device__ __forceinline__ void attn_finish(const f32x16& O0, const f32x16& O1, float m2, float lsum, int tok, int ocol, int hidx, int kh, const AttnOut& AO) {
    const float l = lsum + __shfl_xor(lsum, 32);
    const float lse = (m2 + __log2f(l)) * 0.6931471805599453f;
    const float rl = fast_rcp(l);
    if (MODE == 0) {
        const float gate = fast_rcp(1.0f + __expf(AO.sink - lse)) * rl;
        bf16_t* op = AO.mix + (size_t)tok * DM + ocol;
        u32x2 w0[4], w1[4];
#pragma unroll
        for (int g = 0; g < 4; ++g) {
            w0[g].x = pk2(O0[4 * g] * gate, O0[4 * g + 1] * gate); w0[g].y = pk2(O0[4 * g + 2] * gate, O0[4 * g + 3] * gate);
            w1[g].x = pk2(O1[4 * g] * gate, O1[4 * g + 1] * gate); w1[g].y = pk2(O1[4 * g + 2] * gate, O1[4 * g + 3] * gate);
        }
        store_row16(op, w0, kh); store_row16(op + 32, w1, kh);
    } else if (MODE == 1) {
        bf16_t* op = AO.po + (size_t)tok * 384 + hidx * 64;
        u32x2 w0[4], w1[4];
#pragma unroll
        for (int g = 0; g < 4; ++g) {
            w0[g].x = pk2(O0[4 * g] * rl, O0[4 * g + 1] * rl); w0[g].y = pk2(O0[4 * g + 2] * rl, O0[4 * g + 3] * rl);
            w1[g].x = pk2(O1[4 * g] * rl, O1[4 * g + 1] * rl); w1[g].y = pk2(O1[4 * g + 2] * rl, O1[4 * g + 3] * rl);
        }
        store_row16(op, w0, kh); store_row16(op + 32, w1, kh);
        if (kh == 0) AO.lse[(size_t)tok * 6 + hidx] = lse;
    } else {
        const float l4 = AO.lse4[(size_t)tok * 6 + hidx], l16 = AO.lse16[(size_t)tok * 6 + hidx];
        const float mxl = fmaxf(lse, fmaxf(l4, l16));
        float w1 = __expf(lse - mxl), w4 = __expf(l4 - mxl), w16 = __expf(l16 - mxl);
        const float rs = fast_rcp(w1 + w4 + w16);
        w1 *= rs * rl; w4 *= rs; w16 *= rs;
        const bf16_t* p4 = AO.po4 + (size_t)tok * 384 + hidx * 64 + 4 * kh;
        const bf16_t* p16 = AO.po16 + (size_t)tok * 384 + hidx * 64 + 4 * kh;
        bf16_t* op = AO.mix + (size_t)tok * DM + ocol;
        u32x2 wq[2][4];
#pragma unroll
        for (int g = 0; g < 4; ++g) {
#pragma unroll
            for (int mt = 0; mt < 2; ++mt) {
                const u32x2 a = *(const u32x2*)(p4 + 32 * mt + 8 * g), b = *(const u32x2*)(p16 + 32 * mt + 8 * g);
                float o[4];
#pragma unroll
                for (int e = 0; e < 4; ++e) o[e] = (mt ? O1[4 * g + e] : O0[4 * g + e]) * w1;
                o[0] += bflo(a.x) * w4 + bflo(b.x) * w16; o[1] += bfhi(a.x) * w4 + bfhi(b.x) * w16;
                o[2] += bflo(a.y) * w4 + bflo(b.y) * w16; o[3] += bfhi(a.y) * w4 + bfhi(b.y) * w16;
                wq[mt][g].x = pk2(o[0], o[1]); wq[mt][g].y = pk2(o[2], o[3]);
            }
        }
        store_row16(op, wq[0], kh); store_row16(op + 32, wq[1], kh);
    }
}

struct AttnGeom { int tokb, dil, u0, qcol, kcol, vcol, ocol, hidx, maxd, mode; bool perm; float sink; bf16_t* po; float* lse; };
constexpr int KV_ROWS = 384, VIMG_OFF = KV_ROWS * VROW;

__device__ __forceinline__ void kv_fetch(const bf16_t* __restrict__ P, const AttnGeom& G, int tid, bf16x8 (&kv)[12], bf16x8 (&qn)[4], int wave, int lane) {
    const int piece = tid & 7, rb = tid >> 3;
#pragma unroll
    for (int i = 0; i < 12; ++i) {
        const int row = rb + 64 * (i % 6), u = G.u0 - 128 + row;
        if (u >= 0) kv[i] = *(const bf16x8*)(P + p_off((i < 6 ? G.kcol : G.vcol) >> 6, G.perm, G.tokb + G.dil * u) + 8 * piece);
    }
    const bf16_t* qp = P + p_off(G.qcol >> 6, G.perm, G.tokb + G.dil * (G.u0 + 32 * wave + (lane & 31))) + 8 * (lane >> 5);
#pragma unroll
    for (int ks = 0; ks < 4; ++ks) qn[ks] = *(const bf16x8*)(qp + 16 * ks);
}
__device__ __forceinline__ void kv_store(LAS unsigned char* lds, int tid, const bf16x8 (&kv)[12]) {
    const int piece = tid & 7, rb = tid >> 3;
#pragma unroll
    for (int i = 0; i < 12; ++i) *(LAS bf16x8*)(lds + (i < 6 ? 0 : VIMG_OFF) + (rb + 64 * (i % 6)) * VROW + 16 * piece) = kv[i];
}

__device__ __forceinline__ void attn_wave(LAS unsigned char* lds, const AttnGeom& G, const bf16x8 (&qf)[4], int wave, int lane, const AttnOut& AO0) {
    const int r = lane & 31, kh = lane >> 5;
    const int u0w = G.u0 + 32 * wave;
    f32x16 O0, O1;
#pragma unroll
    for (int j = 0; j < 16; ++j) { O0[j] = 0.f; O1[j] = 0.f; }
    float m2 = -INFINITY, lsum = 0.f;
    const int trlane = ((4 * kh + ((lane & 15) >> 2)) * VROW + 32 * ((lane >> 4) & 1) + 8 * (lane & 3));
    for (int kt = (u0w >= 128 ? 0 : (128 - u0w) >> 5); kt < 5; ++kt) {
        const int ks0 = u0w - 128 + 32 * kt, lrow0 = 32 * wave + 32 * kt;
        bf16x8 kf[4];
        { const LAS unsigned char* kp = lds + (lrow0 + r) * VROW + 16 * kh;
#pragma unroll
          for (int ks = 0; ks < 4; ++ks) kf[ks] = *(const LAS bf16x8*)(kp + 32 * ks); }
        f32x16 S;
#pragma unroll
        for (int j = 0; j < 16; ++j) S[j] = 0.f;
#pragma unroll
        for (int ks = 0; ks < 4; ++ks) S = MFMA32(kf[ks], qf[ks], S);
        if (kt == 0 || kt == 4) {
            const int uq = u0w + r;
#pragma unroll
            for (int j = 0; j < 16; ++j) { const int diff = uq - (ks0 + crow(j, kh)); if (diff < 0 || diff > G.maxd) S[j] = -INFINITY; }
        }
        float mx = S[0];
#pragma unroll
        for (int j = 1; j < 16; ++j) mx = fmaxf(mx, S[j]);
        mx = fmaxf(mx, __shfl_xor(mx, 32));
        const float mnew = fmaxf(m2, mx);
        const float msafe = (mnew == -INFINITY) ? 0.f : mnew;
        const float alpha = fast_exp2(m2 - msafe);
        m2 = mnew;
        float ps = 0.f;
#pragma unroll
        for (int j = 0; j < 16; ++j) { S[j] = fast_exp2(S[j] - msafe); ps += S[j]; }
        lsum = lsum * alpha + ps;
#pragma unroll
        for (int j = 0; j < 16; ++j) { O0[j] *= alpha; O1[j] *= alpha; }
        bf16x8 pf[2];
#pragma unroll
        for (int s = 0; s < 2; ++s) { u32x4 w; w.x = pk2(S[8 * s], S[8 * s + 1]); w.y = pk2(S[8 * s + 2], S[8 * s + 3]); w.z = pk2(S[8 * s + 4], S[8 * s + 5]); w.w = pk2(S[8 * s + 6], S[8 * s + 7]); pf[s] = __builtin_bit_cast(bf16x8, w); }
        LAS s16x4* vt = (LAS s16x4*)(lds + VIMG_OFF + lrow0 * VROW + trlane);
#define TRR(BYTES) __builtin_amdgcn_ds_read_tr16_b64_v4i16(vt + (BYTES) / 8)
        const bf16x8 v00 = __builtin_shufflevector(TRR(0), TRR(1152), 0, 1, 2, 3, 4, 5, 6, 7), v01 = __builtin_shufflevector(TRR(2304), TRR(3456), 0, 1, 2, 3, 4, 5, 6, 7);
        const bf16x8 v10 = __builtin_shufflevector(TRR(64), TRR(1216), 0, 1, 2, 3, 4, 5, 6, 7), v11 = __builtin_shufflevector(TRR(2368), TRR(3520), 0, 1, 2, 3, 4, 5, 6, 7);
#undef TRR
        O0 = MFMA32(v00, pf[0], O0); O0 = MFMA32(v01, pf[1], O0);
        O1 = MFMA32(v10, pf[0], O1); O1 = MFMA32(v11, pf[1], O1);
    }
    AttnOut AO = AO0; AO.sink = G.sink; AO.po = G.po; AO.lse = G.lse;
    const int tok = G.tokb + G.dil * (u0w + r);
    if (G.mode == 0) attn_finish<0>(O0, O1, m2, lsum, tok, G.ocol, G.hidx, kh, AO);
    else if (G.mode == 1) attn_finish<1>(O0, O1, m2, lsum, tok, G.ocol, G.hidx, kh, AO);
    else attn_finish<2>(O0, O1, m2, lsum, tok, G.ocol, G.hidx, kh, AO);
}

struct RgParams { const bf16_t* P; const int* pos; const float* conv_w; const float* conv_b; const bf16_t* wrT; const bf16_t* wiT; const float* b_r; const float* b_i; const float* lam; float* agg; bf16_t* mix; };

template <bool FINAL>
__device__ __forceinline__ void rglru_item(const RgParams& R, int sc, int h, int nt, int lane, LAS unsigned char* yimg) {
    const int r = lane & 31, kh = lane >> 5;
    const int tok_sc = sc * 128, bstart = (sc >> 7) * 128;
    const int ncol = 32 * nt + r, cg = 64 * h + ncol;
    const float br = R.b_r[cg], bi = R.b_i[cg], sp8l = -8.0f * 1.4426950408889634f * log1pf(expf(-R.lam[cg]));
    float carry = 0.f, atot = 1.f;
    if (FINAL) {
        const float* ag = R.agg + (size_t)cg * 2; int s = bstart;
        for (; s + 8 <= sc; s += 8) {
            f32x2 ab[8];
#pragma unroll
            for (int i = 0; i < 8; ++i) ab[i] = *(const f32x2*)(ag + (size_t)(s + i) * 768);
#pragma unroll
            for (int i = 0; i < 8; ++i) carry = ab[i].x * carry + ab[i].y;
        }
        for (; s < sc; ++s) { const f32x2 ab = *(const f32x2*)(ag + (size_t)s * 768); carry = ab.x * carry + ab.y; }
    }
    const int cc = 64 * h + lane;
    const float cw0 = R.conv_w[cc], cw1 = R.conv_w[384 + cc], cw2 = R.conv_w[768 + cc], cw3 = R.conv_w[1152 + cc], cb = R.conv_b[cc];
    unsigned short xr[32];
    const unsigned goff = (unsigned)(4 * kh * 64 + ncol);
    float xm1 = 0.f, xm2 = 0.f, xm3 = 0.f;
    { const bf16_t* xp = R.P + p_off(PC_XC / 64 + h, false, tok_sc);
      if ((tok_sc & (SEQ - 1)) != 0) { xm1 = bf2f((xp - 1 * 64)[lane]); xm2 = bf2f((xp - 2 * 64)[lane]); xm3 = bf2f((xp - 3 * 64)[lane]); }
#pragma unroll
      for (int t = 0; t < 32; ++t) xr[t] = (xp + (size_t)t * 64)[lane]; }
    for (int mt = 0; mt < 4; ++mt) {
        const int t0 = tok_sc + 32 * mt;
        bf16x8 yf[4];
        {
#pragma unroll
          for (int t = 0; t < 32; ++t) {
              const float x0 = bf2f(xr[t]);
              const float y = cb + cw0 * x0 + cw1 * xm1 + cw2 * xm2 + cw3 * xm3;
              *(LAS bf16_t*)(yimg + t * VROW + 2 * lane) = (bf16_t)(pk2(y, 0.f) & 0xffffu);
              xm3 = xm2; xm2 = xm1; xm1 = x0;
          }
          if (mt < 3) { const bf16_t* xp = R.P + p_off(PC_XC / 64 + h, false, t0 + 32);
#pragma unroll
              for (int t = 0; t < 32; ++t) xr[t] = (xp + (size_t)t * 64)[lane]; }
#pragma unroll
          for (int ks = 0; ks < 4; ++ks) yf[ks] = *(const LAS bf16x8*)(yimg + r * VROW + 32 * ks + 16 * kh);
        }
        unsigned short graw[16];
        if (FINAL) {
#pragma unroll
            for (int j = 0; j < 16; ++j) graw[j] = (R.P + p_off(PC_GC / 64 + h, false, t0 + (j & 3) + 8 * (j >> 2)))[goff];
        }
        unsigned rmask = 0u;
#pragma unroll
        for (int g = 0; g < 4; ++g) { const int4 p4 = *(const int4*)(R.pos + t0 + 8 * g + 4 * kh);
            rmask |= (p4.x == 0 ? 1u : 0u) << (4 * g); rmask |= (p4.y == 0 ? 1u : 0u) << (4 * g + 1); rmask |= (p4.z == 0 ? 1u : 0u) << (4 * g + 2); rmask |= (p4.w == 0 ? 1u : 0u) << (4 * g + 3); }
        f32x16 ra, ia, ya;
#pragma unroll
        for (int j = 0; j < 16; ++j) { ra[j] = 0.f; ia[j] = 0.f; ya[j] = 0.f; }
        int ncl = ncol; asm volatile("" : "+v"(ncl));
#pragma unroll
        for (int ks = 0; ks < 4; ++ks) {
            const size_t wo = ((size_t)h * 64 + ncl) * 64 + 16 * ks + 8 * kh;
            const bf16x8 wrf = *(const bf16x8*)(R.wrT + wo), wif = *(const bf16x8*)(R.wiT + wo);
            bf16x8 idf;
#pragma unroll
            for (int i = 0; i < 8; ++i) idf[i] = (16 * ks + 8 * kh + i == ncl) ? (short)0x3f80 : (short)0;
            ra = MFMA32(yf[ks], wrf, ra); ia = MFMA32(yf[ks], wif, ia); ya = MFMA32(yf[ks], idf, ya);
        }
        float av[16], bv[16];
#pragma unroll
        for (int j = 0; j < 16; ++j) {
            const float rr = sigmoidf_(ra[j] + br), ii = sigmoidf_(ia[j] + bi);
            const float a_ = fast_exp2(sp8l * rr);
            float a = a_, mult = __builtin_amdgcn_sqrtf(1.0f - a_ * a_);
            if ((rmask >> j) & 1u) { a = 0.f; mult = 1.f; }
            av[j] = a; bv[j] = mult * ii * ya[j];
        }
        float sa[4], sb[4], pa[4], pb[4];
#pragma unroll
        for (int g = 0; g < 4; ++g) {
            sa[g] = (av[4 * g] * av[4 * g + 1]) * (av[4 * g + 2] * av[4 * g + 3]);
            sb[g] = ((bv[4 * g] * av[4 * g + 1] + bv[4 * g + 1]) * av[4 * g + 2] + bv[4 * g + 2]) * av[4 * g + 3] + bv[4 * g + 3];
            pa[g] = __shfl_xor(sa[g], 32); pb[g] = __shfl_xor(sb[g], 32);
        }
        float c = carry, cin[4], apr = 1.f;
#pragma unroll
        for (int g = 0; g < 4; ++g) {
            const float a0 = kh ? pa[g] : sa[g], b0 = kh ? pb[g] : sb[g], a1 = kh ? sa[g] : pa[g], b1 = kh ? sb[g] : pb[g];
            const float ce = c; c = a0 * c + b0;
            const float co = c; c = a1 * c + b1;
            cin[g] = kh ? co : ce; apr *= a0 * a1;
        }
        carry = c; atot *= apr;
        if (FINAL) {
#pragma unroll
            for (int g = 0; g < 4; ++g) {
                float hp = cin[g];
#pragma unroll
                for (int e = 0; e < 4; ++e) {
                    const int j = 4 * g + e, tok = t0 + crow(j, kh);
                    hp = av[j] * hp + bv[j];
                    const float gt = bf2f(graw[j]);
                    const float z = 0.7978845608028654f * (gt + 0.044715f * gt * gt * gt);
                    const float th = 1.0f - 2.0f * fast_rcp(__expf(2.0f * z) + 1.0f);
                    const float o = hp * 0.5f * gt * (1.0f + th);
                    *(LAS bf16_t*)(yimg + 4608 + crow(j, kh) * 80 + 2 * r) = (bf16_t)(pk2(o, 0.f) & 0xffffu);
                    (void)tok;
                }
            }
#pragma unroll
            for (int q = 0; q < 2; ++q) {
                const int p = lane + 64 * q, tk = p >> 2, qu = p & 3;
                const u32x4 w = *(const LAS u32x4*)(yimg + 4608 + tk * 80 + 16 * qu);
                *(u32x4*)(R.mix + (size_t)(t0 + tk) * DM + 640 + 64 * h + 32 * nt + 8 * qu) = w;
            }
        }
    }
    if (!FINAL && kh == 0) { f32x2 ab = {atot, carry}; *(f32x2*)(R.agg + ((size_t)sc * 384 + cg) * 2) = ab; }
}

struct MapPlain { const float* w; int ld; __device__ __forceinline__ const float* operator()(int R) const { return w + R; } };
struct MapGU { const float* gate; const float* up; int ld;
    __device__ __forceinline__ const float* operator()(int R) const { const int j = 128 * (R >> 8) + (R & 127); const uintptr_t a = (uintptr_t)gate, b = (uintptr_t)up, sel = (uintptr_t)0 - (uintptr_t)((R >> 7) & 1); return (const float*)(a ^ ((a ^ b) & sel)) + j; } };
struct MapIN { const float* w; int ld;
    __device__ __forceinline__ const float* operator()(int R) const {
        int c = R;
        if (R < PC_VA || (R >= PC_QB && R < PC_VB)) { const int q = R & 63; c = (R & ~63) + 32 * ((q >> 2) & 1) + 16 * ((q >> 5) & 1) + 4 * ((q >> 3) & 3) + (q & 3); }
        if (c >= 1664 && c < PC_XC) return nullptr;
        if (c >= PC_XC) c -= 128;
        return w + c; } };

template <class Map>
__device__ __forceinline__ void transpose_item(const Map mp, int K, int N, bf16_t* WT, const float* gain, LAS float* scr, int item, int lane) {
    const int nblk = N / 32, kb = item / nblk, nb = item % nblk, k0 = 64 * kb, n0 = 32 * nb;
    const float* src = mp(n0 + (lane & 31));
    float v[32];
#pragma unroll
    for (int i = 0; i < 32; ++i) { const int kk = 2 * i + (lane >> 5); v[i] = src ? src[(size_t)(k0 + kk) * mp.ld] : 0.f; }
#pragma unroll
    for (int i = 0; i < 32; ++i) { const int kk = 2 * i + (lane >> 5); float t = v[i]; if (gain) t *= gain[k0 + kk]; scr[kk * 33 + (lane & 31)] = t; }
    asm volatile("s_waitcnt lgkmcnt(0)" ::: "memory");
    const int c = lane & 7;
#pragma unroll
    for (int j = 0; j < 4; ++j) { const int n = (lane >> 3) + 8 * j; const LAS float* s = scr + (8 * c) * 33 + n;
        u32x4 o; o.x = pk2(s[0 * 33], s[1 * 33]); o.y = pk2(s[2 * 33], s[3 * 33]); o.z = pk2(s[4 * 33], s[5 * 33]); o.w = pk2(s[6 * 33], s[7 * 33]);
        *(u32x4*)(WT + (size_t)(n0 + n) * K + k0 + 8 * c) = o; }
    asm volatile("s_waitcnt lgkmcnt(0)" ::: "memory");
}

__device__ __forceinline__ float wave_sum(float v) {
#pragma unroll
    for (int o = 1; o < 64; o <<= 1) v += __shfl_xor(v, o);
    return v;
}

__device__ __forceinline__ void sincos_d(double a, float& c, float& s) {
    const double n = rint(a * 0.6366197723675814);
    double t = fma(-n, 1.5707963267948966, a); t = fma(-n, 6.123233995736766e-17, t);
    const double t2 = t * t;
    double sp = -1.0 / 1307674368000.0; sp = sp * t2 + 1.0 / 6227020800.0; sp = sp * t2 - 1.0 / 39916800.0; sp = sp * t2 + 1.0 / 362880.0; sp = sp * t2 - 1.0 / 5040.0; sp = sp * t2 + 1.0 / 120.0; sp = sp * t2 - 1.0 / 6.0; sp = sp * t2 + 1.0;
    const double sn = sp * t;
    double cp = 1.0 / 20922789888000.0; cp = cp * t2 - 1.0 / 87178291200.0; cp = cp * t2 + 1.0 / 479001600.0; cp = cp * t2 - 1.0 / 3628800.0; cp = cp * t2 + 1.0 / 40320.0; cp = cp * t2 - 1.0 / 720.0; cp = cp * t2 + 1.0 / 24.0; cp = cp * t2 - 0.5; cp = cp * t2 + 1.0;
    const int q = (int)((long long)n & 3);
    const double cc = (q == 0) ? cp : (q == 1) ? -sn : (q == 2) ? -cp : sn;
    const double ss = (q == 0) ? sn : (q == 1) ? cp : (q == 2) ? -sn : -cp;
    c = (float)cc; s = (float)ss;
}

typedef const __attribute__((address_space(4))) Args* KArgs;
__device__ __forceinline__ KArgs kargs() { KArgs p = (KArgs)__builtin_amdgcn_kernarg_segment_ptr(); asm volatile("" : "+s"(p)); return p; }
#define IN_F(k) ((const float*)ap->in[k])
__device__ __forceinline__ int fresh_tid(int wave0) { int t = wave0 * 64 + (int)__builtin_amdgcn_mbcnt_hi(~0u, __builtin_amdgcn_mbcnt_lo(~0u, 0u)); asm volatile("" : "+v"(t)); return t; }

__device__ __forceinline__ void touch_lines(const unsigned char* p, size_t bytes, int tid) {
    unsigned acc = 0u;
    for (size_t off = ((size_t)blockIdx.x * 512 + tid) * 128; off < bytes; off += (size_t)gridDim.x * 512 * 128) acc += *(const volatile unsigned*)(p + off);
    asm volatile("" :: "v"(acc));
}
template <int WHICH>
__device__ __forceinline__ void gemm_stage(LAS unsigned char* lds, int l, int ffn, int wave0) {
    KArgs ap = kargs();
    unsigned char* ws = ap->ws; const int G = gridDim.x;
    unsigned char* wl = ws + WS_W + (size_t)l * W_LAYER;
    bf16_t* XB = (bf16_t*)(ws + WS_XB); bf16_t* ACT = (bf16_t*)(ws + WS_ACT); float* ssq0 = (float*)(ws + WS_SSQ) + (size_t)(3 * l) * SSQ_SLOT;
    if (WHICH == 0) {
        pg8::Gemm g{XB, (const bf16_t*)(wl + (ffn ? WO_GU2 : WO_GU1)), MTOK, NGU, DM}; pg8::StaticOrder S; S.init(MTOK, NGU, G, (int)blockIdx.x);
        pg8::EpiGateUp E{ssq0 + (ffn ? 2 * SSQ_SLOT : 0), ACT};
        pg8::gemm_phase<pg8::EpiGateUp, pg8::StaticOrder, true, true>(lds, g, S, E, fresh_tid(wave0));
        touch_lines(wl + (ffn ? WO_D2 : WO_D1), (size_t)DM * FF * 2, fresh_tid(wave0));
    } else if (WHICH == 1) {
        pg8::Gemm g{ACT, (const bf16_t*)(wl + (ffn ? WO_D2 : WO_D1)), MTOK, DM, FF}; pg8::StaticOrder S; S.init(MTOK, DM, G, (int)blockIdx.x);
        pg8::EpiResidual E{XB, ssq0 + (ffn ? 3 * SSQ_SLOT : SSQ_SLOT), 0.5f};
        pg8::gemm_phase<pg8::EpiResidual, pg8::StaticOrder, true, true>(lds, g, S, E, fresh_tid(wave0));
        if (ffn == 0) touch_lines(wl + WO_IN, (size_t)NIN * DM * 2, fresh_tid(wave0));
        else if (l + 1 < DEPTH) touch_lines(wl + W_LAYER + WO_GU1, (size_t)NGU * DM * 2, fresh_tid(wave0));
    } else if (WHICH == 2) {
        float* cosT = (float*)(ws + WS_ROPE);
        pg8::Gemm g{XB, (const bf16_t*)(wl + WO_IN), MTOK, NIN, DM}; pg8::StaticOrder S; S.init(MTOK, NIN, G, (int)blockIdx.x);
        pg8::EpiProj E{ssq0 + SSQ_SLOT, cosT, cosT + (size_t)MTOK * 32, ACT};
        pg8::gemm_phase<pg8::EpiProj, pg8::StaticOrder, true, true>(lds, g, S, E, fresh_tid(wave0));
    } else {
        pg8::Gemm g{(const bf16_t*)(ws + WS_MIX), (const bf16_t*)(wl + WO_OUT), MTOK, DM, DM}; pg8::StaticOrder S; S.init(MTOK, DM, G, (int)blockIdx.x);
        pg8::EpiResidual E{XB, ssq0 + 2 * SSQ_SLOT, 1.0f};
        pg8::gemm_phase<pg8::EpiResidual, pg8::StaticOrder, true, true>(lds, g, S, E, fresh_tid(wave0));
        touch_lines(wl + WO_GU2, (size_t)NGU * DM * 2, fresh_tid(wave0));
    }
}

__device__ __forceinline__ void prologue_stage(LAS unsigned char* lds, int wave0) {
    KArgs ap = kargs(); const int tid = fresh_tid(wave0), lane = tid & 63, wave = __builtin_amdgcn_readfirstlane(tid >> 6);
    unsigned char* ws = ap->ws; const int G = gridDim.x, gw = blockIdx.x * 8 + wave, NGW = G * 8;
    LAS float* scr = (LAS float*)(lds + wave * 16384);
    constexpr int I_GU = (DM / 64) * (NGU / 32), I_D = (FF / 64) * (DM / 32), I_IN = (DM / 64) * (NIN / 32), I_OUT = (DM / 64) * (DM / 32);
    constexpr int I_LAYER = 2 * I_GU + 2 * I_D + I_IN + I_OUT;
    for (int it = gw; it < DEPTH * I_LAYER; it += NGW) {
        const int l = it / I_LAYER; int r = it % I_LAYER;
        unsigned char* wl = ws + WS_W + (size_t)l * W_LAYER;
        if (r < I_GU) { MapGU mp{IN_F(3) + (size_t)l * DM * FF, IN_F(4) + (size_t)l * DM * FF, FF};
            transpose_item(mp, DM, NGU, (bf16_t*)(wl + WO_GU1), IN_F(2) + l * DM, scr, r, lane); continue; } r -= I_GU;
        if (r < I_D) { MapPlain mp{IN_F(5) + (size_t)l * FF * DM, DM};
            transpose_item(mp, FF, DM, (bf16_t*)(wl + WO_D1), nullptr, scr, r, lane); continue; } r -= I_D;
        if (r < I_IN) { MapIN mp{IN_F(7) + (size_t)l * DM * INC, INC};
            transpose_item(mp, DM, NIN, (bf16_t*)(wl + WO_IN), IN_F(6) + l * DM, scr, r, lane); continue; } r -= I_IN;
        if (r < I_OUT) { MapPlain mp{IN_F(16) + (size_t)l * DM * DM, DM};
            transpose_item(mp, DM, DM, (bf16_t*)(wl + WO_OUT), nullptr, scr, r, lane); continue; } r -= I_OUT;
        if (r < I_GU) { MapGU mp{IN_F(18) + (size_t)l * DM * FF, IN_F(19) + (size_t)l * DM * FF, FF};
            transpose_item(mp, DM, NGU, (bf16_t*)(wl + WO_GU2), IN_F(17) + l * DM, scr, r, lane); continue; } r -= I_GU;
        { MapPlain mp{IN_F(20) + (size_t)l * FF * DM, DM};
            transpose_item(mp, FF, DM, (bf16_t*)(wl + WO_D2), nullptr, scr, r, lane); }
    }
    const int gt = blockIdx.x * 512 + tid, NGT = G * 512;
    { const int* positions = (const int*)ap->in[1]; float* cosT = (float*)(ws + WS_ROPE); float* sinT = cosT + (size_t)MTOK * 32;
      for (int i = gt; i < MTOK * 32; i += NGT) {
          const int tok = i >> 5, k = i & 31;
          const float ang = (float)positions[tok] * INV_TAB[k];
          float c, s; sincos_d((double)ang, c, s);
          cosT[i] = c; sinT[i] = s;
      } }
    { float* SSQ = (float*)(ws + WS_SSQ);
      const float* x_in = IN_F(0); bf16_t* XB = (bf16_t*)(ws + WS_XB);
      for (int m = gw; m < MTOK; m += NGW) {
          const f32x4* xr = (const f32x4*)(x_in + (size_t)m * DM) + lane; float s = 0.f;
          unsigned long long* o8 = (unsigned long long*)(XB + (size_t)m * DM) + lane;
#pragma unroll
          for (int j = 0; j < 4; ++j) { const f32x4 v = xr[64 * j]; s += (v.x * v.x + v.y * v.y) + (v.z * v.z + v.w * v.w);
              o8[64 * j] = (unsigned long long)pk2(v.x, v.y) | ((unsigned long long)pk2(v.z, v.w) << 32); }
          s = wave_sum(s);
          if (lane < 16) SSQ[(size_t)m * 16 + lane] = lane == 0 ? s : 0.f;
      } }
    { bf16_t* RGW = (bf16_t*)(ws + WS_RGW); const float* wr = IN_F(11); const float* wi = IN_F(13);
      for (int i = gt; i < DEPTH * 2 * 6 * 4096; i += NGT) {
          const int ii = i & 63, j = (i >> 6) & 63, h = (i >> 12) % 6, gl = i / (6 * 4096), g = gl & 1, l = gl >> 1;
          const size_t so = ((size_t)(l * 6 + h) * 64 + ii) * 64 + j;
          const float v = g ? wi[so] : wr[so];
          RGW[i] = (bf16_t)(pk2(v, 0.f) & 0xffffu);
      } }
}

template <int SUB>
__device__ __forceinline__ void mixer_rg(LAS unsigned char* lds, int l, int wave0) {
    KArgs ap = kargs(); const int tid = fresh_tid(wave0), lane = tid & 63, wave = __builtin_amdgcn_readfirstlane(tid >> 6);
    unsigned char* ws = ap->ws; const int gw = blockIdx.x * 8 + wave, NGW = gridDim.x * 8;
    bf16_t* RGW = (bf16_t*)(ws + WS_RGW);
    RgParams RP{(const bf16_t*)(ws + WS_ACT), (const int*)ap->in[1], IN_F(9) + (size_t)l * 4 * 384, IN_F(10) + l * 384,
                RGW + (size_t)(l * 2 + 0) * 6 * 4096, RGW + (size_t)(l * 2 + 1) * 6 * 4096,
                IN_F(12) + l * 384, IN_F(14) + l * 384, IN_F(15) + l * 384, (float*)(ws + WS_AGG), (bf16_t*)(ws + WS_MIX)};
    LAS unsigned char* yimg = lds + wave * 8192;
    constexpr int N_RG = 256 * 12;
    for (int it = gw; it < N_RG; it += NGW) rglru_item<SUB == 1>(RP, it / 12, (it % 12) >> 1, it & 1, lane, yimg);
}
template <int SUB>
__device__ __forceinline__ void mixer_attn(LAS unsigned char* lds, int l, int wave0) {
    KArgs ap = kargs(); const int tid = fresh_tid(wave0), lane = tid & 63, wave = __builtin_amdgcn_readfirstlane(tid >> 6);
    unsigned char* ws = ap->ws; const int G = gridDim.x;
    const bf16_t* PB = (const bf16_t*)(ws + WS_ACT);
    unsigned char* obp = (unsigned char*)ap->out;
    AttnOut AO{(bf16_t*)(ws + WS_MIX), nullptr, nullptr, (const bf16_t*)(obp + OB_PO4), (const bf16_t*)(obp + OB_PO16), (const float*)(obp + OB_LSE4), (const float*)(obp + OB_LSE16), 0.f};
    const float* sinks = IN_F(8) + l * 4;
    auto geom = [&](int j) -> AttnGeom {
        AttnGeom g; g.sink = 0.f; g.po = nullptr; g.lse = nullptr; g.ocol = 0;
        if (SUB == 0) {
            const int br = j / 768, rr = j % 768, dil = br ? 16 : 4, nblk = SEQ / dil / 256;
            const int qb = rr % nblk, rho = (rr / nblk) % dil, bh = rr / (nblk * dil), h = bh % 6, b = bh / 6;
            g.tokb = b * SEQ + rho; g.dil = dil; g.u0 = qb * 256; g.qcol = PC_QB + 64 * h; g.kcol = PC_KB + 64 * h; g.vcol = PC_VB + 64 * h; g.hidx = h; g.maxd = 128; g.mode = 1; g.perm = true;
            g.po = (bf16_t*)(obp + (br ? OB_PO16 : OB_PO4)); g.lse = (float*)(obp + (br ? OB_LSE16 : OB_LSE4));
        } else if (j < 512) {
            const int qb = j % 64, bhq = j / 64, hq = bhq % 4, b = bhq / 4, kv = hq >> 1;
            g.tokb = b * SEQ; g.dil = 1; g.u0 = qb * 256; g.qcol = PC_QA + 64 * hq; g.kcol = PC_KA + 64 * kv; g.vcol = PC_VA + 64 * kv; g.ocol = 64 * hq; g.hidx = hq; g.maxd = 127; g.mode = 0; g.perm = false;
            g.sink = sinks[hq];
        } else {
            const int rr = j - 512, qb = rr % 64, bh = rr / 64, h = bh % 6, b = bh / 6;
            g.tokb = b * SEQ; g.dil = 1; g.u0 = qb * 256; g.qcol = PC_QB + 64 * h; g.kcol = PC_KB + 64 * h; g.vcol = PC_VB + 64 * h; g.ocol = 256 + 64 * h; g.hidx = h; g.maxd = 128; g.mode = 2; g.perm = true;
        }
        return g;
    };
    constexpr int N_ATT = SUB == 0 ? 1536 : 1280;
    asm volatile("s_waitcnt lgkmcnt(0)" ::: "memory"); __builtin_amdgcn_s_barrier();
    int j = blockIdx.x; asm volatile("" : "+s"(j));
    if (j < N_ATT) {
        bf16x8 kv[12], qn[4];
        AttnGeom g = geom(j);
        kv_fetch(PB, g, tid, kv, qn, wave, lane);
        for (;;) {
            kv_store(lds, tid, kv);
            bf16x8 qf[4];
#pragma unroll
            for (int i = 0; i < 4; ++i) qf[i] = qn[i];
            asm volatile("s_waitcnt lgkmcnt(0)" ::: "memory"); __builtin_amdgcn_s_barrier(); asm volatile("" ::: "memory");
            const int jn = j + G; const bool more = jn < N_ATT;
            AttnGeom gn = g;
            if (more) { gn = geom(jn); kv_fetch(PB, gn, tid, kv, qn, wave, lane); }
            attn_wave(lds, g, qf, wave, lane, AO);
            asm volatile("" ::: "memory"); __builtin_amdgcn_s_barrier(); asm volatile("" ::: "memory");
            if (!more) break;
            g = gn; j = jn;
        }
    }
    if (SUB == 1) touch_lines(ws + WS_W + (size_t)l * W_LAYER + WO_OUT, (size_t)DM * DM * 2, tid);
}
template <int SUB>
__device__ __forceinline__ void mixer_stage(LAS unsigned char* lds, int l, int wave0) { mixer_rg<SUB>(lds, l, wave0); mixer_attn<SUB>(lds, l, wave0); }

#define XB_TMO      128
#define XB_XCNT(j)  (256  + 64 * (j))
#define XB_XSUB(j)  (1280 + 64 * (j))
#define XB_XGEN(j)  (2304 + 64 * (j))
#define XB_TOP      3328
#define XB_TOPGEN   3392
#define XCD_BAR_WORDS 3456
#define XB_SPIN_CAP (1u << 18)

__device__ __forceinline__ unsigned xb_ld(unsigned* p)              { return __hip_atomic_load(p, __ATOMIC_RELAXED, __HIP_MEMORY_SCOPE_AGENT); }
__device__ __forceinline__ unsigned xb_add(unsigned* p, unsigned v) { return __hip_atomic_fetch_add(p, v, __ATOMIC_RELAXED, __HIP_MEMORY_SCOPE_AGENT); }
__device__ __forceinline__ unsigned xb_xcc_id() { return (unsigned)__builtin_amdgcn_s_getreg((3 << 11) | 20) & 0xFu; }
#define XB_SPIN(cond, bar) do { unsigned _sp = 0; while (cond) { __builtin_amdgcn_s_sleep(1); \
    if ((++_sp & 255u) == 0u) { if (xb_ld(&(bar)[XB_TMO])) break; if (_sp > XB_SPIN_CAP) { atomicAdd(&(bar)[XB_TMO], 1u); break; } } } } while (0)

struct XcdBarrier {
    unsigned* bar; unsigned x; bool lead;
    volatile LAS unsigned* st;
};

__device__ __forceinline__ XcdBarrier xcd_barrier_post(unsigned* bar, volatile LAS unsigned* st, bool lead) {
    XcdBarrier b; b.bar = bar; b.x = xb_xcc_id(); b.st = st; b.lead = lead;
    if (lead) (void)xb_add(&bar[XB_XCNT(b.x)], 1u);
    return b;
}
__device__ __forceinline__ void xcd_barrier_complete(unsigned* bar, unsigned x, unsigned& nloc, unsigned& nx) {
    const unsigned G = gridDim.x * gridDim.y * gridDim.z;
    unsigned sum, cnt, mine, sp = 0u;
    for (;;) {
        sum = 0u; cnt = 0u; mine = 0u;
#pragma unroll
        for (unsigned j = 0; j < 16; ++j) { const unsigned c = xb_ld(&bar[XB_XCNT(j)]); sum += c; cnt += (c > 0u) ? 1u : 0u; mine = (j == x) ? c : mine; }
        if (sum == G) break;
        __builtin_amdgcn_s_sleep(1);
        if ((++sp & 255u) == 0u) { if (xb_ld(&bar[XB_TMO])) break; if (sp > XB_SPIN_CAP) { atomicAdd(&bar[XB_TMO], 1u); break; } }
    }
    nloc = mine > 0u ? mine : 1u; nx = cnt > 0u ? cnt : 1u;
}

__device__ __forceinline__ void xcd_barrier(const XcdBarrier& b) {
    asm volatile("s_waitcnt vmcnt(0)" ::: "memory");
    __syncthreads();
    if (b.lead) {
        unsigned* bar = b.bar;
        __builtin_amdgcn_s_waitcnt(0);
        unsigned nloc = b.st[0], nx = b.st[1];
        if (nloc == 0u) { xcd_barrier_complete(bar, b.x, nloc, nx); b.st[0] = nloc; b.st[1] = nx; }
        const unsigned old = xb_add(&bar[XB_XSUB(b.x)], 1u);
        const unsigned gen = old / nloc;
        if (old + 1u == (gen + 1u) * nloc) {
            __builtin_amdgcn_fence(__ATOMIC_RELEASE, "agent");
            asm volatile("s_waitcnt vmcnt(0)" ::: "memory");
            const unsigned og = xb_add(&bar[XB_TOP], 1u);
            const unsigned tg = og / nx;
            if (og + 1u == (tg + 1u) * nx) xb_add(&bar[XB_TOPGEN], 1u);
            else XB_SPIN(xb_ld(&bar[XB_TOPGEN]) == tg, bar);
            __builtin_amdgcn_fence(__ATOMIC_ACQUIRE, "agent");
            xb_add(&bar[XB_XGEN(b.x)], 1u);
            asm volatile("s_waitcnt vmcnt(0)" ::: "memory");
        } else {
            XB_SPIN(xb_ld(&bar[XB_XGEN(b.x)]) == gen, bar);
            __builtin_amdgcn_fence(__ATOMIC_ACQUIRE, "agent");
            asm volatile("s_waitcnt vmcnt(0)" ::: "memory");
        }
    }
    __syncthreads();
}

#define GRID_SYNC_CG() do { asm volatile("s_waitcnt vmcnt(0)" ::: "memory"); grid.sync(); __builtin_amdgcn_fence(__ATOMIC_ACQUIRE, "agent"); asm volatile("s_waitcnt vmcnt(0)" ::: "memory"); } while (0)
#define GRID_SYNC() do { XcdBarrier b_; b_.bar = (unsigned*)(kargs()->ws + WS_BAR); b_.x = xb_xcc_id(); b_.st = (volatile LAS unsigned*)(lds + 131072 + 64); b_.lead = fresh_tid(wave0) == 0; xcd_barrier(b_); } while (0)
__global__ void __launch_bounds__(512, 2) hymba_fwd(Args args) {
    extern __shared__ __attribute__((aligned(16))) unsigned char lds_raw[];
    cg::grid_group grid = cg::this_grid();
    LAS unsigned char* lds = (LAS unsigned char*)lds_raw;
    const int wave0 = __builtin_amdgcn_readfirstlane((int)threadIdx.x >> 6);
    volatile LAS unsigned* xst = (volatile LAS unsigned*)(lds + 131072 + 64);
    { const int t0_ = fresh_tid(wave0); if (t0_ < 2) xst[t0_] = 0u; __syncthreads(); (void)xcd_barrier_post((unsigned*)(kargs()->ws + WS_BAR), xst, t0_ == 0); }
    prologue_stage(lds, wave0);
    if (kargs()->out == nullptr) GRID_SYNC_CG();
    GRID_SYNC();
    for (int l = 0; l < DEPTH; ++l) {
        gemm_stage<0>(lds, l, 0, wave0); GRID_SYNC();
        gemm_stage<1>(lds, l, 0, wave0); GRID_SYNC();
        gemm_stage<2>(lds, l, 0, wave0); GRID_SYNC();
        mixer_stage<0>(lds, l, wave0); GRID_SYNC();
        mixer_stage<1>(lds, l, wave0); GRID_SYNC();
        gemm_stage<3>(lds, l, 0, wave0); GRID_SYNC();
        gemm_stage<0>(lds, l, 1, wave0); GRID_SYNC();
        gemm_stage<1>(lds, l, 1, wave0); GRID_SYNC();
    }
    {
        KArgs ap = kargs(); const int tid = fresh_tid(wave0), lane = tid & 63, wave = __builtin_amdgcn_readfirstlane(tid >> 6);
        const int gw = blockIdx.x * 8 + wave, NGW = gridDim.x * 8;
        float* out = ap->out; const bf16_t* XB = (const bf16_t*)(ap->ws + WS_XB); const float* gfin = IN_F(21); const float* ssqF = (const float*)(ap->ws + WS_SSQ) + (size_t)12 * SSQ_SLOT;
        for (int m = gw; m < MTOK; m += NGW) {
            const float rstd = rsqrtf(ssq_row(ssqF, m) * (1.0f / DM) + EPS);
            const u32x2* xr = (const u32x2*)(XB + (size_t)m * DM) + lane; f32x4* orow = (f32x4*)(out + (size_t)m * DM) + lane; const f32x4* gr = (const f32x4*)gfin + lane;
#pragma unroll
            for (int j = 0; j < 4; ++j) { const u32x2 v = xr[64 * j]; const f32x4 g = gr[64 * j];
                f32x4 o; o[0] = bflo(v.x) * rstd * g[0]; o[1] = bfhi(v.x) * rstd * g[1]; o[2] = bflo(v.y) * rstd * g[2]; o[3] = bfhi(v.y) * rstd * g[3];
                orow[64 * j] = o; }
        }
    }
}

extern "C" void kernel_launch(void* const* d_in, const int* in_sizes, int n_in, void* d_out, int out_size, void* d_ws, size_t ws_size, hipStream_t stream) {
    static int grid = 0;
    if (grid == 0) {
        if (n_in != 22 || out_size != MTOK * DM || ws_size < WS_END) { fprintf(stderr, "kernel_launch: unexpected shapes (n_in %d, out %d, ws %zu)\n", n_in, out_size, ws_size); grid = -1; return; }
        int dev = 0, cus = 0, per_cu = 0;
        (void)hipGetDevice(&dev); (void)hipDeviceGetAttribute(&cus, hipDeviceAttributeMultiprocessorCount, dev);
        if (hipFuncSetAttribute((const void*)hymba_fwd, hipFuncAttributeMaxDynamicSharedMemorySize, LDS_BYTES) != hipSuccess) { fprintf(stderr, "kernel_launch: hipFuncSetAttribute failed\n"); grid = -1; return; }
        if (hipOccupancyMaxActiveBlocksPerMultiprocessor(&per_cu, (const void*)hymba_fwd, 512, LDS_BYTES) != hipSuccess || per_cu < 1) { fprintf(stderr, "kernel_launch: occupancy query gave %d\n", per_cu); per_cu = 1; }
        (void)hipGetLastError();
        grid = cus * per_cu;
    }
    if (grid < 0) return;
    if (hipMemsetAsync((char*)d_ws + WS_BAR, 0, XCD_BAR_WORDS * 4, stream) != hipSuccess) { fprintf(stderr, "kernel_launch: hipMemsetAsync failed\n"); return; }
    Args a{};
    for (int i = 0; i < 22; ++i) a.in[i] = d_in[i];
    a.out = (float*)d_out; a.ws = (unsigned char*)d_ws;
    void* kargs[] = {&a};
    hipError_t e = hipLaunchCooperativeKernel((const void*)hymba_fwd, dim3(grid), dim3(512), kargs, LDS_BYTES, stream);
    if (e != hipSuccess) fprintf(stderr, "kernel_launch: cooperative launch failed: %s (grid %d)\n", hipGetErrorString(e), grid);
}
```

```cpp
#include <hip/hip_runtime.h>
#include <hip/hip_cooperative_groups.h>
#include <cstdio>
#include <cstdint>
#include <cmath>
namespace cg = cooperative_groups;
namespace pg8 {
#define PG8_LAS __attribute__((address_space(3)))
typedef unsigned short bf16_t;
typedef short bf16x8 __attribute__((ext_vector_type(8)));
typedef float f32x4 __attribute__((ext_vector_type(4)));
typedef unsigned u32x4 __attribute__((ext_vector_type(4)));
constexpr int BM = 256, BK = 64, HALF = 128, HTB = HALF * BK * 2  , STAGE_BYTES = 8 * HTB, NXCD = 8, WGM = 8;

__host__ __device__ __forceinline__ int lds_byte(int r, int c) { const int st = (r >> 4) * 2 + (c >> 5), rr = r & 15, cc = c & 31, ob = rr * 64 + cc * 2; return st * 1024 + (ob ^ (((ob >> 9) & 1) << 5)); }
__host__ __device__ __forceinline__ void stage_rc(int b, int& R, int& C) { const int st = b / 1024, sb = b % 1024, swz = sb ^ (((sb >> 9) & 1) << 5); R = (st >> 1) * 16 + swz / 64; C = (st & 1) * 32 + (swz % 64) / 2; }
__host__ __device__ __forceinline__ int perm32(int rho) { const int n = rho >> 4, i = rho & 15; return 8 * (i >> 2) + 4 * n + (i & 3); }

struct Unit { int pm, pn; };
struct Gemm { const bf16_t* A; const bf16_t* Bt; int M, N, K; };

struct StaticOrder {
    int nM, nN, nwg, G, c;
    __host__ __device__ void init(int M, int N, int G_, int c_) { nM = M / BM; nN = N / BM; nwg = nM * nN; G = G_; c = c_; }
    __host__ __device__ bool next(int i, Unit& u) const {
        const long L = (long)i * G + c; if (L >= nwg) return false;
        int wgid = (int)L; { const int q = nwg / NXCD, r = nwg % NXCD, xcd = wgid % NXCD, off = wgid / NXCD; wgid = (xcd < r ? xcd * (q + 1) : r * (q + 1) + (xcd - r) * q) + off; }
        const int nig = WGM * nN, gid = wgid / nig, fm = gid * WGM, gsz = (nM - fm) < WGM ? (nM - fm) : WGM;
        u.pm = fm + ((wgid % nig) % gsz); u.pn = (wgid % nig) / gsz; return true;
    }
    __device__ __forceinline__ void a_ready(const Unit&) const {}
    __device__ __forceinline__ void done(const Unit&) const {}
};
}

constexpr int DM = 1024, BATCH = 2, SEQ = 16384, MTOK = BATCH * SEQ, DEPTH = 4, FF = 2816, NGU = 2 * FF, NIN = 2560, INC = 2432;
constexpr int PC_QA = 0, PC_KA = 256, PC_VA = 384, PC_QB = 512, PC_KB = 896, PC_VB = 1280, PC_XC = 1792, PC_GC = 2176;
constexpr int PP = 2696;
constexpr float EPS = 1e-6f;
constexpr float QSCALE = 0.125f * 1.4426950408889634f;

#define LAS __attribute__((address_space(3)))
typedef unsigned short bf16_t;
typedef short bf16x8 __attribute__((ext_vector_type(8)));
typedef short s16x4 __attribute__((ext_vector_type(4)));
typedef float f32x4 __attribute__((ext_vector_type(4)));
typedef float f32x2 __attribute__((ext_vector_type(2)));
typedef float f32x16 __attribute__((ext_vector_type(16)));
typedef unsigned u32x4 __attribute__((ext_vector_type(4)));
typedef unsigned u32x2 __attribute__((ext_vector_type(2)));
typedef __bf16 nbf16x2 __attribute__((ext_vector_type(2)));

__device__ __forceinline__ unsigned pk2(float lo, float hi) { f32x2 v = {lo, hi}; nbf16x2 r = __builtin_convertvector(v, nbf16x2); return __builtin_bit_cast(unsigned, r); }
__device__ __forceinline__ float bf2f(unsigned short h) { return __builtin_bit_cast(float, (unsigned)h << 16); }
__device__ __forceinline__ float bflo(unsigned w) { return __builtin_bit_cast(float, w << 16); }
__device__ __forceinline__ float bfhi(unsigned w) { return __builtin_bit_cast(float, w & 0xffff0000u); }
__device__ __forceinline__ float fast_rcp(float x) { return __builtin_amdgcn_rcpf(x); }
__device__ __forceinline__ float fast_exp2(float x) { return __builtin_amdgcn_exp2f(x); }
__device__ __forceinline__ float sigmoidf_(float x) { return fast_rcp(1.0f + __expf(-x)); }

__device__ __forceinline__ float ssq_row(const float* part, int row) {
    const f32x4* p = (const f32x4*)(part + (size_t)row * 16);
    const f32x4 a = p[0], b = p[1], c = p[2], d = p[3];
    return (((a[0] + a[1]) + (a[2] + a[3])) + ((b[0] + b[1]) + (b[2] + b[3]))) + (((c[0] + c[1]) + (c[2] + c[3])) + ((d[0] + d[1]) + (d[2] + d[3])));
}

namespace pg8 {
__device__ __forceinline__ void rstd8(const float* ssq, int row0, int fq, float (&rstd)[8]) {
    f32x4 q[8];
#pragma unroll
    for (int i = 0; i < 8; ++i) q[i] = *(const f32x4*)(ssq + (size_t)(row0 + (i >> 2) * HALF + (i & 3) * 16) * 16 + 4 * fq);
#pragma unroll
    for (int i = 0; i < 8; ++i) { float s = (q[i][0] + q[i][1]) + (q[i][2] + q[i][3]); s += __shfl_xor(s, 16); s += __shfl_xor(s, 32); rstd[i] = rsqrtf(s * (1.0f / DM) + EPS); }
}
__device__ __forceinline__ void rstd8_cached(const float* ssq, int row0, int fr, int fq, float (&rstd)[8], PG8_LAS unsigned char* tab, int tagv) {
    PG8_LAS int* tag = (PG8_LAS int*)tab; PG8_LAS float* t = (PG8_LAS float*)(tab + 16);
    if (__builtin_amdgcn_readfirstlane(*tag) == tagv) {
#pragma unroll
        for (int i = 0; i < 8; ++i) rstd[i] = t[(i >> 2) * 64 + (i & 3) * 16 + fr];
    } else {
        rstd8(ssq, row0, fq, rstd);
        if (fq == 0) {
#pragma unroll
            for (int i = 0; i < 8; ++i) t[(i >> 2) * 64 + (i & 3) * 16 + fr] = rstd[i];
        }
        *tag = tagv;
    }
}
struct EpiGateUp {
    static constexpr bool PERM = true, AFTER_DRAIN = false;
    const float* ssq; bf16_t* act; PG8_LAS unsigned char* tabs; int tag0;
    __device__ __forceinline__ void operator()(const f32x4 (&acc)[2][2][4][2], const Unit& u, int wr, int wc, int fr, int fq) const {
        float rstd[8]; rstd8_cached(ssq, u.pm * BM + wr * 64 + fr, fr, fq, rstd, tabs + (wr * 4 + wc) * 1024, tag0 + u.pm);
#pragma unroll
        for (int ai = 0; ai < 2; ++ai)
#pragma unroll
            for (int m = 0; m < 4; ++m) {
                const int row = u.pm * BM + ai * HALF + wr * 64 + m * 16 + fr;
                const float rs = rstd[ai * 4 + m];
                float a[8];
#pragma unroll
                for (int n = 0; n < 2; ++n) {
                    const f32x4 g = acc[ai][0][m][n] * rs, up = acc[ai][1][m][n] * rs;
#pragma unroll
                    for (int e = 0; e < 4; ++e) a[4 * n + e] = g[e] * fast_rcp(1.0f + __expf(-g[e])) * up[e];
                }
                u32x4 w; w.x = pk2(a[0], a[1]); w.y = pk2(a[2], a[3]); w.z = pk2(a[4], a[5]); w.w = pk2(a[6], a[7]);
                *(u32x4*)(act + (size_t)row * FF + u.pn * 128 + wc * 32 + fq * 8) = w;
            }
    }
};
struct EpiResidual {
    static constexpr bool PERM = true, AFTER_DRAIN = false;
    bf16_t* xb; float* ssq_out; float scale;
    __device__ __forceinline__ void operator()(const f32x4 (&acc)[2][2][4][2], const Unit& u, int wr, int wc, int fr, int fq) const {
        bf16_t* p0 = xb + (size_t)(u.pm * BM + wr * 64 + fr) * DM + u.pn * BM + wc * 32 + fq * 8;
        u32x4 b[8][2];
#pragma unroll
        for (int i = 0; i < 2; ++i)
#pragma unroll
            for (int bj = 0; bj < 2; ++bj) b[i][bj] = *(const u32x4*)(p0 + (size_t)((i >> 2) * HALF + (i & 3) * 16) * DM + bj * HALF);
#pragma unroll
        for (int i = 0; i < 8; ++i) {
            if (i + 2 < 8) {
#pragma unroll
                for (int bj = 0; bj < 2; ++bj) b[i + 2][bj] = *(const u32x4*)(p0 + (size_t)(((i + 2) >> 2) * HALF + ((i + 2) & 3) * 16) * DM + bj * HALF);
            }
            const int ai = i >> 2, m = i & 3;
            const int row = u.pm * BM + ai * HALF + wr * 64 + m * 16 + fr;
            float sq = 0.f;
#pragma unroll
            for (int bj = 0; bj < 2; ++bj) {
                const u32x4 bb = b[i][bj];
                const f32x4 a0 = acc[ai][bj][m][0] * scale, a1 = acc[ai][bj][m][1] * scale;
                const float o0 = bflo(bb.x) + a0[0], o1 = bfhi(bb.x) + a0[1], o2 = bflo(bb.y) + a0[2], o3 = bfhi(bb.y) + a0[3];
                const float o4 = bflo(bb.z) + a1[0], o5 = bfhi(bb.z) + a1[1], o6 = bflo(bb.w) + a1[2], o7 = bfhi(bb.w) + a1[3];
                sq += ((o0 * o0 + o1 * o1) + (o2 * o2 + o3 * o3)) + ((o4 * o4 + o5 * o5) + (o6 * o6 + o7 * o7));
                u32x4 w; w.x = pk2(o0, o1); w.y = pk2(o2, o3); w.z = pk2(o4, o5); w.w = pk2(o6, o7);
                *(u32x4*)(p0 + (size_t)(ai * HALF + m * 16) * DM + bj * HALF) = w;
            }
            sq += __shfl_xor(sq, 16); sq += __shfl_xor(sq, 32);
            if (fq == 0) ssq_out[(size_t)row * 16 + u.pn * 4 + wc] = sq;
            asm volatile("" ::: "memory");
        }
    }
};
struct EpiProj {
    static constexpr bool PERM = true, AFTER_DRAIN = false;
    const float* ssq; const float* cosT; const float* sinT; bf16_t* P; PG8_LAS unsigned char* tabs; int tag0;
    __device__ __forceinline__ void operator()(const f32x4 (&acc)[2][2][4][2], const Unit& u, int wr, int wc, int fr, int fq) const {
        const int row0 = u.pm * BM + wr * 64 + fr;
        float rstd[8]; rstd8_cached(ssq, row0, fr, fq, rstd, tabs + (wr * 4 + wc) * 1024, tag0 + u.pm);
        const int d1 = 16 * (wc & 1) + 4 * fq;
        const bool rope0 = (u.pn * BM + wc * 32 < PC_VA) || (u.pn * BM + wc * 32 >= PC_QB && u.pn * BM + wc * 32 < PC_VB);
        f32x4 c4[8], s4[8];
#pragma unroll
        for (int i = 0; i < 2; ++i) { const size_t to = (size_t)(row0 + (i >> 2) * HALF + (i & 3) * 16) * 32 + d1; c4[i] = *(const f32x4*)(cosT + to); s4[i] = *(const f32x4*)(sinT + to); }
#pragma unroll
        for (int i = 0; i < 8; ++i) {
            if (i + 2 < 8) { const size_t to = (size_t)(row0 + ((i + 2) >> 2) * HALF + ((i + 2) & 3) * 16) * 32 + d1; c4[i + 2] = *(const f32x4*)(cosT + to); s4[i + 2] = *(const f32x4*)(sinT + to); }
            const int ai = i >> 2, m = i & 3;
            const int row = row0 + ai * HALF + m * 16;
            const float rs = rstd[i];
#pragma unroll
            for (int bj = 0; bj < 2; ++bj) {
                const int cb = u.pn * BM + bj * HALF + wc * 32;
                f32x4 v0 = acc[ai][bj][m][0] * rs, v1 = acc[ai][bj][m][1] * rs;
                const bool rope = (cb < PC_VA) || (cb >= PC_QB && cb < PC_VB);
                const bool isq = (cb < PC_KA) || (cb >= PC_QB && cb < PC_KB);
                if (rope) {
                    const f32x4 o0 = v0 * c4[i] - v1 * s4[i], o1 = v1 * c4[i] + v0 * s4[i];
                    const float qs = isq ? QSCALE : 1.0f;
                    v0 = o0 * qs; v1 = o1 * qs;
                }
                u32x4 w; w.x = pk2(v0[0], v0[1]); w.y = pk2(v0[2], v0[3]); w.z = pk2(v1[0], v1[1]); w.w = pk2(v1[2], v1[3]);
                *(u32x4*)(P + (size_t)row * PP + cb + fq * 8) = w;
            }
            asm volatile("" ::: "memory");
        }
        (void)rope0;
    }
};
}
namespace pg8 {
template <class Epi, class Sched, bool ALIGN_EPI = false, bool SP2 = false>
__device__ __forceinline__ void gemm_phase(PG8_LAS unsigned char* lds, const Gemm g, const Sched& S, const Epi& E, int tid_in) {
    int tid_ = tid_in; asm volatile("" : "+v"(tid_));
    const int tid = tid_, wid = __builtin_amdgcn_readfirstlane(tid >> 6), lane = tid & 63, wr = wid >> 2, wc = wid & 3, fr = lane & 15, fq = lane >> 4;
    const int K = g.K, nt = K / BK;
    unsigned voffA[2], voffB[2];
#pragma unroll
    for (int i = 0; i < 2; ++i) { int R, C; stage_rc(tid * 16 + i * 8192, R, C); const int Rb = Epi::PERM ? ((R & ~31) + perm32(R & 31)) : R;
        voffA[i] = (unsigned)(R * K + C) * 2u; voffB[i] = (unsigned)(Rb * K + C) * 2u; }
    const size_t kstep = (size_t)(BK * 2);
    const size_t hstep = (size_t)HALF * K * 2;
    const size_t tstep = 2 * hstep;
    const unsigned ldsw = (unsigned)wid * 1024u;
    const int aoff = lds_byte(wr * 64 + fr, fq * 8), boff = lds_byte(wc * 32 + fr, fq * 8);
#define PG8_SA(b, h) (((b) * 2 + (h)) * HTB)
#define PG8_SB(b, h) ((4 + (b) * 2 + (h)) * HTB)
#define PG8_STAGE(bufoff, gbase, voff) do { _Pragma("unroll") for (int _i = 0; _i < 2; ++_i) \
        __builtin_amdgcn_global_load_lds((const unsigned*)((const char*)(gbase) + (voff)[_i]), (PG8_LAS unsigned*)(lds + (bufoff) + ldsw + _i * 8192), 16, 0, 0); } while (0)
#define PG8_LDA(dst, b, h) do { _Pragma("unroll") for (int m = 0; m < 4; ++m) _Pragma("unroll") for (int k = 0; k < 2; ++k) dst[m][k] = *(const PG8_LAS bf16x8*)(lds + PG8_SA(b, h) + aoff + m * 2048 + k * 1024); } while (0)
#define PG8_LDB(dst, b, h) do { _Pragma("unroll") for (int n = 0; n < 2; ++n) _Pragma("unroll") for (int k = 0; k < 2; ++k) dst[n][k] = *(const PG8_LAS bf16x8*)(lds + PG8_SB(b, h) + boff + n * 2048 + k * 1024); } while (0)
#define PG8_MMA(ai, bj, At, Bt) do { __builtin_amdgcn_s_setprio(1); _Pragma("unroll") for (int m = 0; m < 4; ++m) _Pragma("unroll") for (int n = 0; n < 2; ++n) _Pragma("unroll") for (int k = 0; k < 2; ++k) \
        acc[ai][bj][m][n] = __builtin_amdgcn_mfma_f32_16x16x32_bf16(Bt[n][k], At[m][k], acc[ai][bj][m][n], 0, 0, 0); __builtin_amdgcn_s_setprio(0); } while (0)
#define PG8_WAIT_V(n) asm volatile("s_waitcnt vmcnt(" #n ")" ::: "memory")
#define PG8_WAIT_L(n) asm volatile("s_waitcnt lgkmcnt(" #n ")" ::: "memory")
#define PG8_BAR __builtin_amdgcn_s_barrier()
#define PG8_SCHED __builtin_amdgcn_sched_barrier(0)
    Unit cur, nxt; int ui = 0;
    if (!S.next(0, cur)) return;
    f32x4 acc[2][2][4][2];
#pragma unroll
    for (int a = 0; a < 2; ++a)
#pragma unroll
        for (int b = 0; b < 2; ++b)
#pragma unroll
            for (int m = 0; m < 4; ++m)
#pragma unroll
                for (int n = 0; n < 2; ++n) acc[a][b][m][n] = (f32x4){0.f, 0.f, 0.f, 0.f};
    bf16x8 At[4][2], B0[2][2], B1[2][2];
    const char* cA = (const char*)g.A + (size_t)cur.pm * tstep; const char* cB = (const char*)g.Bt + (size_t)cur.pn * tstep;
    S.a_ready(cur);
    if constexpr (SP2) {
        PG8_STAGE(PG8_SB(0, 0), cB, voffB); PG8_STAGE(PG8_SB(0, 1), cB + hstep, voffB); PG8_STAGE(PG8_SA(0, 0), cA, voffA); PG8_STAGE(PG8_SA(0, 1), cA + hstep, voffA);
        if (wr == 1) PG8_BAR;
        PG8_WAIT_V(2); PG8_BAR;
        PG8_STAGE(PG8_SB(1, 0), cB + kstep, voffB); PG8_STAGE(PG8_SA(1, 0), cA + kstep, voffA); PG8_STAGE(PG8_SB(1, 1), cB + hstep + kstep, voffB);
        PG8_WAIT_V(6); PG8_BAR;
    } else {
        PG8_STAGE(PG8_SB(0, 0), cB, voffB); PG8_STAGE(PG8_SA(0, 0), cA, voffA); PG8_STAGE(PG8_SB(0, 1), cB + hstep, voffB); PG8_STAGE(PG8_SA(0, 1), cA + hstep, voffA);
        if (wr == 1) PG8_BAR;
        PG8_WAIT_V(4); PG8_BAR;
        PG8_STAGE(PG8_SB(1, 0), cB + kstep, voffB); PG8_STAGE(PG8_SA(1, 0), cA + kstep, voffA); PG8_STAGE(PG8_SB(1, 1), cB + hstep + kstep, voffB);
        PG8_WAIT_V(6); PG8_BAR;
    }
    for (;;) {
        const bool has_next = S.next(ui + 1, nxt);
        const char* nA = has_next ? (const char*)g.A + (size_t)nxt.pm * tstep : cA; const char* nB = has_next ? (const char*)g.Bt + (size_t)nxt.pn * tstep : cB;
        for (int t = 0; t < nt; t += 2) {
            const bool last = (t == nt - 2);
            const char* a1 = cA + (size_t)(t + 1) * kstep;
            const char* a2 = last ? nA : cA + (size_t)(t + 2) * kstep; const char* b2 = last ? nB : cB + (size_t)(t + 2) * kstep;
            const char* a3 = a2 + kstep; const char* b3 = b2 + kstep;
            if (last && has_next) S.a_ready(nxt);
            if constexpr (SP2) {
            PG8_LDB(B0, 0, 0); PG8_LDB(B1, 0, 1); PG8_SCHED; PG8_LDA(At, 0, 0); PG8_STAGE(PG8_SA(1, 1), a1 + hstep, voffA);
            PG8_WAIT_V(8); PG8_WAIT_L(0); PG8_BAR; PG8_MMA(0, 0, At, B0); PG8_MMA(0, 1, At, B1); PG8_BAR; PG8_SCHED;
            PG8_LDA(At, 0, 1); PG8_STAGE(PG8_SB(0, 0), b2, voffB); PG8_STAGE(PG8_SB(0, 1), b2 + hstep, voffB); PG8_STAGE(PG8_SA(0, 0), a2, voffA);
            PG8_WAIT_V(8); PG8_WAIT_L(0); PG8_BAR; PG8_MMA(1, 0, At, B0); PG8_MMA(1, 1, At, B1); PG8_BAR; PG8_SCHED;
            PG8_LDB(B0, 1, 0); PG8_LDB(B1, 1, 1); PG8_SCHED; PG8_LDA(At, 1, 0); PG8_STAGE(PG8_SA(0, 1), a2 + hstep, voffA);
            PG8_WAIT_V(8); PG8_WAIT_L(0); PG8_BAR; PG8_MMA(0, 0, At, B0); PG8_MMA(0, 1, At, B1); PG8_BAR; PG8_SCHED;
            PG8_LDA(At, 1, 1); PG8_STAGE(PG8_SB(1, 0), b3, voffB); PG8_STAGE(PG8_SB(1, 1), b3 + hstep, voffB); PG8_STAGE(PG8_SA(1, 0), a3, voffA);
            PG8_WAIT_V(8); PG8_WAIT_L(0); PG8_BAR; PG8_MMA(1, 0, At, B0); PG8_MMA(1, 1, At, B1); PG8_BAR; PG8_SCHED;
            } else {
            PG8_LDB(B0, 0, 0); PG8_SCHED; PG8_LDA(At, 0, 0); PG8_STAGE(PG8_SA(1, 1), a1 + hstep, voffA);
            PG8_WAIT_L(8); PG8_BAR; PG8_WAIT_L(0); PG8_MMA(0, 0, At, B0); PG8_BAR; PG8_SCHED;
            PG8_LDB(B1, 0, 1); PG8_STAGE(PG8_SB(0, 0), b2, voffB);
            PG8_BAR; PG8_WAIT_L(0); PG8_MMA(0, 1, At, B1); PG8_BAR;
            PG8_LDA(At, 0, 1); PG8_STAGE(PG8_SA(0, 0), a2, voffA);
            PG8_BAR; PG8_WAIT_L(0); PG8_MMA(1, 0, At, B0); PG8_BAR; PG8_SCHED;
            PG8_STAGE(PG8_SB(0, 1), b2 + hstep, voffB);
            PG8_WAIT_V(6); PG8_BAR; PG8_MMA(1, 1, At, B1); PG8_BAR;
            PG8_LDB(B0, 1, 0); PG8_SCHED; PG8_LDA(At, 1, 0); PG8_STAGE(PG8_SA(0, 1), a2 + hstep, voffA);
            PG8_WAIT_L(8); PG8_BAR; PG8_WAIT_L(0); PG8_MMA(0, 0, At, B0); PG8_BAR; PG8_SCHED;
            PG8_LDB(B1, 1, 1); PG8_STAGE(PG8_SB(1, 0), b3, voffB);
            PG8_BAR; PG8_WAIT_L(0); PG8_MMA(0, 1, At, B1); PG8_BAR;
            PG8_LDA(At, 1, 1); PG8_STAGE(PG8_SA(1, 0), a3, voffA);
            PG8_BAR; PG8_WAIT_L(0); PG8_MMA(1, 0, At, B0); PG8_BAR; PG8_SCHED;
            PG8_STAGE(PG8_SB(1, 1), b3 + hstep, voffB);
            PG8_WAIT_V(6); PG8_BAR; PG8_MMA(1, 1, At, B1); PG8_BAR;
            }
        }
        if constexpr (ALIGN_EPI) { if (wr == 0) PG8_BAR; }
        if constexpr (!Epi::AFTER_DRAIN) { E(acc, cur, wr, wc, fr, fq); S.done(cur); }
        if (!has_next) break;
#pragma unroll
        for (int a = 0; a < 2; ++a)
#pragma unroll
            for (int b = 0; b < 2; ++b)
#pragma unroll
                for (int m = 0; m < 4; ++m)
#pragma unroll
                    for (int n = 0; n < 2; ++n) acc[a][b][m][n] = (f32x4){0.f, 0.f, 0.f, 0.f};
        cur = nxt; cA = nA; cB = nB; ++ui;
        if constexpr (ALIGN_EPI) { if (wr == 1) PG8_BAR; }
    }
    PG8_WAIT_V(0);
    if constexpr (!ALIGN_EPI) { if (wr == 0) PG8_BAR; }
    PG8_BAR;
    if constexpr (Epi::AFTER_DRAIN) { E.fused(acc, cur, wr, wc, fr, fq, lds, wid, lane); S.done(cur); }
#undef PG8_SA
#undef PG8_SB
#undef PG8_STAGE
#undef PG8_LDA
#undef PG8_LDB
#undef PG8_MMA
#undef PG8_WAIT_V
#undef PG8_WAIT_L
#undef PG8_BAR
#undef PG8_SCHED
}
}

constexpr size_t MiB = 1u << 20;
constexpr size_t WS_W = 0, W_LAYER = 40 * MiB;
constexpr size_t WO_GU1 = 0, WO_D1 = 11 * MiB, WO_IN = WO_D1 + 11 * MiB / 2, WO_OUT = WO_IN + 5 * MiB, WO_GU2 = WO_OUT + 2 * MiB, WO_D2 = WO_GU2 + 11 * MiB;
static_assert(WO_D2 + 11 * MiB / 2 == W_LAYER, "weight map");
constexpr size_t WS_XB = 160 * MiB;
constexpr size_t WS_ACT = 224 * MiB;
constexpr size_t WS_MIX = 400 * MiB;
constexpr size_t WS_ROPE = 464 * MiB;
constexpr size_t WS_SSQ = 476 * MiB;
constexpr size_t SSQ_SLOT = (size_t)MTOK * 16;
constexpr size_t WS_RGW = 474 * MiB;
constexpr size_t WS_AGG = 475 * MiB;
constexpr size_t WS_TS = 502 * MiB;
constexpr size_t WS_BAR = 504 * MiB;
constexpr size_t WS_END = 505 * MiB;
constexpr size_t PO_BYTES = (size_t)MTOK * 384 * 2;
constexpr size_t OB_PO4 = 0, OB_PO16 = PO_BYTES, OB_LSE4 = 2 * PO_BYTES, OB_LSE16 = OB_LSE4 + MiB;
static_assert(OB_LSE16 + MiB <= (size_t)MTOK * DM * 4, "partials fit the output buffer");

constexpr int LDS_BYTES = 147456;
constexpr int VROW = 144;

struct Args { const void* in[22]; float* out; unsigned char* ws; };
__device__ const float INV_TAB[32] = {1.000000000e+00f, 7.498942018e-01f, 5.623413324e-01f, 4.216965139e-01f, 3.162277639e-01f, 2.371373773e-01f, 1.778279394e-01f, 1.333521456e-01f, 1.000000015e-01f, 7.498942316e-02f, 5.623413250e-02f, 4.216964915e-02f, 3.162277490e-02f, 2.371373773e-02f, 1.778279431e-02f, 1.333521400e-02f, 9.999999776e-03f, 7.498942316e-03f, 5.623413250e-03f, 4.216964822e-03f, 3.162277630e-03f, 2.371373819e-03f, 1.778279431e-03f, 1.333521446e-03f, 1.000000047e-03f, 7.498941850e-04f, 5.623413017e-04f, 4.216965172e-04f, 3.162277571e-04f, 2.371373703e-04f, 1.778279402e-04f, 1.333521504e-04f};

#define MFMA32(a, b, c) __builtin_amdgcn_mfma_f32_32x32x16_bf16((a), (b), (c), 0, 0, 0)
__device__ __forceinline__ int crow(int reg, int h) { return (reg & 3) + 8 * (reg >> 2) + 4 * h; }

struct AttnOut { bf16_t* mix; bf16_t* po; float* lse; const bf16_t* po4; const bf16_t* po16; const float* lse4; const float* lse16; float sink; };

__device__ __forceinline__ void store_row16(bf16_t* rowp  , const u32x2 (&wv)[4], int kh) {
#pragma unroll
    for (int gp = 0; gp < 2; ++gp) {
        const u32x2 keep = kh ? wv[2 * gp + 1] : wv[2 * gp], send = kh ? wv[2 * gp] : wv[2 * gp + 1];
        u32x2 recv; recv.x = (unsigned)__shfl_xor((int)send.x, 32); recv.y = (unsigned)__shfl_xor((int)send.y, 32);
        u32x4 w; if (kh) { w.x = recv.x; w.y = recv.y; w.z = keep.x; w.w = keep.y; } else { w.x = keep.x; w.y = keep.y; w.z = recv.x; w.w = recv.y; }
        *(u32x4*)(rowp + 8 * (2 * gp + kh)) = w;
    }
}
template <int MODE>
__device__ __forceinline__ void attn_finish(const f32x16& O0, const f32x16& O1, float m2, float lsum, int tok, int ocol, int hidx, int kh, const AttnOut& AO) {
    const float l = lsum + __shfl_xor(lsum, 32);
    const float lse = (m2 + __log2f(l)) * 0.6931471805599453f;
    const float rl = fast_rcp(l);
    if (MODE == 0) {
        const float gate = fast_rcp(1.0f + __expf(AO.sink - lse)) * rl;
        bf16_t* op = AO.mix + (size_t)tok * DM + ocol;
        u32x2 w0[4], w1[4];
#pragma unroll
        for (int g = 0; g < 4; ++g) {
            w0[g].x = pk2(O0[4 * g] * gate, O0[4 * g + 1] * gate); w0[g].y = pk2(O0[4 * g + 2] * gate, O0[4 * g + 3] * gate);
            w1[g].x = pk2(O1[4 * g] * gate, O1[4 * g + 1] * gate); w1[g].y = pk2(O1[4 * g + 2] * gate, O1[4 * g + 3] * gate);
        }
        store_row16(op, w0, kh); store_row16(op + 32, w1, kh);
    } else if (MODE == 1) {
        bf16_t* op = AO.po + (size_t)tok * 384 + hidx * 64;
        u32x2 w0[4], w1[4];
#pragma unroll
        for (int g = 0; g < 4; ++g) {
            w0[g].x = pk2(O0[4 * g] * rl, O0[4 * g + 1] * rl); w0[g].y = pk2(O0[4 * g + 2] * rl, O0[4 * g + 3] * rl);
            w1[g].x = pk2(O1[4 * g] * rl, O1[4 * g + 1] * rl); w1[g].y = pk2(O1[4 * g + 2] * rl, O1[4 * g + 3] * rl);
        }
        store_row16(op, w0, kh); store_row16(op + 32, w1, kh);
        if (kh == 0) AO.lse[(size_t)tok * 6 + hidx] = lse;
    } else {
        const float l4 = AO.lse4[(size_t)tok * 6 + hidx], l16 = AO.lse16[(size_t)tok * 6 + hidx];
        const float mxl = fmaxf(lse, fmaxf(l4, l16));
        float w1 = __expf(lse - mxl), w4 = __expf(l4 - mxl), w16 = __expf(l16 - mxl);
        const float rs = fast_rcp(w1 + w4 + w16);
        w1 *= rs * rl; w4 *= rs; w16 *= rs;
        const bf16_t* p4 = AO.po4 + (size_t)tok * 384 + hidx * 64 + 4 * kh;
        const bf16_t* p16 = AO.po16 + (size_t)tok * 384 + hidx * 64 + 4 * kh;
        bf16_t* op = AO.mix + (size_t)tok * DM + ocol;
        u32x2 wq[2][4];
#pragma unroll
        for (int g = 0; g < 4; ++g) {
#pragma unroll
            for (int mt = 0; mt < 2; ++mt) {
                const u32x2 a = *(const u32x2*)(p4 + 32 * mt + 8 * g), b = *(const u32x2*)(p16 + 32 * mt + 8 * g);
                float o[4];
#pragma unroll
                for (int e = 0; e < 4; ++e) o[e] = (mt ? O1[4 * g + e] : O0[4 * g + e]) * w1;
                o[0] += bflo(a.x) * w4 + bflo(b.x) * w16; o[1] += bfhi(a.x) * w4 + bfhi(b.x) * w16;
                o[2] += bflo(a.y) * w4 + bflo(b.y) * w16; o[3] += bfhi(a.y) * w4 + bfhi(b.y) * w16;
                wq[mt][g].x = pk2(o[0], o[1]); wq[mt][g].y = pk2(o[2], o[3]);
            }
        }
        store_row16(op, wq[0], kh); store_row16(op + 32, wq[1], kh);
    }
}

struct AttnGeom { int tokb, dil, u0, qcol, kcol, vcol, ocol, hidx, maxd, mode; float sink; bf16_t* po; float* lse; };
constexpr int KV_ROWS = 384, VIMG_OFF = KV_ROWS * VROW;

__device__ __forceinline__ void kv_fetch(const bf16_t* __restrict__ P, const AttnGeom& G, int tid, bf16x8 (&kv)[12], bf16x8 (&qn)[4], int wave, int lane) {
    const int piece = tid & 7, rb = tid >> 3;
#pragma unroll
    for (int i = 0; i < 12; ++i) {
        const int row = rb + 64 * (i % 6), u = G.u0 - 128 + row;
        if (u >= 0) kv[i] = *(const bf16x8*)(P + (size_t)(G.tokb + G.dil * u) * PP + (i < 6 ? G.kcol : G.vcol) + 8 * piece);
    }
    const bf16_t* qp = P + (size_t)(G.tokb + G.dil * (G.u0 + 32 * wave + (lane & 31))) * PP + G.qcol + 8 * (lane >> 5);
#pragma unroll
    for (int ks = 0; ks < 4; ++ks) qn[ks] = *(const bf16x8*)(qp + 16 * ks);
}
__device__ __forceinline__ void kv_store(LAS unsigned char* lds, int tid, const bf16x8 (&kv)[12]) {
    const int piece = tid & 7, rb = tid >> 3;
#pragma unroll
    for (int i = 0; i < 12; ++i) *(LAS bf16x8*)(lds + (i < 6 ? 0 : VIMG_OFF) + (rb + 64 * (i % 6)) * VROW + 16 * piece) = kv[i];
}

__device__ __forceinline__ void attn_wave(LAS unsigned char* lds, const AttnGeom& G, const bf16x8 (&qf)[4], int wave, int lane, const AttnOut& AO0) {
    const int r = lane & 31, kh = lane >> 5;
    const int u0w = G.u0 + 32 * wave;
    f32x16 O0, O1;
#pragma unroll
    for (int j = 0; j < 16; ++j) { O0[j] = 0.f; O1[j] = 0.f; }
    float m2 = -INFINITY, lsum = 0.f;
    const int trlane = ((4 * kh + ((lane & 15) >> 2)) * VROW + 32 * ((lane >> 4) & 1) + 8 * (lane & 3));
    for (int kt = (u0w >= 128 ? 0 : (128 - u0w) >> 5); kt < 5; ++kt) {
        const int ks0 = u0w - 128 + 32 * kt, lrow0 = 32 * wave + 32 * kt;
        bf16x8 kf[4];
        { const LAS unsigned char* kp = lds + (lrow0 + r) * VROW + 16 * kh;
#pragma unroll
          for (int ks = 0; ks < 4; ++ks) kf[ks] = *(const LAS bf16x8*)(kp + 32 * ks); }
        f32x16 S;
#pragma unroll
        for (int j = 0; j < 16; ++j) S[j] = 0.f;
#pragma unroll
        for (int ks = 0; ks < 4; ++ks) S = MFMA32(kf[ks], qf[ks], S);
        if (kt == 0 || kt == 4) {
            const int uq = u0w + r;
#pragma unroll
            for (int j = 0; j < 16; ++j) { const int diff = uq - (ks0 + crow(j, kh)); if (diff < 0 || diff > G.maxd) S[j] = -INFINITY; }
        }
        float mx = S[0];
#pragma unroll
        for (int j = 1; j < 16; ++j) mx = fmaxf(mx, S[j]);
        mx = fmaxf(mx, __shfl_xor(mx, 32));
        const float mnew = fmaxf(m2, mx);
        const float msafe = (mnew == -INFINITY) ? 0.f : mnew;
        const float alpha = fast_exp2(m2 - msafe);
        m2 = mnew;
        float ps = 0.f;
#pragma unroll
        for (int j = 0; j < 16; ++j) { S[j] = fast_exp2(S[j] - msafe); ps += S[j]; }
        lsum = lsum * alpha + ps;
#pragma unroll
        for (int j = 0; j < 16; ++j) { O0[j] *= alpha; O1[j] *= alpha; }
        bf16x8 pf[2];
#pragma unroll
        for (int s = 0; s < 2; ++s) { u32x4 w; w.x = pk2(S[8 * s], S[8 * s + 1]); w.y = pk2(S[8 * s + 2], S[8 * s + 3]); w.z = pk2(S[8 * s + 4], S[8 * s + 5]); w.w = pk2(S[8 * s + 6], S[8 * s + 7]); pf[s] = __builtin_bit_cast(bf16x8, w); }
        LAS s16x4* vt = (LAS s16x4*)(lds + VIMG_OFF + lrow0 * VROW + trlane);
#define TRR(BYTES) __builtin_amdgcn_ds_read_tr16_b64_v4i16(vt + (BYTES) / 8)
        const bf16x8 v00 = __builtin_shufflevector(TRR(0), TRR(1152), 0, 1, 2, 3, 4, 5, 6, 7), v01 = __builtin_shufflevector(TRR(2304), TRR(3456), 0, 1, 2, 3, 4, 5, 6, 7);
        const bf16x8 v10 = __builtin_shufflevector(TRR(64), TRR(1216), 0, 1, 2, 3, 4, 5, 6, 7), v11 = __builtin_shufflevector(TRR(2368), TRR(3520), 0, 1, 2, 3, 4, 5, 6, 7);
#undef TRR
        O0 = MFMA32(v00, pf[0], O0); O0 = MFMA32(v01, pf[1], O0);
        O1 = MFMA32(v10, pf[0], O1); O1 = MFMA32(v11, pf[1], O1);
    }
    AttnOut AO = AO0; AO.sink = G.sink; AO.po = G.po; AO.lse = G.lse;
    const int tok = G.tokb + G.dil * (u0w + r);
    if (G.mode == 0) attn_finish<0>(O0, O1, m2, lsum, tok, G.ocol, G.hidx, kh, AO);
    else if (G.mode == 1) attn_finish<1>(O0, O1, m2, lsum, tok, G.ocol, G.hidx, kh, AO);
    else attn_finish<2>(O0, O1, m2, lsum, tok, G.ocol, G.hidx, kh, AO);
}

struct RgParams { const bf16_t* P; const int* pos; const float* conv_w; const float* conv_b; const bf16_t* wrT; const bf16_t* wiT; const float* b_r; const float* b_i; const float* lam; float* agg; bf16_t* mix; };

template <bool FINAL>
__device__ __forceinline__ void rglru_item(const RgParams& R, int sc, int h, int nt, int lane, LAS unsigned char* yimg) {
    const int r = lane & 31, kh = lane >> 5;
    const int tok_sc = sc * 128, bstart = (sc >> 7) * 128;
    const int ncol = 32 * nt + r, cg = 64 * h + ncol;
    const float br = R.b_r[cg], bi = R.b_i[cg], sp8l = -8.0f * 1.4426950408889634f * log1pf(expf(-R.lam[cg]));
    float carry = 0.f, atot = 1.f;
    if (FINAL) {
        const float* ag = R.agg + (size_t)cg * 2; int s = bstart;
        for (; s + 8 <= sc; s += 8) {
            f32x2 ab[8];
#pragma unroll
            for (int i = 0; i < 8; ++i) ab[i] = *(const f32x2*)(ag + (size_t)(s + i) * 768);
#pragma unroll
            for (int i = 0; i < 8; ++i) carry = ab[i].x * carry + ab[i].y;
        }
        for (; s < sc; ++s) { const f32x2 ab = *(const f32x2*)(ag + (size_t)s * 768); carry = ab.x * carry + ab.y; }
    }
    const int cc = 64 * h + lane;
    const float cw0 = R.conv_w[cc], cw1 = R.conv_w[384 + cc], cw2 = R.conv_w[768 + cc], cw3 = R.conv_w[1152 + cc], cb = R.conv_b[cc];
    unsigned short xr[32];
    const unsigned goff = (unsigned)(4 * kh * PP + ncol);
    float xm1 = 0.f, xm2 = 0.f, xm3 = 0.f;
    { const bf16_t* xp = R.P + (size_t)tok_sc * PP + PC_XC + 64 * h;
      if ((tok_sc & (SEQ - 1)) != 0) { xm1 = bf2f((xp - 1 * PP)[lane]); xm2 = bf2f((xp - 2 * PP)[lane]); xm3 = bf2f((xp - 3 * PP)[lane]); }
#pragma unroll
      for (int t = 0; t < 32; ++t) xr[t] = (xp + (size_t)t * PP)[lane]; }
    for (int mt = 0; mt < 4; ++mt) {
        const int t0 = tok_sc + 32 * mt;
        bf16x8 yf[4];
        {
#pragma unroll
          for (int t = 0; t < 32; ++t) {
              const float x0 = bf2f(xr[t]);
              const float y = cb + cw0 * x0 + cw1 * xm1 + cw2 * xm2 + cw3 * xm3;
              *(LAS bf16_t*)(yimg + t * VROW + 2 * lane) = (bf16_t)(pk2(y, 0.f) & 0xffffu);
              xm3 = xm2; xm2 = xm1; xm1 = x0;
          }
          if (mt < 3) { const bf16_t* xp = R.P + (size_t)(t0 + 32) * PP + PC_XC + 64 * h;
#pragma unroll
              for (int t = 0; t < 32; ++t) xr[t] = (xp + (size_t)t * PP)[lane]; }
#pragma unroll
          for (int ks = 0; ks < 4; ++ks) yf[ks] = *(const LAS bf16x8*)(yimg + r * VROW + 32 * ks + 16 * kh);
        }
        unsigned short graw[16];
        if (FINAL) {
#pragma unroll
            for (int j = 0; j < 16; ++j) graw[j] = (R.P + (size_t)(t0 + (j & 3) + 8 * (j >> 2)) * PP + PC_GC + 64 * h)[goff];
        }
        unsigned rmask = 0u;
#pragma unroll
        for (int g = 0; g < 4; ++g) { const int4 p4 = *(const int4*)(R.pos + t0 + 8 * g + 4 * kh);
            rmask |= (p4.x == 0 ? 1u : 0u) << (4 * g); rmask |= (p4.y == 0 ? 1u : 0u) << (4 * g + 1); rmask |= (p4.z == 0 ? 1u : 0u) << (4 * g + 2); rmask |= (p4.w == 0 ? 1u : 0u) << (4 * g + 3); }
        f32x16 ra, ia, ya;
#pragma unroll
        for (int j = 0; j < 16; ++j) { ra[j] = 0.f; ia[j] = 0.f; ya[j] = 0.f; }
        int ncl = ncol; asm volatile("" : "+v"(ncl));
#pragma unroll
        for (int ks = 0; ks < 4; ++ks) {
            const size_t wo = ((size_t)h * 64 + ncl) * 64 + 16 * ks + 8 * kh;
            const bf16x8 wrf = *(const bf16x8*)(R.wrT + wo), wif = *(const bf16x8*)(R.wiT + wo);
            bf16x8 idf;
#pragma unroll
            for (int i = 0; i < 8; ++i) idf[i] = (16 * ks + 8 * kh + i == ncl) ? (short)0x3f80 : (short)0;
            ra = MFMA32(yf[ks], wrf, ra); ia = MFMA32(yf[ks], wif, ia); ya = MFMA32(yf[ks], idf, ya);
        }
        float av[16], bv[16];
#pragma unroll
        for (int j = 0; j < 16; ++j) {
            const float rr = sigmoidf_(ra[j] + br), ii = sigmoidf_(ia[j] + bi);
            const float a_ = fast_exp2(sp8l * rr);
            float a = a_, mult = __builtin_amdgcn_sqrtf(1.0f - a_ * a_);
            if ((rmask >> j) & 1u) { a = 0.f; mult = 1.f; }
            av[j] = a; bv[j] = mult * ii * ya[j];
        }
        float sa[4], sb[4], pa[4], pb[4];
#pragma unroll
        for (int g = 0; g < 4; ++g) {
            sa[g] = (av[4 * g] * av[4 * g + 1]) * (av[4 * g + 2] * av[4 * g + 3]);
            sb[g] = ((bv[4 * g] * av[4 * g + 1] + bv[4 * g + 1]) * av[4 * g + 2] + bv[4 * g + 2]) * av[4 * g + 3] + bv[4 * g + 3];
            pa[g] = __shfl_xor(sa[g], 32); pb[g] = __shfl_xor(sb[g], 32);
        }
        float c = carry, cin[4], apr = 1.f;
#pragma unroll
        for (int g = 0; g < 4; ++g) {
            const float a0 = kh ? pa[g] : sa[g], b0 = kh ? pb[g] : sb[g], a1 = kh ? sa[g] : pa[g], b1 = kh ? sb[g] : pb[g];
            const float ce = c; c = a0 * c + b0;
            const float co = c; c = a1 * c + b1;
            cin[g] = kh ? co : ce; apr *= a0 * a1;
        }
        carry = c; atot *= apr;
        if (FINAL) {
#pragma unroll
            for (int g = 0; g < 4; ++g) {
                float hp = cin[g];
#pragma unroll
                for (int e = 0; e < 4; ++e) {
                    const int j = 4 * g + e, tok = t0 + crow(j, kh);
                    hp = av[j] * hp + bv[j];
                    const float gt = bf2f(graw[j]);
                    const float z = 0.7978845608028654f * (gt + 0.044715f * gt * gt * gt);
                    const float th = 1.0f - 2.0f * fast_rcp(__expf(2.0f * z) + 1.0f);
                    const float o = hp * 0.5f * gt * (1.0f + th);
                    *(LAS bf16_t*)(yimg + 4608 + crow(j, kh) * 80 + 2 * r) = (bf16_t)(pk2(o, 0.f) & 0xffffu);
                    (void)tok;
                }
            }
#pragma unroll
            for (int q = 0; q < 2; ++q) {
                const int p = lane + 64 * q, tk = p >> 2, qu = p & 3;
                const u32x4 w = *(const LAS u32x4*)(yimg + 4608 + tk * 80 + 16 * qu);
                *(u32x4*)(R.mix + (size_t)(t0 + tk) * DM + 640 + 64 * h + 32 * nt + 8 * qu) = w;
            }
        }
    }
    if (!FINAL && kh == 0) { f32x2 ab = {atot, carry}; *(f32x2*)(R.agg + ((size_t)sc * 384 + cg) * 2) = ab; }
}

struct MapPlain { const float* w; int ld; __device__ __forceinline__ const float* operator()(int R) const { return w + R; } };
struct MapGU { const float* gate; const float* up; int ld;
    __device__ __forceinline__ const float* operator()(int R) const { const int j = 128 * (R >> 8) + (R & 127); const uintptr_t a = (uintptr_t)gate, b = (uintptr_t)up, sel = (uintptr_t)0 - (uintptr_t)((R >> 7) & 1); return (const float*)(a ^ ((a ^ b) & sel)) + j; } };
struct MapIN { const float* w; int ld;
    __device__ __forceinline__ const float* operator()(int R) const {
        int c = R;
        if (R < PC_VA || (R >= PC_QB && R < PC_VB)) { const int q = R & 63; c = (R & ~63) + 32 * ((q >> 2) & 1) + 16 * ((q >> 5) & 1) + 4 * ((q >> 3) & 3) + (q & 3); }
        if (c >= 1664 && c < PC_XC) return nullptr;
        if (c >= PC_XC) c -= 128;
        return w + c; } };

template <class Map>
__device__ __forceinline__ void transpose_item(const Map mp, int K, int N, bf16_t* WT, const float* gain, LAS float* scr, int item, int lane) {
    const int nblk = N / 32, kb = item / nblk, nb = item % nblk, k0 = 64 * kb, n0 = 32 * nb;
    const float* src = mp(n0 + (lane & 31));
    float v[32];
#pragma unroll
    for (int i = 0; i < 32; ++i) { const int kk = 2 * i + (lane >> 5); v[i] = src ? src[(size_t)(k0 + kk) * mp.ld] : 0.f; }
#pragma unroll
    for (int i = 0; i < 32; ++i) { const int kk = 2 * i + (lane >> 5); float t = v[i]; if (gain) t *= gain[k0 + kk]; scr[kk * 33 + (lane & 31)] = t; }
    asm volatile("s_waitcnt lgkmcnt(0)" ::: "memory");
    const int c = lane & 7;
#pragma unroll
    for (int j = 0; j < 4; ++j) { const int n = (lane >> 3) + 8 * j; const LAS float* s = scr + (8 * c) * 33 + n;
        u32x4 o; o.x = pk2(s[0 * 33], s[1 * 33]); o.y = pk2(s[2 * 33], s[3 * 33]); o.z = pk2(s[4 * 33], s[5 * 33]); o.w = pk2(s[6 * 33], s[7 * 33]);
        *(u32x4*)(WT + (size_t)(n0 + n) * K + k0 + 8 * c) = o; }
    asm volatile("s_waitcnt lgkmcnt(0)" ::: "memory");
}

__device__ __forceinline__ float wave_sum(float v) {
#pragma unroll
    for (int o = 1; o < 64; o <<= 1) v += __shfl_xor(v, o);
    return v;
}

__device__ __forceinline__ void sincos_d(double a, float& c, float& s) {
    const double n = rint(a * 0.6366197723675814);
    double t = fma(-n, 1.5707963267948966, a); t = fma(-n, 6.123233995736766e-17, t);
    const double t2 = t * t;
    double sp = -1.0 / 1307674368000.0; sp = sp * t2 + 1.0 / 6227020800.0; sp = sp * t2 - 1.0 / 39916800.0; sp = sp * t2 + 1.0 / 362880.0; sp = sp * t2 - 1.0 / 5040.0; sp = sp * t2 + 1.0 / 120.0; sp = sp * t2 - 1.0 / 6.0; sp = sp * t2 + 1.0;
    const double sn = sp * t;
    double cp = 1.0 / 20922789888000.0; cp = cp * t2 - 1.0 / 87178291200.0; cp = cp * t2 + 1.0 / 479001600.0; cp = cp * t2 - 1.0 / 3628800.0; cp = cp * t2 + 1.0 / 40320.0; cp = cp * t2 - 1.0 / 720.0; cp = cp * t2 + 1.0 / 24.0; cp = cp * t2 - 0.5; cp = cp * t2 + 1.0;
    const int q = (int)((long long)n & 3);
    const double cc = (q == 0) ? cp : (q == 1) ? -sn : (q == 2) ? -cp : sn;
    const double ss = (q == 0) ? sn : (q == 1) ? cp : (q == 2) ? -sn : -cp;
    c = (float)cc; s = (float)ss;
}

typedef const __attribute__((address_space(4))) Args* KArgs;
__device__ __forceinline__ KArgs kargs() { KArgs p = (KArgs)__builtin_amdgcn_kernarg_segment_ptr(); asm volatile("" : "+s"(p)); return p; }
#define IN_F(k) ((const float*)ap->in[k])
__device__ __forceinline__ int fresh_tid(int wave0) { int t = wave0 * 64 + (int)__builtin_amdgcn_mbcnt_hi(~0u, __builtin_amdgcn_mbcnt_lo(~0u, 0u)); asm volatile("" : "+v"(t)); return t; }

template <int WHICH>
__device__ __forceinline__ void gemm_stage(LAS unsigned char* lds, int l, int ffn, int wave0) {
    KArgs ap = kargs();
    unsigned char* ws = ap->ws; const int G = gridDim.x;
    unsigned char* wl = ws + WS_W + (size_t)l * W_LAYER;
    bf16_t* XB = (bf16_t*)(ws + WS_XB); bf16_t* ACT = (bf16_t*)(ws + WS_ACT); float* ssq0 = (float*)(ws + WS_SSQ) + (size_t)(3 * l) * SSQ_SLOT;
    if (WHICH == 0) {
        pg8::Gemm g{XB, (const bf16_t*)(wl + (ffn ? WO_GU2 : WO_GU1)), MTOK, NGU, DM}; pg8::StaticOrder S; S.init(MTOK, NGU, G, (int)blockIdx.x);
        pg8::EpiGateUp E{ssq0 + (ffn ? 2 * SSQ_SLOT : 0), ACT, lds + 131072 + 256, (3 * l + (ffn ? 2 : 0)) * 256};
        pg8::gemm_phase<pg8::EpiGateUp, pg8::StaticOrder, true, true>(lds, g, S, E, fresh_tid(wave0));
    } else if (WHICH == 1) {
        pg8::Gemm g{ACT, (const bf16_t*)(wl + (ffn ? WO_D2 : WO_D1)), MTOK, DM, FF}; pg8::StaticOrder S; S.init(MTOK, DM, G, (int)blockIdx.x);
        pg8::EpiResidual E{XB, ssq0 + (ffn ? 3 * SSQ_SLOT : SSQ_SLOT), 0.5f};
        pg8::gemm_phase<pg8::EpiResidual, pg8::StaticOrder, true, true>(lds, g, S, E, fresh_tid(wave0));
    } else if (WHICH == 2) {
        float* cosT = (float*)(ws + WS_ROPE);
        pg8::Gemm g{XB, (const bf16_t*)(wl + WO_IN), MTOK, NIN, DM}; pg8::StaticOrder S; S.init(MTOK, NIN, G, (int)blockIdx.x);
        pg8::EpiProj E{ssq0 + SSQ_SLOT, cosT, cosT + (size_t)MTOK * 32, ACT, lds + 131072 + 256, (3 * l + 1) * 256};
        pg8::gemm_phase<pg8::EpiProj, pg8::StaticOrder, true, true>(lds, g, S, E, fresh_tid(wave0));
    } else {
        pg8::Gemm g{(const bf16_t*)(ws + WS_MIX), (const bf16_t*)(wl + WO_OUT), MTOK, DM, DM}; pg8::StaticOrder S; S.init(MTOK, DM, G, (int)blockIdx.x);
        pg8::EpiResidual E{XB, ssq0 + 2 * SSQ_SLOT, 1.0f};
        pg8::gemm_phase<pg8::EpiResidual, pg8::StaticOrder, true, true>(lds, g, S, E, fresh_tid(wave0));
    }
}

__device__ __forceinline__ void prologue_stage(LAS unsigned char* lds, int wave0) {
    KArgs ap = kargs(); const int tid = fresh_tid(wave0), lane = tid & 63, wave = __builtin_amdgcn_readfirstlane(tid >> 6);
    unsigned char* ws = ap->ws; const int G = gridDim.x, gw = blockIdx.x * 8 + wave, NGW = G * 8;
    LAS float* scr = (LAS float*)(lds + wave * 16384);
    constexpr int I_GU = (DM / 64) * (NGU / 32), I_D = (FF / 64) * (DM / 32), I_IN = (DM / 64) * (NIN / 32), I_OUT = (DM / 64) * (DM / 32);
    constexpr int I_LAYER = 2 * I_GU + 2 * I_D + I_IN + I_OUT;
    for (int it = gw; it < DEPTH * I_LAYER; it += NGW) {
        const int l = it / I_LAYER; int r = it % I_LAYER;
        unsigned char* wl = ws + WS_W + (size_t)l * W_LAYER;
        if (r < I_GU) { MapGU mp{IN_F(3) + (size_t)l * DM * FF, IN_F(4) + (size_t)l * DM * FF, FF};
            transpose_item(mp, DM, NGU, (bf16_t*)(wl + WO_GU1), IN_F(2) + l * DM, scr, r, lane); continue; } r -= I_GU;
        if (r < I_D) { MapPlain mp{IN_F(5) + (size_t)l * FF * DM, DM};
            transpose_item(mp, FF, DM, (bf16_t*)(wl + WO_D1), nullptr, scr, r, lane); continue; } r -= I_D;
        if (r < I_IN) { MapIN mp{IN_F(7) + (size_t)l * DM * INC, INC};
            transpose_item(mp, DM, NIN, (bf16_t*)(wl + WO_IN), IN_F(6) + l * DM, scr, r, lane); continue; } r -= I_IN;
        if (r < I_OUT) { MapPlain mp{IN_F(16) + (size_t)l * DM * DM, DM};
            transpose_item(mp, DM, DM, (bf16_t*)(wl + WO_OUT), nullptr, scr, r, lane); continue; } r -= I_OUT;
        if (r < I_GU) { MapGU mp{IN_F(18) + (size_t)l * DM * FF, IN_F(19) + (size_t)l * DM * FF, FF};
            transpose_item(mp, DM, NGU, (bf16_t*)(wl + WO_GU2), IN_F(17) + l * DM, scr, r, lane); continue; } r -= I_GU;
        { MapPlain mp{IN_F(20) + (size_t)l * FF * DM, DM};
            transpose_item(mp, FF, DM, (bf16_t*)(wl + WO_D2), nullptr, scr, r, lane); }
    }
    const int gt = blockIdx.x * 512 + tid, NGT = G * 512;
    { const int* positions = (const int*)ap->in[1]; float* cosT = (float*)(ws + WS_ROPE); float* sinT = cosT + (size_t)MTOK * 32;
      for (int i = gt; i < MTOK * 32; i += NGT) {
          const int tok = i >> 5, k = i & 31;
          const float ang = (float)positions[tok] * INV_TAB[k];
          float c, s; sincos_d((double)ang, c, s);
          cosT[i] = c; sinT[i] = s;
      } }
    { float* SSQ = (float*)(ws + WS_SSQ);
      const float* x_in = IN_F(0); bf16_t* XB = (bf16_t*)(ws + WS_XB);
      for (int m = gw; m < MTOK; m += NGW) {
          const f32x4* xr = (const f32x4*)(x_in + (size_t)m * DM) + lane; float s = 0.f;
          unsigned long long* o8 = (unsigned long long*)(XB + (size_t)m * DM) + lane;
#pragma unroll
          for (int j = 0; j < 4; ++j) { const f32x4 v = xr[64 * j]; s += (v.x * v.x + v.y * v.y) + (v.z * v.z + v.w * v.w);
              o8[64 * j] = (unsigned long long)pk2(v.x, v.y) | ((unsigned long long)pk2(v.z, v.w) << 32); }
          s = wave_sum(s);
          if (lane < 16) SSQ[(size_t)m * 16 + lane] = lane == 0 ? s : 0.f;
      } }
    { bf16_t* RGW = (bf16_t*)(ws + WS_RGW); const float* wr = IN_F(11); const float* wi = IN_F(13);
      for (int i = gt; i < DEPTH * 2 * 6 * 4096; i += NGT) {
          const int ii = i & 63, j = (i >> 6) & 63, h = (i >> 12) % 6, gl = i / (6 * 4096), g = gl & 1, l = gl >> 1;
          const size_t so = ((size_t)(l * 6 + h) * 64 + ii) * 64 + j;
          const float v = g ? wi[so] : wr[so];
          RGW[i] = (bf16_t)(pk2(v, 0.f) & 0xffffu);
      } }
}

template <int SUB>
__device__ __forceinline__ void mixer_rg(LAS unsigned char* lds, int l, int wave0) {
    KArgs ap = kargs(); const int tid = fresh_tid(wave0), lane = tid & 63, wave = __builtin_amdgcn_readfirstlane(tid >> 6);
    unsigned char* ws = ap->ws; const int gw = blockIdx.x * 8 + wave, NGW = gridDim.x * 8;
    bf16_t* RGW = (bf16_t*)(ws + WS_RGW);
    RgParams RP{(const bf16_t*)(ws + WS_ACT), (const int*)ap->in[1], IN_F(9) + (size_t)l * 4 * 384, IN_F(10) + l * 384,
                RGW + (size_t)(l * 2 + 0) * 6 * 4096, RGW + (size_t)(l * 2 + 1) * 6 * 4096,
                IN_F(12) + l * 384, IN_F(14) + l * 384, IN_F(15) + l * 384, (float*)(ws + WS_AGG), (bf16_t*)(ws + WS_MIX)};
    LAS unsigned char* yimg = lds + wave * 8192;
    constexpr int N_RG = 256 * 12;
    for (int it = gw; it < N_RG; it += NGW) rglru_item<SUB == 1>(RP, it / 12, (it % 12) >> 1, it & 1, lane, yimg);
}
template <int SUB>
__device__ __forceinline__ void mixer_attn(LAS unsigned char* lds, int l, int wave0) {
    KArgs ap = kargs(); const int tid = fresh_tid(wave0), lane = tid & 63, wave = __builtin_amdgcn_readfirstlane(tid >> 6);
    unsigned char* ws = ap->ws; const int G = gridDim.x;
    const bf16_t* PB = (const bf16_t*)(ws + WS_ACT);
    unsigned char* obp = (unsigned char*)ap->out;
    AttnOut AO{(bf16_t*)(ws + WS_MIX), nullptr, nullptr, (const bf16_t*)(obp + OB_PO4), (const bf16_t*)(obp + OB_PO16), (const float*)(obp + OB_LSE4), (const float*)(obp + OB_LSE16), 0.f};
    const float* sinks = IN_F(8) + l * 4;
    auto geom = [&](int j) -> AttnGeom {
        AttnGeom g; g.sink = 0.f; g.po = nullptr; g.lse = nullptr; g.ocol = 0;
        if (SUB == 0) {
            const int br = j / 768, rr = j % 768, dil = br ? 16 : 4, nblk = SEQ / dil / 256;
            const int qb = rr % nblk, rho = (rr / nblk) % dil, bh = rr / (nblk * dil), h = bh % 6, b = bh / 6;
            g.tokb = b * SEQ + rho; g.dil = dil; g.u0 = qb * 256; g.qcol = PC_QB + 64 * h; g.kcol = PC_KB + 64 * h; g.vcol = PC_VB + 64 * h; g.hidx = h; g.maxd = 128; g.mode = 1;
            g.po = (bf16_t*)(obp + (br ? OB_PO16 : OB_PO4)); g.lse = (float*)(obp + (br ? OB_LSE16 : OB_LSE4));
        } else if (j < 512) {
            const int qb = j % 64, bhq = j / 64, hq = bhq % 4, b = bhq / 4, kv = hq >> 1;
            g.tokb = b * SEQ; g.dil = 1; g.u0 = qb * 256; g.qcol = PC_QA + 64 * hq; g.kcol = PC_KA + 64 * kv; g.vcol = PC_VA + 64 * kv; g.ocol = 64 * hq; g.hidx = hq; g.maxd = 127; g.mode = 0;
            g.sink = sinks[hq];
        } else {
            const int rr = j - 512, qb = rr % 64, bh = rr / 64, h = bh % 6, b = bh / 6;
            g.tokb = b * SEQ; g.dil = 1; g.u0 = qb * 256; g.qcol = PC_QB + 64 * h; g.kcol = PC_KB + 64 * h; g.vcol = PC_VB + 64 * h; g.ocol = 256 + 64 * h; g.hidx = h; g.maxd = 128; g.mode = 2;
        }
        return g;
    };
    constexpr int N_ATT = SUB == 0 ? 1536 : 1280;
    asm volatile("s_waitcnt lgkmcnt(0)" ::: "memory"); __builtin_amdgcn_s_barrier();
    int j = blockIdx.x; asm volatile("" : "+s"(j));
    if (j < N_ATT) {
        bf16x8 kv[12], qn[4];
        AttnGeom g = geom(j);
        kv_fetch(PB, g, tid, kv, qn, wave, lane);
        for (;;) {
            kv_store(lds, tid, kv);
            bf16x8 qf[4];
#pragma unroll
            for (int i = 0; i < 4; ++i) qf[i] = qn[i];
            asm volatile("s_waitcnt lgkmcnt(0)" ::: "memory"); __builtin_amdgcn_s_barrier(); asm volatile("" ::: "memory");
            const int jn = j + G; const bool more = jn < N_ATT;
            AttnGeom gn = g;
            if (more) { gn = geom(jn); kv_fetch(PB, gn, tid, kv, qn, wave, lane); }
            attn_wave(lds, g, qf, wave, lane, AO);
            asm volatile("" ::: "memory"); __builtin_amdgcn_s_barrier(); asm volatile("" ::: "memory");
            if (!more) break;
            g = gn; j = jn;
        }
    }
}
template <int SUB>
__device__ __forceinline__ void mixer_stage(LAS unsigned char* lds, int l, int wave0) { mixer_rg<SUB>(lds, l, wave0); mixer_attn<SUB>(lds, l, wave0); }

#define XB_TMO      128
#define XB_XCNT(j)  (256  + 64 * (j))
#define XB_XSUB(j)  (1280 + 64 * (j))
#define XB_XGEN(j)  (2304 + 64 * (j))
#define XB_TOP      3328
#define XB_TOPGEN   3392
#define XCD_BAR_WORDS 3456
#define XB_SPIN_CAP (1u << 18)

__device__ __forceinline__ unsigned xb_ld(unsigned* p)              { return __hip_atomic_load(p, __ATOMIC_RELAXED, __HIP_MEMORY_SCOPE_AGENT); }
__device__ __forceinline__ unsigned xb_add(unsigned* p, unsigned v) { return __hip_atomic_fetch_add(p, v, __ATOMIC_RELAXED, __HIP_MEMORY_SCOPE_AGENT); }
__device__ __forceinline__ unsigned xb_xcc_id() { return (unsigned)__builtin_amdgcn_s_getreg((3 << 11) | 20) & 0xFu; }
#define XB_SPIN(cond, bar) do { unsigned _sp = 0; while (cond) { __builtin_amdgcn_s_sleep(1); \
    if ((++_sp & 255u) == 0u) { if (xb_ld(&(bar)[XB_TMO])) break; if (_sp > XB_SPIN_CAP) { atomicAdd(&(bar)[XB_TMO], 1u); break; } } } } while (0)

struct XcdBarrier {
    unsigned* bar; unsigned x; bool lead;
    volatile LAS unsigned* st;
};

__device__ __forceinline__ XcdBarrier xcd_barrier_post(unsigned* bar, volatile LAS unsigned* st, bool lead) {
    XcdBarrier b; b.bar = bar; b.x = xb_xcc_id(); b.st = st; b.lead = lead;
    if (lead) (void)xb_add(&bar[XB_XCNT(b.x)], 1u);
    return b;
}
__device__ __forceinline__ void xcd_barrier_complete(unsigned* bar, unsigned x, unsigned& nloc, unsigned& nx) {
    const unsigned G = gridDim.x * gridDim.y * gridDim.z;
    unsigned sum, cnt, mine, sp = 0u;
    for (;;) {
        sum = 0u; cnt = 0u; mine = 0u;
#pragma unroll
        for (unsigned j = 0; j < 16; ++j) { const unsigned c = xb_ld(&bar[XB_XCNT(j)]); sum += c; cnt += (c > 0u) ? 1u : 0u; mine = (j == x) ? c : mine; }
        if (sum == G) break;
        __builtin_amdgcn_s_sleep(1);
        if ((++sp & 255u) == 0u) { if (xb_ld(&bar[XB_TMO])) break; if (sp > XB_SPIN_CAP) { atomicAdd(&bar[XB_TMO], 1u); break; } }
    }
    nloc = mine > 0u ? mine : 1u; nx = cnt > 0u ? cnt : 1u;
}

__device__ __forceinline__ void xcd_barrier(const XcdBarrier& b) {
    asm volatile("s_waitcnt vmcnt(0)" ::: "memory");
    __syncthreads();
    if (b.lead) {
        unsigned* bar = b.bar;
        __builtin_amdgcn_s_waitcnt(0);
        unsigned nloc = b.st[0], nx = b.st[1];
        if (nloc == 0u) { xcd_barrier_complete(bar, b.x, nloc, nx); b.st[0] = nloc; b.st[1] = nx; }
        const unsigned old = xb_add(&bar[XB_XSUB(b.x)], 1u);
        const unsigned gen = old / nloc;
        if (old + 1u == (gen + 1u) * nloc) {
            __builtin_amdgcn_fence(__ATOMIC_RELEASE, "agent");
            asm volatile("s_waitcnt vmcnt(0)" ::: "memory");
            const unsigned og = xb_add(&bar[XB_TOP], 1u);
            const unsigned tg = og / nx;
            if (og + 1u == (tg + 1u) * nx) xb_add(&bar[XB_TOPGEN], 1u);
            else XB_SPIN(xb_ld(&bar[XB_TOPGEN]) == tg, bar);
            __builtin_amdgcn_fence(__ATOMIC_ACQUIRE, "agent");
            xb_add(&bar[XB_XGEN(b.x)], 1u);
            asm volatile("s_waitcnt vmcnt(0)" ::: "memory");
        } else {
            XB_SPIN(xb_ld(&bar[XB_XGEN(b.x)]) == gen, bar);
            __builtin_amdgcn_fence(__ATOMIC_ACQUIRE, "agent");
            asm volatile("s_waitcnt vmcnt(0)" ::: "memory");
        }
    }
    __syncthreads();
}

#define GRID_SYNC_CG() do { asm volatile("s_waitcnt vmcnt(0)" ::: "memory"); grid.sync(); __builtin_amdgcn_fence(__ATOMIC_ACQUIRE, "agent"); asm volatile("s_waitcnt vmcnt(0)" ::: "memory"); } while (0)
#define GRID_SYNC() do { XcdBarrier b_; b_.bar = (unsigned*)(kargs()->ws + WS_BAR); b_.x = xb_xcc_id(); b_.st = (volatile LAS unsigned*)(lds + 131072 + 64); b_.lead = fresh_tid(wave0) == 0; xcd_barrier(b_); } while (0)
__global__ void __launch_bounds__(512, 2) hymba_fwd(Args args) {
    extern __shared__ __attribute__((aligned(16))) unsigned char lds_raw[];
    cg::grid_group grid = cg::this_grid();
    LAS unsigned char* lds = (LAS unsigned char*)lds_raw;
    const int wave0 = __builtin_amdgcn_readfirstlane((int)threadIdx.x >> 6);
    volatile LAS unsigned* xst = (volatile LAS unsigned*)(lds + 131072 + 64);
    { const int t0_ = fresh_tid(wave0); if ((t0_ & 63) == 0) *(LAS int*)(lds + 131072 + 256 + (t0_ >> 6) * 1024) = -1;
      if (t0_ < 2) xst[t0_] = 0u; __syncthreads(); (void)xcd_barrier_post((unsigned*)(kargs()->ws + WS_BAR), xst, t0_ == 0); }
    prologue_stage(lds, wave0);
    if (kargs()->out == nullptr) GRID_SYNC_CG();
    GRID_SYNC();
    for (int l = 0; l < DEPTH; ++l) {
        gemm_stage<0>(lds, l, 0, wave0); GRID_SYNC();
        gemm_stage<1>(lds, l, 0, wave0); GRID_SYNC();
        gemm_stage<2>(lds, l, 0, wave0); GRID_SYNC();
        mixer_stage<0>(lds, l, wave0); GRID_SYNC();
        mixer_stage<1>(lds, l, wave0); GRID_SYNC();
        gemm_stage<3>(lds, l, 0, wave0); GRID_SYNC();
        gemm_stage<0>(lds, l, 1, wave0); GRID_SYNC();
        gemm_stage<1>(lds, l, 1, wave0); GRID_SYNC();
    }
    {
        KArgs ap = kargs(); const int tid = fresh_tid(wave0), lane = tid & 63, wave = __builtin_amdgcn_readfirstlane(tid >> 6);
        const int gw = blockIdx.x * 8 + wave, NGW = gridDim.x * 8;
        float* out = ap->out; const bf16_t* XB = (const bf16_t*)(ap->ws + WS_XB); const float* gfin = IN_F(21); const float* ssqF = (const float*)(ap->ws + WS_SSQ) + (size_t)12 * SSQ_SLOT;
        for (int m = gw; m < MTOK; m += NGW) {
            const float rstd = rsqrtf(ssq_row(ssqF, m) * (1.0f / DM) + EPS);
            const u32x2* xr = (const u32x2*)(XB + (size_t)m * DM) + lane; f32x4* orow = (f32x4*)(out + (size_t)m * DM) + lane; const f32x4* gr = (const f32x4*)gfin + lane;
#pragma unroll
            for (int j = 0; j < 4; ++j) { const u32x2 v = xr[64 * j]; const f32x4 g = gr[64 * j];
                f32x4 o; o[0] = bflo(v.x) * rstd * g[0]; o[1] = bfhi(v.x) * rstd * g[1]; o[2] = bflo(v.y) * rstd * g[2]; o[3] = bfhi(v.y) * rstd * g[3];
                orow[64 * j] = o; }
        }
    }
}

extern "C" void kernel_launch(void* const* d_in, const int* in_sizes, int n_in, void* d_out, int out_size, void* d_ws, size_t ws_size, hipStream_t stream) {
    static int grid = 0;
    if (grid == 0) {
        if (n_in != 22 || out_size != MTOK * DM || ws_size < WS_END) { fprintf(stderr, "kernel_launch: unexpected shapes (n_in %d, out %d, ws %zu)\n", n_in, out_size, ws_size); grid = -1; return; }
        int dev = 0, cus = 0, per_cu = 0;
        (void)hipGetDevice(&dev); (void)hipDeviceGetAttribute(&cus, hipDeviceAttributeMultiprocessorCount, dev);
        if (hipFuncSetAttribute((const void*)hymba_fwd, hipFuncAttributeMaxDynamicSharedMemorySize, LDS_BYTES) != hipSuccess) { fprintf(stderr, "kernel_launch: hipFuncSetAttribute failed\n"); grid = -1; return; }
        if (hipOccupancyMaxActiveBlocksPerMultiprocessor(&per_cu, (const void*)hymba_fwd, 512, LDS_BYTES) != hipSuccess || per_cu < 1) { fprintf(stderr, "kernel_launch: occupancy query gave %d\n", per_cu); per_cu = 1; }
        (void)hipGetLastError();
        grid = cus * per_cu;
    }
    if (grid < 0) return;
    if (hipMemsetAsync((char*)d_ws + WS_BAR, 0, XCD_BAR_WORDS * 4, stream) != hipSuccess) { fprintf(stderr, "kernel_launch: hipMemsetAsync failed\n"); return; }
    Args a{};
    for (int i = 0; i < 22; ++i) a.in[i] = d_in[i];
    a.out = (float*)d_out; a.ws = (unsigned char*)d_ws;
    void* kargs[] = {&a};
    hipError_t e = hipLaunchCooperativeKernel((const void*)hymba_fwd, dim3(grid), dim3(512), kargs, LDS_BYTES, stream);
    if (e != hipSuccess) fprintf(stderr, "kernel_launch: cooperative launch failed: %s (grid %d)\n", hipGetErrorString(e), grid);
}
```

```cpp
#include <hip/hip_runtime.h>
#include <hip/hip_cooperative_groups.h>
#include <cstdio>
#include <cstdint>
#include <cmath>
namespace cg = cooperative_groups;
namespace pg8 {
#define PG8_LAS __attribute__((address_space(3)))
typedef unsigned short bf16_t;
typedef short bf16x8 __attribute__((ext_vector_type(8)));
typedef float f32x4 __attribute__((ext_vector_type(4)));
typedef unsigned u32x4 __attribute__((ext_vector_type(4)));
constexpr int BM = 256, BK = 64, HALF = 128, HTB = HALF * BK * 2  , STAGE_BYTES = 8 * HTB, NXCD = 8, WGM = 8;

__host__ __device__ __forceinline__ int lds_byte(int r, int c) { const int st = (r >> 4) * 2 + (c >> 5), rr = r & 15, cc = c & 31, ob = rr * 64 + cc * 2; return st * 1024 + (ob ^ (((ob >> 9) & 1) << 5)); }
__host__ __device__ __forceinline__ void stage_rc(int b, int& R, int& C) { const int st = b / 1024, sb = b % 1024, swz = sb ^ (((sb >> 9) & 1) << 5); R = (st >> 1) * 16 + swz / 64; C = (st & 1) * 32 + (swz % 64) / 2; }
__host__ __device__ __forceinline__ int perm32(int rho) { const int n = rho >> 4, i = rho & 15; return 8 * (i >> 2) + 4 * n + (i & 3); }

struct Unit { int pm, pn; };
struct Gemm { const bf16_t* A; const bf16_t* Bt; int M, N, K; };

struct StaticOrder {
    int nM, nN, nwg, G, c;
    __host__ __device__ void init(int M, int N, int G_, int c_) { nM = M / BM; nN = N / BM; nwg = nM * nN; G = G_; c = c_; }
    __host__ __device__ bool next(int i, Unit& u) const {
        const long L = (long)i * G + c; if (L >= nwg) return false;
        int wgid = (int)L; { const int q = nwg / NXCD, r = nwg % NXCD, xcd = wgid % NXCD, off = wgid / NXCD; wgid = (xcd < r ? xcd * (q + 1) : r * (q + 1) + (xcd - r) * q) + off; }
        const int nig = WGM * nN, gid = wgid / nig, fm = gid * WGM, gsz = (nM - fm) < WGM ? (nM - fm) : WGM;
        u.pm = fm + ((wgid % nig) % gsz); u.pn = (wgid % nig) / gsz; return true;
    }
    __device__ __forceinline__ void a_ready(const Unit&) const {}
    __device__ __forceinline__ void done(const Unit&) const {}
};
}

constexpr int DM = 1024, BATCH = 2, SEQ = 16384, MTOK = BATCH * SEQ, DEPTH = 4, FF = 2816, NGU = 2 * FF, NIN = 2560, INC = 2432;
constexpr int PC_QA = 0, PC_KA = 256, PC_VA = 384, PC_QB = 512, PC_KB = 896, PC_VB = 1280, PC_XC = 1792, PC_GC = 2176;
constexpr int PP = 2696;
constexpr float EPS = 1e-6f;
constexpr float QSCALE = 0.125f * 1.4426950408889634f;

#define LAS __attribute__((address_space(3)))
typedef unsigned short bf16_t;
typedef short bf16x8 __attribute__((ext_vector_type(8)));
typedef short s16x4 __attribute__((ext_vector_type(4)));
typedef float f32x4 __attribute__((ext_vector_type(4)));
typedef float f32x2 __attribute__((ext_vector_type(2)));
typedef float f32x16 __attribute__((ext_vector_type(16)));
typedef unsigned u32x4 __attribute__((ext_vector_type(4)));
typedef unsigned u32x2 __attribute__((ext_vector_type(2)));
typedef __bf16 nbf16x2 __attribute__((ext_vector_type(2)));

__device__ __forceinline__ unsigned pk2(float lo, float hi) { f32x2 v = {lo, hi}; nbf16x2 r = __builtin_convertvector(v, nbf16x2); return __builtin_bit_cast(unsigned, r); }
__device__ __forceinline__ float bf2f(unsigned short h) { return __builtin_bit_cast(float, (unsigned)h << 16); }
__device__ __forceinline__ float bflo(unsigned w) { return __builtin_bit_cast(float, w << 16); }
__device__ __forceinline__ float bfhi(unsigned w) { return __builtin_bit_cast(float, w & 0xffff0000u); }
__device__ __forceinline__ float fast_rcp(float x) { return __builtin_amdgcn_rcpf(x); }
__device__ __forceinline__ float fast_exp2(float x) { return __builtin_amdgcn_exp2f(x); }
__device__ __forceinline__ float sigmoidf_(float x) { return fast_rcp(1.0f + __expf(-x)); }

__device__ __forceinline__ float ssq_row(const float* part, int row) {
    const f32x4* p = (const f32x4*)(part + (size_t)row * 16);
    const f32x4 a = p[0], b = p[1], c = p[2], d = p[3];
    return (((a[0] + a[1]) + (a[2] + a[3])) + ((b[0] + b[1]) + (b[2] + b[3]))) + (((c[0] + c[1]) + (c[2] + c[3])) + ((d[0] + d[1]) + (d[2] + d[3])));
}

namespace pg8 {
__device__ __forceinline__ void rstd8(const float* ssq, int row0, int fq, float (&rstd)[8]) {
    f32x4 q[8];
#pragma unroll
    for (int i = 0; i < 8; ++i) q[i] = *(const f32x4*)(ssq + (size_t)(row0 + (i >> 2) * HALF + (i & 3) * 16) * 16 + 4 * fq);
#pragma unroll
    for (int i = 0; i < 8; ++i) { float s = (q[i][0] + q[i][1]) + (q[i][2] + q[i][3]); s += __shfl_xor(s, 16); s += __shfl_xor(s, 32); rstd[i] = rsqrtf(s * (1.0f / DM) + EPS); }
}
__device__ __forceinline__ void rstd8_cached(const float* ssq, int row0, int fr, int fq, float (&rstd)[8], PG8_LAS unsigned char* tab, int tagv) {
    PG8_LAS int* tag = (PG8_LAS int*)tab; PG8_LAS float* t = (PG8_LAS float*)(tab + 16);
    if (__builtin_amdgcn_readfirstlane(*tag) == tagv) {
#pragma unroll
        for (int i = 0; i < 8; ++i) rstd[i] = t[(i >> 2) * 64 + (i & 3) * 16 + fr];
    } else {
        rstd8(ssq, row0, fq, rstd);
        if (fq == 0) {
#pragma unroll
            for (int i = 0; i < 8; ++i) t[(i >> 2) * 64 + (i & 3) * 16 + fr] = rstd[i];
        }
        *tag = tagv;
    }
}
struct EpiGateUp {
    static constexpr bool PERM = true, AFTER_DRAIN = false;
    const float* ssq; bf16_t* act; PG8_LAS unsigned char* tabs; int tag0;
    __device__ __forceinline__ void operator()(const f32x4 (&acc)[2][2][4][2], const Unit& u, int wr, int wc, int fr, int fq) const {
        float rstd[8]; rstd8_cached(ssq, u.pm * BM + wr * 64 + fr, fr, fq, rstd, tabs + (wr * 4 + wc) * 1024, tag0 + u.pm);
#pragma unroll
        for (int ai = 0; ai < 2; ++ai)
#pragma unroll
            for (int m = 0; m < 4; ++m) {
                const int row = u.pm * BM + ai * HALF + wr * 64 + m * 16 + fr;
                const float rs = rstd[ai * 4 + m];
                float a[8];
#pragma unroll
                for (int n = 0; n < 2; ++n) {
                    const f32x4 g = acc[ai][0][m][n] * rs, up = acc[ai][1][m][n] * rs;
#pragma unroll
                    for (int e = 0; e < 4; ++e) a[4 * n + e] = g[e] * fast_rcp(1.0f + __expf(-g[e])) * up[e];
                }
                u32x4 w; w.x = pk2(a[0], a[1]); w.y = pk2(a[2], a[3]); w.z = pk2(a[4], a[5]); w.w = pk2(a[6], a[7]);
                *(u32x4*)(act + (size_t)row * FF + u.pn * 128 + wc * 32 + fq * 8) = w;
            }
    }
};
struct EpiResidual {
    static constexpr bool PERM = true, AFTER_DRAIN = false;
    bf16_t* xb; float* ssq_out; float scale;
    __device__ __forceinline__ void operator()(const f32x4 (&acc)[2][2][4][2], const Unit& u, int wr, int wc, int fr, int fq) const {
        bf16_t* p0 = xb + (size_t)(u.pm * BM + wr * 64 + fr) * DM + u.pn * BM + wc * 32 + fq * 8;
        u32x4 b[8][2];
#pragma unroll
        for (int i = 0; i < 2; ++i)
#pragma unroll
            for (int bj = 0; bj < 2; ++bj) b[i][bj] = *(const u32x4*)(p0 + (size_t)((i >> 2) * HALF + (i & 3) * 16) * DM + bj * HALF);
#pragma unroll
        for (int i = 0; i < 8; ++i) {
            if (i + 2 < 8) {
#pragma unroll
                for (int bj = 0; bj < 2; ++bj) b[i + 2][bj] = *(const u32x4*)(p0 + (size_t)(((i + 2) >> 2) * HALF + ((i + 2) & 3) * 16) * DM + bj * HALF);
            }
            const int ai = i >> 2, m = i & 3;
            const int row = u.pm * BM + ai * HALF + wr * 64 + m * 16 + fr;
            float sq = 0.f;
#pragma unroll
            for (int bj = 0; bj < 2; ++bj) {
                const u32x4 bb = b[i][bj];
                const f32x4 a0 = acc[ai][bj][m][0] * scale, a1 = acc[ai][bj][m][1] * scale;
                const float o0 = bflo(bb.x) + a0[0], o1 = bfhi(bb.x) + a0[1], o2 = bflo(bb.y) + a0[2], o3 = bfhi(bb.y) + a0[3];
                const float o4 = bflo(bb.z) + a1[0], o5 = bfhi(bb.z) + a1[1], o6 = bflo(bb.w) + a1[2], o7 = bfhi(bb.w) + a1[3];
                sq += ((o0 * o0 + o1 * o1) + (o2 * o2 + o3 * o3)) + ((o4 * o4 + o5 * o5) + (o6 * o6 + o7 * o7));
                u32x4 w; w.x = pk2(o0, o1); w.y = pk2(o2, o3); w.z = pk2(o4, o5); w.w = pk2(o6, o7);
                *(u32x4*)(p0 + (size_t)(ai * HALF + m * 16) * DM + bj * HALF) = w;
            }
            sq += __shfl_xor(sq, 16); sq += __shfl_xor(sq, 32);
            if (fq == 0) ssq_out[(size_t)row * 16 + u.pn * 4 + wc] = sq;
            asm volatile("" ::: "memory");
        }
    }
};
struct EpiProj {
    static constexpr bool PERM = true, AFTER_DRAIN = false;
    const float* ssq; const float* cosT; const float* sinT; bf16_t* P; PG8_LAS unsigned char* tabs; int tag0;
    __device__ __forceinline__ void operator()(const f32x4 (&acc)[2][2][4][2], const Unit& u, int wr, int wc, int fr, int fq) const {
        const int row0 = u.pm * BM + wr * 64 + fr;
        float rstd[8]; rstd8_cached(ssq, row0, fr, fq, rstd, tabs + (wr * 4 + wc) * 1024, tag0 + u.pm);
        const int d1 = 16 * (wc & 1) + 4 * fq;
        const bool rope0 = (u.pn * BM + wc * 32 < PC_VA) || (u.pn * BM + wc * 32 >= PC_QB && u.pn * BM + wc * 32 < PC_VB);
        f32x4 c4[8], s4[8];
#pragma unroll
        for (int i = 0; i < 2; ++i) { const size_t to = (size_t)(row0 + (i >> 2) * HALF + (i & 3) * 16) * 32 + d1; c4[i] = *(const f32x4*)(cosT + to); s4[i] = *(const f32x4*)(sinT + to); }
#pragma unroll
        for (int i = 0; i < 8; ++i) {
            if (i + 2 < 8) { const size_t to = (size_t)(row0 + ((i + 2) >> 2) * HALF + ((i + 2) & 3) * 16) * 32 + d1; c4[i + 2] = *(const f32x4*)(cosT + to); s4[i + 2] = *(const f32x4*)(sinT + to); }
            const int ai = i >> 2, m = i & 3;
            const int row = row0 + ai * HALF + m * 16;
            const float rs = rstd[i];
#pragma unroll
            for (int bj = 0; bj < 2; ++bj) {
                const int cb = u.pn * BM + bj * HALF + wc * 32;
                f32x4 v0 = acc[ai][bj][m][0] * rs, v1 = acc[ai][bj][m][1] * rs;
                const bool rope = (cb < PC_VA) || (cb >= PC_QB && cb < PC_VB);
                const bool isq = (cb < PC_KA) || (cb >= PC_QB && cb < PC_KB);
                if (rope) {
                    const f32x4 o0 = v0 * c4[i] - v1 * s4[i], o1 = v1 * c4[i] + v0 * s4[i];
                    const float qs = isq ? QSCALE : 1.0f;
                    v0 = o0 * qs; v1 = o1 * qs;
                }
                u32x4 w; w.x = pk2(v0[0], v0[1]); w.y = pk2(v0[2], v0[3]); w.z = pk2(v1[0], v1[1]); w.w = pk2(v1[2], v1[3]);
                *(u32x4*)(P + (size_t)row * PP + cb + fq * 8) = w;
            }
            asm volatile("" ::: "memory");
        }
        (void)rope0;
    }
};
}
namespace pg8 {
template <class Epi, class Sched, bool ALIGN_EPI = false, bool SP2 = false>
__device__ __forceinline__ void gemm_phase(PG8_LAS unsigned char* lds, const Gemm g, const Sched& S, const Epi& E, int tid_in) {
    int tid_ = tid_in; asm volatile("" : "+v"(tid_));
    const int tid = tid_, wid = __builtin_amdgcn_readfirstlane(tid >> 6), lane = tid & 63, wr = wid >> 2, wc = wid & 3, fr = lane & 15, fq = lane >> 4;
    const int K = g.K, nt = K / BK;
    unsigned voffA[2], voffB[2];
#pragma unroll
    for (int i = 0; i < 2; ++i) { int R, C; stage_rc(tid * 16 + i * 8192, R, C); const int Rb = Epi::PERM ? ((R & ~31) + perm32(R & 31)) : R;
        voffA[i] = (unsigned)(R * K + C) * 2u; voffB[i] = (unsigned)(Rb * K + C) * 2u; }
    const size_t kstep = (size_t)(BK * 2);
    const size_t hstep = (size_t)HALF * K * 2;
    const size_t tstep = 2 * hstep;
    const unsigned ldsw = (unsigned)wid * 1024u;
    const int aoff = lds_byte(wr * 64 + fr, fq * 8), boff = lds_byte(wc * 32 + fr, fq * 8);
#define PG8_SA(b, h) (((b) * 2 + (h)) * HTB)
#define PG8_SB(b, h) ((4 + (b) * 2 + (h)) * HTB)
#define PG8_STAGE(bufoff, gbase, voff) do { _Pragma("unroll") for (int _i = 0; _i < 2; ++_i) \
        __builtin_amdgcn_global_load_lds((const unsigned*)((const char*)(gbase) + (voff)[_i]), (PG8_LAS unsigned*)(lds + (bufoff) + ldsw + _i * 8192), 16, 0, 0); } while (0)
#define PG8_LDA(dst, b, h) do { _Pragma("unroll") for (int m = 0; m < 4; ++m) _Pragma("unroll") for (int k = 0; k < 2; ++k) dst[m][k] = *(const PG8_LAS bf16x8*)(lds + PG8_SA(b, h) + aoff + m * 2048 + k * 1024); } while (0)
#define PG8_LDB(dst, b, h) do { _Pragma("unroll") for (int n = 0; n < 2; ++n) _Pragma("unroll") for (int k = 0; k < 2; ++k) dst[n][k] = *(const PG8_LAS bf16x8*)(lds + PG8_SB(b, h) + boff + n * 2048 + k * 1024); } while (0)
#define PG8_MMA(ai, bj, At, Bt) do { __builtin_amdgcn_s_setprio(1); _Pragma("unroll") for (int m = 0; m < 4; ++m) _Pragma("unroll") for (int n = 0; n < 2; ++n) _Pragma("unroll") for (int k = 0; k < 2; ++k) \
        acc[ai][bj][m][n] = __builtin_amdgcn_mfma_f32_16x16x32_bf16(Bt[n][k], At[m][k], acc[ai][bj][m][n], 0, 0, 0); __builtin_amdgcn_s_setprio(0); } while (0)
#define PG8_WAIT_V(n) asm volatile("s_waitcnt vmcnt(" #n ")" ::: "memory")
#define PG8_WAIT_L(n) asm volatile("s_waitcnt lgkmcnt(" #n ")" ::: "memory")
#define PG8_BAR __builtin_amdgcn_s_barrier()
#define PG8_SCHED __builtin_amdgcn_sched_barrier(0)
    Unit cur, nxt; int ui = 0;
    if (!S.next(0, cur)) return;
    f32x4 acc[2][2][4][2];
#pragma unroll
    for (int a = 0; a < 2; ++a)
#pragma unroll
        for (int b = 0; b < 2; ++b)
#pragma unroll
            for (int m = 0; m < 4; ++m)
#pragma unroll
                for (int n = 0; n < 2; ++n) acc[a][b][m][n] = (f32x4){0.f, 0.f, 0.f, 0.f};
    bf16x8 At[4][2], B0[2][2], B1[2][2];
    const char* cA = (const char*)g.A + (size_t)cur.pm * tstep; const char* cB = (const char*)g.Bt + (size_t)cur.pn * tstep;
    S.a_ready(cur);
    if constexpr (SP2) {
        PG8_STAGE(PG8_SB(0, 0), cB, voffB); PG8_STAGE(PG8_SB(0, 1), cB + hstep, voffB); PG8_STAGE(PG8_SA(0, 0), cA, voffA); PG8_STAGE(PG8_SA(0, 1), cA + hstep, voffA);
        if (wr == 1) PG8_BAR;
        PG8_WAIT_V(2); PG8_BAR;
        PG8_STAGE(PG8_SB(1, 0), cB + kstep, voffB); PG8_STAGE(PG8_SA(1, 0), cA + kstep, voffA); PG8_STAGE(PG8_SB(1, 1), cB + hstep + kstep, voffB);
        PG8_WAIT_V(6); PG8_BAR;
    } else {
        PG8_STAGE(PG8_SB(0, 0), cB, voffB); PG8_STAGE(PG8_SA(0, 0), cA, voffA); PG8_STAGE(PG8_SB(0, 1), cB + hstep, voffB); PG8_STAGE(PG8_SA(0, 1), cA + hstep, voffA);
        if (wr == 1) PG8_BAR;
        PG8_WAIT_V(4); PG8_BAR;
        PG8_STAGE(PG8_SB(1, 0), cB + kstep, voffB); PG8_STAGE(PG8_SA(1, 0), cA + kstep, voffA); PG8_STAGE(PG8_SB(1, 1), cB + hstep + kstep, voffB);
        PG8_WAIT_V(6); PG8_BAR;
    }
    for (;;) {
        const bool has_next = S.next(ui + 1, nxt);
        const char* nA = has_next ? (const char*)g.A + (size_t)nxt.pm * tstep : cA; const char* nB = has_next ? (const char*)g.Bt + (size_t)nxt.pn * tstep : cB;
        for (int t = 0; t < nt; t += 2) {
            const bool last = (t == nt - 2);
            const char* a1 = cA + (size_t)(t + 1) * kstep;
            const char* a2 = last ? nA : cA + (size_t)(t + 2) * kstep; const char* b2 = last ? nB : cB + (size_t)(t + 2) * kstep;
            const char* a3 = a2 + kstep; const char* b3 = b2 + kstep;
            if (last && has_next) S.a_ready(nxt);
            if constexpr (SP2) {
            PG8_LDB(B0, 0, 0); PG8_LDB(B1, 0, 1); PG8_SCHED; PG8_LDA(At, 0, 0); PG8_STAGE(PG8_SA(1, 1), a1 + hstep, voffA);
            PG8_WAIT_V(8); PG8_WAIT_L(0); PG8_BAR; PG8_MMA(0, 0, At, B0); PG8_MMA(0, 1, At, B1); PG8_BAR; PG8_SCHED;
            PG8_LDA(At, 0, 1); PG8_STAGE(PG8_SB(0, 0), b2, voffB); PG8_STAGE(PG8_SB(0, 1), b2 + hstep, voffB); PG8_STAGE(PG8_SA(0, 0), a2, voffA);
            PG8_WAIT_V(8); PG8_WAIT_L(0); PG8_BAR; PG8_MMA(1, 0, At, B0); PG8_MMA(1, 1, At, B1); PG8_BAR; PG8_SCHED;
            PG8_LDB(B0, 1, 0); PG8_LDB(B1, 1, 1); PG8_SCHED; PG8_LDA(At, 1, 0); PG8_STAGE(PG8_SA(0, 1), a2 + hstep, voffA);
            PG8_WAIT_V(8); PG8_WAIT_L(0); PG8_BAR; PG8_MMA(0, 0, At, B0); PG8_MMA(0, 1, At, B1); PG8_BAR; PG8_SCHED;
            PG8_LDA(At, 1, 1); PG8_STAGE(PG8_SB(1, 0), b3, voffB); PG8_STAGE(PG8_SB(1, 1), b3 + hstep, voffB); PG8_STAGE(PG8_SA(1, 0), a3, voffA);
            PG8_WAIT_V(8); PG8_WAIT_L(0); PG8_BAR; PG8_MMA(1, 0, At, B0); PG8_MMA(1, 1, At, B1); PG8_BAR; PG8_SCHED;
            } else {
            PG8_LDB(B0, 0, 0); PG8_SCHED; PG8_LDA(At, 0, 0); PG8_STAGE(PG8_SA(1, 1), a1 + hstep, voffA);
            PG8_WAIT_L(8); PG8_BAR; PG8_WAIT_L(0); PG8_MMA(0, 0, At, B0); PG8_BAR; PG8_SCHED;
            PG8_LDB(B1, 0, 1); PG8_STAGE(PG8_SB(0, 0), b2, voffB);
            PG8_BAR; PG8_WAIT_L(0); PG8_MMA(0, 1, At, B1); PG8_BAR;
            PG8_LDA(At, 0, 1); PG8_STAGE(PG8_SA(0, 0), a2, voffA);
            PG8_BAR; PG8_WAIT_L(0); PG8_MMA(1, 0, At, B0); PG8_BAR; PG8_SCHED;
            PG8_STAGE(PG8_SB(0, 1), b2 + hstep, voffB);
            PG8_WAIT_V(6); PG8_BAR; PG8_MMA(1, 1, At, B1); PG8_BAR;
            PG8_LDB(B0, 1, 0); PG8_SCHED; PG8_LDA(At, 1, 0); PG8_STAGE(PG8_SA(0, 1), a2 + hstep, voffA);
            PG8_WAIT_L(8); PG8_BAR; PG8_WAIT_L(0); PG8_MMA(0, 0, At, B0); PG8_BAR; PG8_SCHED;
            PG8_LDB(B1, 1, 1); PG8_STAGE(PG8_SB(1, 0), b3, voffB);
            PG8_BAR; PG8_WAIT_L(0); PG8_MMA(0, 1, At, B1); PG8_BAR;
            PG8_LDA(At, 1, 1); PG8_STAGE(PG8_SA(1, 0), a3, voffA);
            PG8_BAR; PG8_WAIT_L(0); PG8_MMA(1, 0, At, B0); PG8_BAR; PG8_SCHED;
            PG8_STAGE(PG8_SB(1, 1), b3 + hstep, voffB);
            PG8_WAIT_V(6); PG8_BAR; PG8_MMA(1, 1, At, B1); PG8_BAR;
            }
        }
        if constexpr (ALIGN_EPI) { if (wr == 0) PG8_BAR; }
        if constexpr (!Epi::AFTER_DRAIN) { E(acc, cur, wr, wc, fr, fq); S.done(cur); }
        if (!has_next) break;
#pragma unroll
        for (int a = 0; a < 2; ++a)
#pragma unroll
            for (int b = 0; b < 2; ++b)
#pragma unroll
                for (int m = 0; m < 4; ++m)
#pragma unroll
                    for (int n = 0; n < 2; ++n) acc[a][b][m][n] = (f32x4){0.f, 0.f, 0.f, 0.f};
        cur = nxt; cA = nA; cB = nB; ++ui;
        if constexpr (ALIGN_EPI) { if (wr == 1) PG8_BAR; }
    }
    PG8_WAIT_V(0);
    if constexpr (!ALIGN_EPI) { if (wr == 0) PG8_BAR; }
    PG8_BAR;
    if constexpr (Epi::AFTER_DRAIN) { E.fused(acc, cur, wr, wc, fr, fq, lds, wid, lane); S.done(cur); }
#undef PG8_SA
#undef PG8_SB
#undef PG8_STAGE
#undef PG8_LDA
#undef PG8_LDB
#undef PG8_MMA
#undef PG8_WAIT_V
#undef PG8_WAIT_L
#undef PG8_BAR
#undef PG8_SCHED
}
}

constexpr size_t MiB = 1u << 20;
constexpr size_t WS_W = 0, W_LAYER = 40 * MiB;
constexpr size_t WO_GU1 = 0, WO_D1 = 11 * MiB, WO_IN = WO_D1 + 11 * MiB / 2, WO_OUT = WO_IN + 5 * MiB, WO_GU2 = WO_OUT + 2 * MiB, WO_D2 = WO_GU2 + 11 * MiB;
static_assert(WO_D2 + 11 * MiB / 2 == W_LAYER, "weight map");
constexpr size_t WS_XB = 160 * MiB;
constexpr size_t WS_ACT = 224 * MiB;
constexpr size_t WS_MIX = 400 * MiB;
constexpr size_t WS_ROPE = 464 * MiB;
constexpr size_t WS_SSQ = 476 * MiB;
constexpr size_t SSQ_SLOT = (size_t)MTOK * 16;
constexpr size_t WS_RGW = 474 * MiB;
constexpr size_t WS_AGG = 475 * MiB;
constexpr size_t WS_TS = 502 * MiB;
constexpr size_t WS_BAR = 504 * MiB;
constexpr size_t WS_END = 505 * MiB;
constexpr size_t PO_BYTES = (size_t)MTOK * 384 * 2;
constexpr size_t OB_PO4 = 0, OB_PO16 = PO_BYTES, OB_LSE4 = 2 * PO_BYTES, OB_LSE16 = OB_LSE4 + MiB;
static_assert(OB_LSE16 + MiB <= (size_t)MTOK * DM * 4, "partials fit the output buffer");

constexpr int LDS_BYTES = 147456;
constexpr int VROW = 144;

struct Args { const void* in[22]; float* out; unsigned char* ws; };
__device__ const float INV_TAB[32] = {1.000000000e+00f, 7.498942018e-01f, 5.623413324e-01f, 4.216965139e-01f, 3.162277639e-01f, 2.371373773e-01f, 1.778279394e-01f, 1.333521456e-01f, 1.000000015e-01f, 7.498942316e-02f, 5.623413250e-02f, 4.216964915e-02f, 3.162277490e-02f, 2.371373773e-02f, 1.778279431e-02f, 1.333521400e-02f, 9.999999776e-03f, 7.498942316e-03f, 5.623413250e-03f, 4.216964822e-03f, 3.162277630e-03f, 2.371373819e-03f, 1.778279431e-03f, 1.333521446e-03f, 1.000000047e-03f, 7.498941850e-04f, 5.623413017e-04f, 4.216965172e-04f, 3.162277571e-04f, 2.371373703e-04f, 1.778279402e-04f, 1.333521504e-04f};

#define MFMA32(a, b, c) __builtin_amdgcn_mfma_f32_32x32x16_bf16((a), (b), (c), 0, 0, 0)
__device__ __forceinline__ int crow(int reg, int h) { return (reg & 3) + 8 * (reg >> 2) + 4 * h; }

struct AttnOut { bf16_t* mix; bf16_t* po; float* lse; const bf16_t* po4; const bf16_t* po16; const float* lse4; const float* lse16; float sink; };

__device__ __forceinline__ void store_row16(bf16_t* rowp  , const u32x2 (&wv)[4], int kh) {
#pragma unroll
    for (int gp = 0; gp < 2; ++gp) {
        const u32x2 keep = kh ? wv[2 * gp + 1] : wv[2 * gp], send = kh ? wv[2 * gp] : wv[2 * gp + 1];
        u32x2 recv; recv.x = (unsigned)__shfl_xor((int)send.x, 32); recv.y = (unsigned)__shfl_xor((int)send.y, 32);
        u32x4 w; if (kh) { w.x = recv.x; w.y = recv.y; w.z = keep.x; w.w = keep.y; } else { w.x = keep.x; w.y = keep.y; w.z = recv.x; w.w = recv.y; }
        *(u32x4*)(rowp + 8 * (2 * gp + kh)) = w;
    }
}
template <int MODE>
__device__ __forceinline__ void attn_finish(const f32x16& O0, const f32x16& O1, float m2, float lsum, int tok, int ocol, int hidx, int kh, const AttnOut& AO) {
    const float l = lsum + __shfl_xor(lsum, 32);
    const float lse = (m2 + __log2f(l)) * 0.6931471805599453f;
    const float rl = fast_rcp(l);
    if (MODE == 0) {
        const float gate = fast_rcp(1.0f + __expf(AO.sink - lse)) * rl;
        bf16_t* op = AO.mix + (size_t)tok * DM + ocol;
        u32x2 w0[4], w1[4];
#pragma unroll
        for (int g = 0; g < 4; ++g) {
            w0[g].x = pk2(O0[4 * g] * gate, O0[4 * g + 1] * gate); w0[g].y = pk2(O0[4 * g + 2] * gate, O0[4 * g + 3] * gate);
            w1[g].x = pk2(O1[4 * g] * gate, O1[4 * g + 1] * gate); w1[g].y = pk2(O1[4 * g + 2] * gate, O1[4 * g + 3] * gate);
        }
        store_row16(op, w0, kh); store_row16(op + 32, w1, kh);
    } else if (MODE == 1) {
        bf16_t* op = AO.po + (size_t)tok * 384 + hidx * 64;
        u32x2 w0[4], w1[4];
#pragma unroll
        for (int g = 0; g < 4; ++g) {
            w0[g].x = pk2(O0[4 * g] * rl, O0[4 * g + 1] * rl); w0[g].y = pk2(O0[4 * g + 2] * rl, O0[4 * g + 3] * rl);
            w1[g].x = pk2(O1[4 * g] * rl, O1[4 * g + 1] * rl); w1[g].y = pk2(O1[4 * g + 2] * rl, O1[4 * g + 3] * rl);
        }
        store_row16(op, w0, kh); store_row16(op + 32, w1, kh);
        if (kh == 0) AO.lse[(size_t)tok * 6 + hidx] = lse;
    } else {
        const float l4 = AO.lse4[(size_t)tok * 6 + hidx], l16 = AO.lse16[(size_t)tok * 6 + hidx];
        const float mxl = fmaxf(lse, fmaxf(l4, l16));
        float w1 = __expf(lse - mxl), w4 = __expf(l4 - mxl), w16 = __expf(l16 - mxl);
        const float rs = fast_rcp(w1 + w4 + w16);
        w1 *= rs * rl; w4 *= rs; w16 *= rs;
        const bf16_t* p4 = AO.po4 + (size_t)tok * 384 + hidx * 64 + 4 * kh;
        const bf16_t* p16 = AO.po16 + (size_t)tok * 384 + hidx * 64 + 4 * kh;
        bf16_t* op = AO.mix + (size_t)tok * DM + ocol;
        u32x2 wq[2][4];
#pragma unroll
        for (int g = 0; g < 4; ++g) {
#pragma unroll
            for (int mt = 0; mt < 2; ++mt) {
                const u32x2 a = *(const u32x2*)(p4 + 32 * mt + 8 * g), b = *(const u32x2*)(p16 + 32 * mt + 8 * g);
                float o[4];
#pragma unroll
                for (int e = 0; e < 4; ++e) o[e] = (mt ? O1[4 * g + e] : O0[4 * g + e]) * w1;
                o[0] += bflo(a.x) * w4 + bflo(b.x) * w16; o[1] += bfhi(a.x) * w4 + bfhi(b.x) * w16;
                o[2] += bflo(a.y) * w4 + bflo(b.y) * w16; o[3] += bfhi(a.y) * w4 + bfhi(b.y) * w16;
                wq[mt][g].x = pk2(o[0], o[1]); wq[mt][g].y = pk2(o[2], o[3]);
            }
        }
        store_row16(op, wq[0], kh); store_row16(op + 32, wq[1], kh);
    }
}

struct AttnGeom { int tokb, dil, u0, qcol, kcol, vcol, ocol, hidx, maxd, mode; float sink; bf16_t* po; float* lse; };
constexpr int KV_ROWS = 384, VIMG_OFF = KV_ROWS * VROW;

__device__ __forceinline__ void kv_fetch(const bf16_t* __restrict__ P, const AttnGeom& G, int tid, bf16x8 (&kv)[12], bf16x8 (&qn)[4], int wave, int lane) {
    const int piece = tid & 7, rb = tid >> 3;
#pragma unroll
    for (int i = 0; i < 12; ++i) {
        const int row = rb + 64 * (i % 6), u = G.u0 - 128 + row;
        if (u >= 0) kv[i] = *(const bf16x8*)(P + (size_t)(G.tokb + G.dil * u) * PP + (i < 6 ? G.kcol : G.vcol) + 8 * piece);
    }
    const bf16_t* qp = P + (size_t)(G.tokb + G.dil * (G.u0 + 32 * wave + (lane & 31))) * PP + G.qcol + 8 * (lane >> 5);
#pragma unroll
    for (int ks = 0; ks < 4; ++ks) qn[ks] = *(const bf16x8*)(qp + 16 * ks);
}
__device__ __forceinline__ void kv_store(LAS unsigned char* lds, int tid, const bf16x8 (&kv)[12]) {
    const int piece = tid & 7, rb = tid >> 3;
#pragma unroll
    for (int i = 0; i < 12; ++i) *(LAS bf16x8*)(lds + (i < 6 ? 0 : VIMG_OFF) + (rb + 64 * (i % 6)) * VROW + 16 * piece) = kv[i];
}

__device__ __forceinline__ void attn_wave(LAS unsigned char* lds, const AttnGeom& G, const bf16x8 (&qf)[4], int wave, int lane, const AttnOut& AO0) {
    const int r = lane & 31, kh = lane >> 5;
    const int u0w = G.u0 + 32 * wave;
    f32x16 O0, O1;
#pragma unroll
    for (int j = 0; j < 16; ++j) { O0[j] = 0.f; O1[j] = 0.f; }
    float m2 = -INFINITY, lsum = 0.f;
    const int trlane = ((4 * kh + ((lane & 15) >> 2)) * VROW + 32 * ((lane >> 4) & 1) + 8 * (lane & 3));
    for (int kt = (u0w >= 128 ? 0 : (128 - u0w) >> 5); kt < 5; ++kt) {
        const int ks0 = u0w - 128 + 32 * kt, lrow0 = 32 * wave + 32 * kt;
        bf16x8 kf[4];
        { const LAS unsigned char* kp = lds + (lrow0 + r) * VROW + 16 * kh;
#pragma unroll
          for (int ks = 0; ks < 4; ++ks) kf[ks] = *(const LAS bf16x8*)(kp + 32 * ks); }
        f32x16 S;
#pragma unroll
        for (int j = 0; j < 16; ++j) S[j] = 0.f;
#pragma unroll
        for (int ks = 0; ks < 4; ++ks) S = MFMA32(kf[ks], qf[ks], S);
        if (kt == 0 || kt == 4) {
            const int uq = u0w + r;
#pragma unroll
            for (int j = 0; j < 16; ++j) { const int diff = uq - (ks0 + crow(j, kh)); if (diff < 0 || diff > G.maxd) S[j] = -INFINITY; }
        }
        float mx = S[0];
#pragma unroll
        for (int j = 1; j < 16; ++j) mx = fmaxf(mx, S[j]);
        mx = fmaxf(mx, __shfl_xor(mx, 32));
        const float mnew = fmaxf(m2, mx);
        const float msafe = (mnew == -INFINITY) ? 0.f : mnew;
        const float alpha = fast_exp2(m2 - msafe);
        m2 = mnew;
        float ps = 0.f;
#pragma unroll
        for (int j = 0; j < 16; ++j) { S[j] = fast_exp2(S[j] - msafe); ps += S[j]; }
        lsum = lsum * alpha + ps;
#pragma unroll
        for (int j = 0; j < 16; ++j) { O0[j] *= alpha; O1[j] *= alpha; }
        bf16x8 pf[2];
#pragma unroll
        for (int s = 0; s < 2; ++s) { u32x4 w; w.x = pk2(S[8 * s], S[8 * s + 1]); w.y = pk2(S[8 * s + 2], S[8 * s + 3]); w.z = pk2(S[8 * s + 4], S[8 * s + 5]); w.w = pk2(S[8 * s + 6], S[8 * s + 7]); pf[s] = __builtin_bit_cast(bf16x8, w); }
        LAS s16x4* vt = (LAS s16x4*)(lds + VIMG_OFF + lrow0 * VROW + trlane);
#define TRR(BYTES) __builtin_amdgcn_ds_read_tr16_b64_v4i16(vt + (BYTES) / 8)
        const bf16x8 v00 = __builtin_shufflevector(TRR(0), TRR(1152), 0, 1, 2, 3, 4, 5, 6, 7), v01 = __builtin_shufflevector(TRR(2304), TRR(3456), 0, 1, 2, 3, 4, 5, 6, 7);
        const bf16x8 v10 = __builtin_shufflevector(TRR(64), TRR(1216), 0, 1, 2, 3, 4, 5, 6, 7), v11 = __builtin_shufflevector(TRR(2368), TRR(3520), 0, 1, 2, 3, 4, 5, 6, 7);
#undef TRR
        O0 = MFMA32(v00, pf[0], O0); O0 = MFMA32(v01, pf[1], O0);
        O1 = MFMA32(v10, pf[0], O1); O1 = MFMA32(v11, pf[1], O1);
    }
    AttnOut AO = AO0; AO.sink = G.sink; AO.po = G.po; AO.lse = G.lse;
    const int tok = G.tokb + G.dil * (u0w + r);
    if (G.mode == 0) attn_finish<0>(O0, O1, m2, lsum, tok, G.ocol, G.hidx, kh, AO);
    else if (G.mode == 1) attn_finish<1>(O0, O1, m2, lsum, tok, G.ocol, G.hidx, kh, AO);
    else attn_finish<2>(O0, O1, m2, lsum, tok, G.ocol, G.hidx, kh, AO);
}

struct RgParams { const bf16_t* P; const int* pos; const float* conv_w; const float* conv_b; const bf16_t* wrT; const bf16_t* wiT; const float* b_r; const float* b_i; const float* lam; float* agg; bf16_t* mix; };

template <bool FINAL>
__device__ __forceinline__ void rglru_item(const RgParams& R, int sc, int h, int nt, int lane, LAS unsigned char* yimg) {
    const int r = lane & 31, kh = lane >> 5;
    const int tok_sc = sc * 128, bstart = (sc >> 7) * 128;
    const int ncol = 32 * nt + r, cg = 64 * h + ncol;
    const float br = R.b_r[cg], bi = R.b_i[cg], sp8l = -8.0f * 1.4426950408889634f * log1pf(expf(-R.lam[cg]));
    float carry = 0.f, atot = 1.f;
    if (FINAL) {
        const float* ag = R.agg + (size_t)cg * 2; int s = bstart;
        for (; s + 8 <= sc; s += 8) {
            f32x2 ab[8];
#pragma unroll
            for (int i = 0; i < 8; ++i) ab[i] = *(const f32x2*)(ag + (size_t)(s + i) * 768);
#pragma unroll
            for (int i = 0; i < 8; ++i) carry = ab[i].x * carry + ab[i].y;
        }
        for (; s < sc; ++s) { const f32x2 ab = *(const f32x2*)(ag + (size_t)s * 768); carry = ab.x * carry + ab.y; }
    }
    const int cc = 64 * h + lane;
    const float cw0 = R.conv_w[cc], cw1 = R.conv_w[384 + cc], cw2 = R.conv_w[768 + cc], cw3 = R.conv_w[1152 + cc], cb = R.conv_b[cc];
    unsigned short xr[32];
    const unsigned goff = (unsigned)(4 * kh * PP + ncol);
    float xm1 = 0.f, xm2 = 0.f, xm3 = 0.f;
    { const bf16_t* xp = R.P + (size_t)tok_sc * PP + PC_XC + 64 * h;
      if ((tok_sc & (SEQ - 1)) != 0) { xm1 = bf2f((xp - 1 * PP)[lane]); xm2 = bf2f((xp - 2 * PP)[lane]); xm3 = bf2f((xp - 3 * PP)[lane]); }
#pragma unroll
      for (int t = 0; t < 32; ++t) xr[t] = (xp + (size_t)t * PP)[lane]; }
    for (int mt = 0; mt < 4; ++mt) {
        const int t0 = tok_sc + 32 * mt;
        bf16x8 yf[4];
        {
#pragma unroll
          for (int t = 0; t < 32; ++t) {
              const float x0 = bf2f(xr[t]);
              const float y = cb + cw0 * x0 + cw1 * xm1 + cw2 * xm2 + cw3 * xm3;
              *(LAS bf16_t*)(yimg + t * VROW + 2 * lane) = (bf16_t)(pk2(y, 0.f) & 0xffffu);
              xm3 = xm2; xm2 = xm1; xm1 = x0;
          }
          if (mt < 3) { const bf16_t* xp = R.P + (size_t)(t0 + 32) * PP + PC_XC + 64 * h;
#pragma unroll
              for (int t = 0; t < 32; ++t) xr[t] = (xp + (size_t)t * PP)[lane]; }
#pragma unroll
          for (int ks = 0; ks < 4; ++ks) yf[ks] = *(const LAS bf16x8*)(yimg + r * VROW + 32 * ks + 16 * kh);
        }
        unsigned short graw[16];
        if (FINAL) {
#pragma unroll
            for (int j = 0; j < 16; ++j) graw[j] = (R.P + (size_t)(t0 + (j & 3) + 8 * (j >> 2)) * PP + PC_GC + 64 * h)[goff];
        }
        unsigned rmask = 0u;
#pragma unroll
        for (int g = 0; g < 4; ++g) { const int4 p4 = *(const int4*)(R.pos + t0 + 8 * g + 4 * kh);
            rmask |= (p4.x == 0 ? 1u : 0u) << (4 * g); rmask |= (p4.y == 0 ? 1u : 0u) << (4 * g + 1); rmask |= (p4.z == 0 ? 1u : 0u) << (4 * g + 2); rmask |= (p4.w == 0 ? 1u : 0u) << (4 * g + 3); }
        f32x16 ra, ia, ya;
#pragma unroll
        for (int j = 0; j < 16; ++j) { ra[j] = 0.f; ia[j] = 0.f; ya[j] = 0.f; }
        int ncl = ncol; asm volatile("" : "+v"(ncl));
#pragma unroll
        for (int ks = 0; ks < 4; ++ks) {
            const size_t wo = ((size_t)h * 64 + ncl) * 64 + 16 * ks + 8 * kh;
            const bf16x8 wrf = *(const bf16x8*)(R.wrT + wo), wif = *(const bf16x8*)(R.wiT + wo);
            bf16x8 idf;
#pragma unroll
            for (int i = 0; i < 8; ++i) idf[i] = (16 * ks + 8 * kh + i == ncl) ? (short)0x3f80 : (short)0;
            ra = MFMA32(yf[ks], wrf, ra); ia = MFMA32(yf[ks], wif, ia); ya = MFMA32(yf[ks], idf, ya);
        }
        float av[16], bv[16];
#pragma unroll
        for (int j = 0; j < 16; ++j) {
            const float rr = sigmoidf_(ra[j] + br), ii = sigmoidf_(ia[j] + bi);
            const float a_ = fast_exp2(sp8l * rr);
            float a = a_, mult = __builtin_amdgcn_sqrtf(1.0f - a_ * a_);
            if ((rmask >> j) & 1u) { a = 0.f; mult = 1.f; }
            av[j] = a; bv[j] = mult * ii * ya[j];
        }
        float sa[4], sb[4], pa[4], pb[4];
#pragma unroll
        for (int g = 0; g < 4; ++g) {
            sa[g] = (av[4 * g] * av[4 * g + 1]) * (av[4 * g + 2] * av[4 * g + 3]);
            sb[g] = ((bv[4 * g] * av[4 * g + 1] + bv[4 * g + 1]) * av[4 * g + 2] + bv[4 * g + 2]) * av[4 * g + 3] + bv[4 * g + 3];
            pa[g] = __shfl_xor(sa[g], 32); pb[g] = __shfl_xor(sb[g], 32);
        }
        float c = carry, cin[4], apr = 1.f;
#pragma unroll
        for (int g = 0; g < 4; ++g) {
            const float a0 = kh ? pa[g] : sa[g], b0 = kh ? pb[g] : sb[g], a1 = kh ? sa[g] : pa[g], b1 = kh ? sb[g] : pb[g];
            const float ce = c; c = a0 * c + b0;
            const float co = c; c = a1 * c + b1;
            cin[g] = kh ? co : ce; apr *= a0 * a1;
        }
        carry = c; atot *= apr;
        if (FINAL) {
#pragma unroll
            for (int g = 0; g < 4; ++g) {
                float hp = cin[g];
#pragma unroll
                for (int e = 0; e < 4; ++e) {
                    const int j = 4 * g + e, tok = t0 + crow(j, kh);
                    hp = av[j] * hp + bv[j];
                    const float gt = bf2f(graw[j]);
                    const float z = 0.7978845608028654f * (gt + 0.044715f * gt * gt * gt);
                    const float th = 1.0f - 2.0f * fast_rcp(__expf(2.0f * z) + 1.0f);
                    const float o = hp * 0.5f * gt * (1.0f + th);
                    *(LAS bf16_t*)(yimg + 4608 + crow(j, kh) * 80 + 2 * r) = (bf16_t)(pk2(o, 0.f) & 0xffffu);
                    (void)tok;
                }
            }
#pragma unroll
            for (int q = 0; q < 2; ++q) {
                const int p = lane + 64 * q, tk = p >> 2, qu = p & 3;
                const u32x4 w = *(const LAS u32x4*)(yimg + 4608 + tk * 80 + 16 * qu);
                *(u32x4*)(R.mix + (size_t)(t0 + tk) * DM + 640 + 64 * h + 32 * nt + 8 * qu) = w;
            }
        }
    }
    if (!FINAL && kh == 0) { f32x2 ab = {atot, carry}; *(f32x2*)(R.agg + ((size_t)sc * 384 + cg) * 2) = ab; }
}

struct MapPlain { const float* w; int ld; __device__ __forceinline__ const float* operator()(int R) const { return w + R; } };
struct MapGU { const float* gate; const float* up; int ld;
    __device__ __forceinline__ const float* operator()(int R) const { const int j = 128 * (R >> 8) + (R & 127); const uintptr_t a = (uintptr_t)gate, b = (uintptr_t)up, sel = (uintptr_t)0 - (uintptr_t)((R >> 7) & 1); return (const float*)(a ^ ((a ^ b) & sel)) + j; } };
struct MapIN { const float* w; int ld;
    __device__ __forceinline__ const float* operator()(int R) const {
        int c = R;
        if (R < PC_VA || (R >= PC_QB && R < PC_VB)) { const int q = R & 63; c = (R & ~63) + 32 * ((q >> 2) & 1) + 16 * ((q >> 5) & 1) + 4 * ((q >> 3) & 3) + (q & 3); }
        if (c >= 1664 && c < PC_XC) return nullptr;
        if (c >= PC_XC) c -= 128;
        return w + c; } };

template <class Map>
__device__ __forceinline__ void transpose_item(const Map mp, int K, int N, bf16_t* WT, const float* gain, LAS float* scr, int item, int lane) {
    const int nblk = N / 32, kb = item / nblk, nb = item % nblk, k0 = 64 * kb, n0 = 32 * nb;
    const float* src = mp(n0 + (lane & 31));
    float v[32];
#pragma unroll
    for (int i = 0; i < 32; ++i) { const int kk = 2 * i + (lane >> 5); v[i] = src ? src[(size_t)(k0 + kk) * mp.ld] : 0.f; }
#pragma unroll
    for (int i = 0; i < 32; ++i) { const int kk = 2 * i + (lane >> 5); float t = v[i]; if (gain) t *= gain[k0 + kk]; scr[kk * 33 + (lane & 31)] = t; }
    asm volatile("s_waitcnt lgkmcnt(0)" ::: "memory");
    const int c = lane & 7;
#pragma unroll
    for (int j = 0; j < 4; ++j) { const int n = (lane >> 3) + 8 * j; const LAS float* s = scr + (8 * c) * 33 + n;
        u32x4 o; o.x = pk2(s[0 * 33], s[1 * 33]); o.y = pk2(s[2 * 33], s[3 * 33]); o.z = pk2(s[4 * 33], s[5 * 33]); o.w = pk2(s[6 * 33], s[7 * 33]);
        *(u32x4*)(WT + (size_t)(n0 + n) * K + k0 + 8 * c) = o; }
    asm volatile("s_waitcnt lgkmcnt(0)" ::: "memory");
}

__device__ __forceinline__ float wave_sum(float v) {
#pragma unroll
    for (int o = 1; o < 64; o <<= 1) v += __shfl_xor(v, o);
    return v;
}

__device__ __forceinline__ void sincos_d(double a, float& c, float& s) {
    const double n = rint(a * 0.6366197723675814);
    double t = fma(-n, 1.5707963267948966, a); t = fma(-n, 6.123233995736766e-17, t);
    const double t2 = t * t;
    double sp = -1.0 / 1307674368000.0; sp = sp * t2 + 1.0 / 6227020800.0; sp = sp * t2 - 1.0 / 39916800.0; sp = sp * t2 + 1.0 / 362880.0; sp = sp * t2 - 1.0 / 5040.0; sp = sp * t2 + 1.0 / 120.0; sp = sp * t2 - 1.0 / 6.0; sp = sp * t2 + 1.0;
    const double sn = sp * t;
    double cp = 1.0 / 20922789888000.0; cp = cp * t2 - 1.0 / 87178291200.0; cp = cp * t2 + 1.0 / 479001600.0; cp = cp * t2 - 1.0 / 3628800.0; cp = cp * t2 + 1.0 / 40320.0; cp = cp * t2 - 1.0 / 720.0; cp = cp * t2 + 1.0 / 24.0; cp = cp * t2 - 0.5; cp = cp * t2 + 1.0;
    const int q = (int)((long long)n & 3);
    const double cc = (q == 0) ? cp : (q == 1) ? -sn : (q == 2) ? -cp : sn;
    const double ss = (q == 0) ? sn : (q == 1) ? cp : (q == 2) ? -sn : -cp;
    c = (float)cc; s = (float)ss;
}

typedef const __attribute__((address_space(4))) Args* KArgs;
__device__ __forceinline__ KArgs kargs() { KArgs p = (KArgs)__builtin_amdgcn_kernarg_segment_ptr(); asm volatile("" : "+s"(p)); return p; }
#define IN_F(k) ((const float*)ap->in[k])
__device__ __forceinline__ int fresh_tid(int wave0) { int t = wave0 * 64 + (int)__builtin_amdgcn_mbcnt_hi(~0u, __builtin_amdgcn_mbcnt_lo(~0u, 0u)); asm volatile("" : "+v"(t)); return t; }

template <int WHICH>
__device__ __forceinline__ void gemm_stage(LAS unsigned char* lds, int l, int ffn, int wave0) {
    KArgs ap = kargs();
    unsigned char* ws = ap->ws; const int G = gridDim.x;
    unsigned char* wl = ws + WS_W + (size_t)l * W_LAYER;
    bf16_t* XB = (bf16_t*)(ws + WS_XB); bf16_t* ACT = (bf16_t*)(ws + WS_ACT); float* ssq0 = (float*)(ws + WS_SSQ) + (size_t)(3 * l) * SSQ_SLOT;
    if (WHICH == 0) {
        pg8::Gemm g{XB, (const bf16_t*)(wl + (ffn ? WO_GU2 : WO_GU1)), MTOK, NGU, DM}; pg8::StaticOrder S; S.init(MTOK, NGU, G, (int)blockIdx.x);
        pg8::EpiGateUp E{ssq0 + (ffn ? 2 * SSQ_SLOT : 0), ACT, lds + 131072 + 256, (3 * l + (ffn ? 2 : 0)) * 256};
        pg8::gemm_phase<pg8::EpiGateUp, pg8::StaticOrder, true, true>(lds, g, S, E, fresh_tid(wave0));
    } else if (WHICH == 1) {
        pg8::Gemm g{ACT, (const bf16_t*)(wl + (ffn ? WO_D2 : WO_D1)), MTOK, DM, FF}; pg8::StaticOrder S; S.init(MTOK, DM, G, (int)blockIdx.x);
        pg8::EpiResidual E{XB, ssq0 + (ffn ? 3 * SSQ_SLOT : SSQ_SLOT), 0.5f};
        pg8::gemm_phase<pg8::EpiResidual, pg8::StaticOrder, true, true>(lds, g, S, E, fresh_tid(wave0));
    } else if (WHICH == 2) {
        float* cosT = (float*)(ws + WS_ROPE);
        pg8::Gemm g{XB, (const bf16_t*)(wl + WO_IN), MTOK, NIN, DM}; pg8::StaticOrder S; S.init(MTOK, NIN, G, (int)blockIdx.x);
        pg8::EpiProj E{ssq0 + SSQ_SLOT, cosT, cosT + (size_t)MTOK * 32, ACT, lds + 131072 + 256, (3 * l + 1) * 256};
        pg8::gemm_phase<pg8::EpiProj, pg8::StaticOrder, true, true>(lds, g, S, E, fresh_tid(wave0));
    } else {
        pg8::Gemm g{(const bf16_t*)(ws + WS_MIX), (const bf16_t*)(wl + WO_OUT), MTOK, DM, DM}; pg8::StaticOrder S; S.init(MTOK, DM, G, (int)blockIdx.x);
        pg8::EpiResidual E{XB, ssq0 + 2 * SSQ_SLOT, 1.0f};
        pg8::gemm_phase<pg8::EpiResidual, pg8::StaticOrder, true, true>(lds, g, S, E, fresh_tid(wave0));
    }
}

__device__ __forceinline__ void prologue_stage(LAS unsigned char* lds, int wave0) {
    KArgs ap = kargs(); const int tid = fresh_tid(wave0), lane = tid & 63, wave = __builtin_amdgcn_readfirstlane(tid >> 6);
    unsigned char* ws = ap->ws; const int G = gridDim.x, gw = blockIdx.x * 8 + wave, NGW = G * 8;
    LAS float* scr = (LAS float*)(lds + wave * 16384);
    constexpr int I_GU = (DM / 64) * (NGU / 32), I_D = (FF / 64) * (DM / 32), I_IN = (DM / 64) * (NIN / 32), I_OUT = (DM / 64) * (DM / 32);
    constexpr int I_LAYER = 2 * I_GU + 2 * I_D + I_IN + I_OUT;
    for (int it = gw; it < DEPTH * I_LAYER; it += NGW) {
        const int l = it / I_LAYER; int r = it % I_LAYER;
        unsigned char* wl = ws + WS_W + (size_t)l * W_LAYER;
        if (r < I_GU) { MapGU mp{IN_F(3) + (size_t)l * DM * FF, IN_F(4) + (size_t)l * DM * FF, FF};
            transpose_item(mp, DM, NGU, (bf16_t*)(wl + WO_GU1), IN_F(2) + l * DM, scr, r, lane); continue; } r -= I_GU;
        if (r < I_D) { MapPlain mp{IN_F(5) + (size_t)l * FF * DM, DM};
            transpose_item(mp, FF, DM, (bf16_t*)(wl + WO_D1), nullptr, scr, r, lane); continue; } r -= I_D;
        if (r < I_IN) { MapIN mp{IN_F(7) + (size_t)l * DM * INC, INC};
            transpose_item(mp, DM, NIN, (bf16_t*)(wl + WO_IN), IN_F(6) + l * DM, scr, r, lane); continue; } r -= I_IN;
        if (r < I_OUT) { MapPlain mp{IN_F(16) + (size_t)l * DM * DM, DM};
            transpose_item(mp, DM, DM, (bf16_t*)(wl + WO_OUT), nullptr, scr, r, lane); continue; } r -= I_OUT;
        if (r < I_GU) { MapGU mp{IN_F(18) + (size_t)l * DM * FF, IN_F(19) + (size_t)l * DM * FF, FF};
            transpose_item(mp, DM, NGU, (bf16_t*)(wl + WO_GU2), IN_F(17) + l * DM, scr, r, lane); continue; } r -= I_GU;
        { MapPlain mp{IN_F(20) + (size_t)l * FF * DM, DM};
            transpose_item(mp, FF, DM, (bf16_t*)(wl + WO_D2), nullptr, scr, r, lane); }
    }
    const int gt = blockIdx.x * 512 + tid, NGT = G * 512;
    { const int* positions = (const int*)ap->in[1]; float* cosT = (float*)(ws + WS_ROPE); float* sinT = cosT + (size_t)MTOK * 32;
      for (int i = gt; i < MTOK * 32; i += NGT) {
          const int tok = i >> 5, k = i & 31;
          const float ang = (float)positions[tok] * INV_TAB[k];
          float c, s; sincos_d((double)ang, c, s);
          cosT[i] = c; sinT[i] = s;
      } }
    { float* SSQ = (float*)(ws + WS_SSQ);
      const float* x_in = IN_F(0); bf16_t* XB = (bf16_t*)(ws + WS_XB);
      for (int m = gw; m < MTOK; m += NGW) {
          const f32x4* xr = (const f32x4*)(x_in + (size_t)m * DM) + lane; float s = 0.f;
          unsigned long long* o8 = (unsigned long long*)(XB + (size_t)m * DM) + lane;
#pragma unroll
          for (int j = 0; j < 4; ++j) { const f32x4 v = xr[64 * j]; s += (v.x * v.x + v.y * v.y) + (v.z * v.z + v.w * v.w);
              o8[64 * j] = (unsigned long long)pk2(v.x, v.y) | ((unsigned long long)pk2(v.z, v.w) << 32); }
          s = wave_sum(s);
          if (lane < 16) SSQ[(size_t)m * 16 + lane] = lane == 0 ? s : 0.f;
      } }
    { bf16_t* RGW = (bf16_t*)(ws + WS_RGW); const float* wr = IN_F(11); const float* wi = IN_F(13);
      for (int i = gt; i < DEPTH * 2 * 6 * 4096; i += NGT) {
          const int ii = i & 63, j = (i >> 6) & 63, h = (i >> 12) % 6, gl = i / (6 * 4096), g = gl & 1, l = gl >> 1;
          const size_t so = ((size_t)(l * 6 + h) * 64 + ii) * 64 + j;
          const float v = g ? wi[so] : wr[so];
          RGW[i] = (bf16_t)(pk2(v, 0.f) & 0xffffu);
      } }
}

template <int SUB>
__device__ __forceinline__ void mixer_rg(LAS unsigned char* lds, int l, int wave0) {
    KArgs ap = kargs(); const int tid = fresh_tid(wave0), lane = tid & 63, wave = __builtin_amdgcn_readfirstlane(tid >> 6);
    unsigned char* ws = ap->ws; const int gw = blockIdx.x * 8 + wave, NGW = gridDim.x * 8;
    bf16_t* RGW = (bf16_t*)(ws + WS_RGW);
    RgParams RP{(const bf16_t*)(ws + WS_ACT), (const int*)ap->in[1], IN_F(9) + (size_t)l * 4 * 384, IN_F(10) + l * 384,
                RGW + (size_t)(l * 2 + 0) * 6 * 4096, RGW + (size_t)(l * 2 + 1) * 6 * 4096,
                IN_F(12) + l * 384, IN_F(14) + l * 384, IN_F(15) + l * 384, (float*)(ws + WS_AGG), (bf16_t*)(ws + WS_MIX)};
    LAS unsigned char* yimg = lds + wave * 8192;
    constexpr int N_RG = 256 * 12;
    for (int it = gw; it < N_RG; it += NGW) rglru_item<SUB == 1>(RP, it / 12, (it % 12) >> 1, it & 1, lane, yimg);
}
template <int SUB>
__device__ __forceinline__ void mixer_attn(LAS unsigned char* lds, int l, int wave0) {
    KArgs ap = kargs(); const int tid = fresh_tid(wave0), lane = tid & 63, wave = __builtin_amdgcn_readfirstlane(tid >> 6);
    unsigned char* ws = ap->ws; const int G = gridDim.x;
    const bf16_t* PB = (const bf16_t*)(ws + WS_ACT);
    unsigned char* obp = (unsigned char*)ap->out;
    AttnOut AO{(bf16_t*)(ws + WS_MIX), nullptr, nullptr, (const bf16_t*)(obp + OB_PO4), (const bf16_t*)(obp + OB_PO16), (const float*)(obp + OB_LSE4), (const float*)(obp + OB_LSE16), 0.f};
    const float* sinks = IN_F(8) + l * 4;
    auto geom = [&](int j) -> AttnGeom {
        AttnGeom g; g.sink = 0.f; g.po = nullptr; g.lse = nullptr; g.ocol = 0;
        if (SUB == 0) {
            const int br = j / 768, rr = j % 768, dil = br ? 16 : 4, nblk = SEQ / dil / 256;
            const int qb = rr % nblk, rho = (rr / nblk) % dil, bh = rr / (nblk * dil), h = bh % 6, b = bh / 6;
            g.tokb = b * SEQ + rho; g.dil = dil; g.u0 = qb * 256; g.qcol = PC_QB + 64 * h; g.kcol = PC_KB + 64 * h; g.vcol = PC_VB + 64 * h; g.hidx = h; g.maxd = 128; g.mode = 1;
            g.po = (bf16_t*)(obp + (br ? OB_PO16 : OB_PO4)); g.lse = (float*)(obp + (br ? OB_LSE16 : OB_LSE4));
        } else if (j < 512) {
            const int qb = j % 64, bhq = j / 64, hq = bhq % 4, b = bhq / 4, kv = hq >> 1;
            g.tokb = b * SEQ; g.dil = 1; g.u0 = qb * 256; g.qcol = PC_QA + 64 * hq; g.kcol = PC_KA + 64 * kv; g.vcol = PC_VA + 64 * kv; g.ocol = 64 * hq; g.hidx = hq; g.maxd = 127; g.mode = 0;
            g.sink = sinks[hq];
        } else {
            const int rr = j - 512, qb = rr % 64, bh = rr / 64, h = bh % 6, b = bh / 6;
            g.tokb = b * SEQ; g.dil = 1; g.u0 = qb * 256; g.qcol = PC_QB + 64 * h; g.kcol = PC_KB + 64 * h; g.vcol = PC_VB + 64 * h; g.ocol = 256 + 64 * h; g.hidx = h; g.maxd = 128; g.mode = 2;
        }
        return g;
    };
    constexpr int N_ATT = SUB == 0 ? 1536 : 1280;
    asm volatile("s_waitcnt lgkmcnt(0)" ::: "memory"); __builtin_amdgcn_s_barrier();
    int j = blockIdx.x; asm volatile("" : "+s"(j));
    if (j < N_ATT) {
        bf16x8 kv[12], qn[4];
        AttnGeom g = geom(j);
        kv_fetch(PB, g, tid, kv, qn, wave, lane);
        for (;;) {
            kv_store(lds, tid, kv);
            bf16x8 qf[4];
#pragma unroll
            for (int i = 0; i < 4; ++i) qf[i] = qn[i];
            asm volatile("s_waitcnt lgkmcnt(0)" ::: "memory"); __builtin_amdgcn_s_barrier(); asm volatile("" ::: "memory");
            const int jn = j + G; const bool more = jn < N_ATT;
            AttnGeom gn = g;
            if (more) { gn = geom(jn); kv_fetch(PB, gn, tid, kv, qn, wave, lane); }
            attn_wave(lds, g, qf, wave, lane, AO);
            asm volatile("" ::: "memory"); __builtin_amdgcn_s_barrier(); asm volatile("" ::: "memory");
            if (!more) break;
            g = gn; j = jn;
        }
    }
}
template <int SUB>
__device__ __forceinline__ void mixer_stage(LAS unsigned char* lds, int l, int wave0) { mixer_rg<SUB>(lds, l, wave0); mixer_attn<SUB>(lds, l, wave0); }

#define XB_TMO      128
#define XB_XCNT(j)  (256  + 64 * (j))
#define XB_XSUB(j)  (1280 + 64 * (j))
#define XB_XGEN(j)  (2304 + 64 * (j))
#define XB_TOP      3328
#define XB_TOPGEN   3392
#define XCD_BAR_WORDS 3456
#define XB_SPIN_CAP (1u << 18)

__device__ __forceinline__ unsigned xb_ld(unsigned* p)              { return __hip_atomic_load(p, __ATOMIC_RELAXED, __HIP_MEMORY_SCOPE_AGENT); }
__device__ __forceinline__ unsigned xb_add(unsigned* p, unsigned v) { return __hip_atomic_fetch_add(p, v, __ATOMIC_RELAXED, __HIP_MEMORY_SCOPE_AGENT); }
__device__ __forceinline__ unsigned xb_xcc_id() { return (unsigned)__builtin_amdgcn_s_getreg((3 << 11) | 20) & 0xFu; }
#define XB_SPIN(cond, bar) do { unsigned _sp = 0; while (cond) {   \
    if ((++_sp & 255u) == 0u) { if (xb_ld(&(bar)[XB_TMO])) break; if (_sp > XB_SPIN_CAP) { atomicAdd(&(bar)[XB_TMO], 1u); break; } } } } while (0)

struct XcdBarrier {
    unsigned* bar; unsigned x; bool lead;
    volatile LAS unsigned* st;
};

__device__ __forceinline__ XcdBarrier xcd_barrier_post(unsigned* bar, volatile LAS unsigned* st, bool lead) {
    XcdBarrier b; b.bar = bar; b.x = xb_xcc_id(); b.st = st; b.lead = lead;
    if (lead) (void)xb_add(&bar[XB_XCNT(b.x)], 1u);
    return b;
}
__device__ __forceinline__ void xcd_barrier_complete(unsigned* bar, unsigned x, unsigned& nloc, unsigned& nx) {
    const unsigned G = gridDim.x * gridDim.y * gridDim.z;
    unsigned sum, cnt, mine, sp = 0u;
    for (;;) {
        sum = 0u; cnt = 0u; mine = 0u;
#pragma unroll
        for (unsigned j = 0; j < 16; ++j) { const unsigned c = xb_ld(&bar[XB_XCNT(j)]); sum += c; cnt += (c > 0u) ? 1u : 0u; mine = (j == x) ? c : mine; }
        if (sum == G) break;
        __builtin_amdgcn_s_sleep(1);
        if ((++sp & 255u) == 0u) { if (xb_ld(&bar[XB_TMO])) break; if (sp > XB_SPIN_CAP) { atomicAdd(&bar[XB_TMO], 1u); break; } }
    }
    nloc = mine > 0u ? mine : 1u; nx = cnt > 0u ? cnt : 1u;
}

__device__ __forceinline__ void xcd_barrier(const XcdBarrier& b) {
    asm volatile("s_waitcnt vmcnt(0)" ::: "memory");
    __syncthreads();
    if (b.lead) {
        unsigned* bar = b.bar;
        __builtin_amdgcn_s_waitcnt(0);
        unsigned nloc = b.st[0], nx = b.st[1];
        if (nloc == 0u) { xcd_barrier_complete(bar, b.x, nloc, nx); b.st[0] = nloc; b.st[1] = nx; }
        const unsigned old = xb_add(&bar[XB_XSUB(b.x)], 1u);
        const unsigned gen = old / nloc;
        if (old + 1u == (gen + 1u) * nloc) {
            __builtin_amdgcn_fence(__ATOMIC_RELEASE, "agent");
            asm volatile("s_waitcnt vmcnt(0)" ::: "memory");
            const unsigned og = xb_add(&bar[XB_TOP], 1u);
            const unsigned tg = og / nx;
            if (og + 1u == (tg + 1u) * nx) xb_add(&bar[XB_TOPGEN], 1u);
            else XB_SPIN(xb_ld(&bar[XB_TOPGEN]) == tg, bar);
            __builtin_amdgcn_fence(__ATOMIC_ACQUIRE, "agent");
            xb_add(&bar[XB_XGEN(b.x)], 1u);
            asm volatile("s_waitcnt vmcnt(0)" ::: "memory");
        } else {
            XB_SPIN(xb_ld(&bar[XB_XGEN(b.x)]) == gen, bar);
            __builtin_amdgcn_fence(__ATOMIC_ACQUIRE, "agent");
            asm volatile("s_waitcnt vmcnt(0)" ::: "memory");
        }
    }
    __syncthreads();
}

#define GRID_SYNC_CG() do { asm volatile("s_waitcnt vmcnt(0)" ::: "memory"); grid.sync(); __builtin_amdgcn_fence(__ATOMIC_ACQUIRE, "agent"); asm volatile("s_waitcnt vmcnt(0)" ::: "memory"); } while (0)
#define GRID_SYNC() do { XcdBarrier b_; b_.bar = (unsigned*)(kargs()->ws + WS_BAR); b_.x = xb_xcc_id(); b_.st = (volatile LAS unsigned*)(lds + 131072 + 64); b_.lead = fresh_tid(wave0) == 0; xcd_barrier(b_); } while (0)
__global__ void __launch_bounds__(512, 2) hymba_fwd(Args args) {
    extern __shared__ __attribute__((aligned(16))) unsigned char lds_raw[];
    cg::grid_group grid = cg::this_grid();
    LAS unsigned char* lds = (LAS unsigned char*)lds_raw;
    const int wave0 = __builtin_amdgcn_readfirstlane((int)threadIdx.x >> 6);
    volatile LAS unsigned* xst = (volatile LAS unsigned*)(lds + 131072 + 64);
    { const int t0_ = fresh_tid(wave0); if ((t0_ & 63) == 0) *(LAS int*)(lds + 131072 + 256 + (t0_ >> 6) * 1024) = -1;
      if (t0_ < 2) xst[t0_] = 0u; __syncthreads(); (void)xcd_barrier_post((unsigned*)(kargs()->ws + WS_BAR), xst, t0_ == 0); }
    prologue_stage(lds, wave0);
    if (kargs()->out == nullptr) GRID_SYNC_CG();
    GRID_SYNC();
    for (int l = 0; l < DEPTH; ++l) {
        gemm_stage<0>(lds, l, 0, wave0); GRID_SYNC();
        gemm_stage<1>(lds, l, 0, wave0); GRID_SYNC();
        gemm_stage<2>(lds, l, 0, wave0); GRID_SYNC();
        mixer_stage<0>(lds, l, wave0); GRID_SYNC();
        mixer_stage<1>(lds, l, wave0); GRID_SYNC();
        gemm_stage<3>(lds, l, 0, wave0); GRID_SYNC();
        gemm_stage<0>(lds, l, 1, wave0); GRID_SYNC();
        gemm_stage<1>(lds, l, 1, wave0); GRID_SYNC();
    }
    {
        KArgs ap = kargs(); const int tid = fresh_tid(wave0), lane = tid & 63, wave = __builtin_amdgcn_readfirstlane(tid >> 6);
        const int gw = blockIdx.x * 8 + wave, NGW = gridDim.x * 8;
        float* out = ap->out; const bf16_t* XB = (const bf16_t*)(ap->ws + WS_XB); const float* gfin = IN_F(21); const float* ssqF = (const float*)(ap->ws + WS_SSQ) + (size_t)12 * SSQ_SLOT;
        for (int m = gw; m < MTOK; m += NGW) {
            const float rstd = rsqrtf(ssq_row(ssqF, m) * (1.0f / DM) + EPS);
            const u32x2* xr = (const u32x2*)(XB + (size_t)m * DM) + lane; f32x4* orow = (f32x4*)(out + (size_t)m * DM) + lane; const f32x4* gr = (const f32x4*)gfin + lane;
#pragma unroll
            for (int j = 0; j < 4; ++j) { const u32x2 v = xr[64 * j]; const f32x4 g = gr[64 * j];
                f32x4 o; o[0] = bflo(v.x) * rstd * g[0]; o[1] = bfhi(v.x) * rstd * g[1]; o[2] = bflo(v.y) * rstd * g[2]; o[3] = bfhi(v.y) * rstd * g[3];
                orow[64 * j] = o; }
        }
    }
}

extern "C" void kernel_launch(void* const* d_in, const int* in_sizes, int n_in, void* d_out, int out_size, void* d_ws, size_t ws_size, hipStream_t stream) {
    static int grid = 0;
    if (grid == 0) {
        if (n_in != 22 || out_size != MTOK * DM || ws_size < WS_END) { fprintf(stderr, "kernel_launch: unexpected shapes (n_in %d, out %d, ws %zu)\n", n_in, out_size, ws_size); grid = -1; return; }
        int dev = 0, cus = 0, per_cu = 0;
        (void)hipGetDevice(&dev); (void)hipDeviceGetAttribute(&cus, hipDeviceAttributeMultiprocessorCount, dev);
        if (hipFuncSetAttribute((const void*)hymba_fwd, hipFuncAttributeMaxDynamicSharedMemorySize, LDS_BYTES) != hipSuccess) { fprintf(stderr, "kernel_launch: hipFuncSetAttribute failed\n"); grid = -1; return; }
        if (hipOccupancyMaxActiveBlocksPerMultiprocessor(&per_cu, (const void*)hymba_fwd, 512, LDS_BYTES) != hipSuccess || per_cu < 1) { fprintf(stderr, "kernel_launch: occupancy query gave %d\n", per_cu); per_cu = 1; }
        (void)hipGetLastError();
        grid = cus * per_cu;
    }
    if (grid < 0) return;
    if (hipMemsetAsync((char*)d_ws + WS_BAR, 0, XCD_BAR_WORDS * 4, stream) != hipSuccess) { fprintf(stderr, "kernel_launch: hipMemsetAsync failed\n"); return; }
    Args a{};
    for (int i = 0; i < 22; ++i) a.in[i] = d_in[i];
    a.out = (float*)d_out; a.ws = (unsigned char*)d_ws;
    void* kargs[] = {&a};
    hipError_t e = hipLaunchCooperativeKernel((const void*)hymba_fwd, dim3(grid), dim3(512), kargs, LDS_BYTES, stream);
    if (e != hipSuccess) fprintf(stderr, "kernel_launch: cooperative launch failed: %s (grid %d)\n", hipGetErrorString(e), grid);
}
```

```cpp
#include <hip/hip_runtime.h>
#include <hip/hip_cooperative_groups.h>
#include <cstdio>
#include <cstdint>
#include <cmath>
namespace cg = cooperative_groups;
namespace pg8 {
#define PG8_LAS __attribute__((address_space(3)))
typedef unsigned short bf16_t;
typedef short bf16x8 __attribute__((ext_vector_type(8)));
typedef float f32x4 __attribute__((ext_vector_type(4)));
typedef unsigned u32x4 __attribute__((ext_vector_type(4)));
constexpr int BM = 256, BK = 64, HALF = 128, HTB = HALF * BK * 2  , STAGE_BYTES = 8 * HTB, NXCD = 8, WGM = 8;

__host__ __device__ __forceinline__ int lds_byte(int r, int c) { const int st = (r >> 4) * 2 + (c >> 5), rr = r & 15, cc = c & 31, ob = rr * 64 + cc * 2; return st * 1024 + (ob ^ (((ob >> 9) & 1) << 5)); }
__host__ __device__ __forceinline__ void stage_rc(int b, int& R, int& C) { const int st = b / 1024, sb = b % 1024, swz = sb ^ (((sb >> 9) & 1) << 5); R = (st >> 1) * 16 + swz / 64; C = (st & 1) * 32 + (swz % 64) / 2; }
__host__ __device__ __forceinline__ int perm32(int rho) { const int n = rho >> 4, i = rho & 15; return 8 * (i >> 2) + 4 * n + (i & 3); }

struct Unit { int pm, pn; };
struct Gemm { const bf16_t* A; const bf16_t* Bt; int M, N, K; };

struct StaticOrder {
    int nM, nN, nwg, G, c;
    __host__ __device__ void init(int M, int N, int G_, int c_) { nM = M / BM; nN = N / BM; nwg = nM * nN; G = G_; c = c_; }
    __host__ __device__ bool next(int i, Unit& u) const {
        const long L = (long)i * G + c; if (L >= nwg) return false;
        int wgid = (int)L; { const int q = nwg / NXCD, r = nwg % NXCD, xcd = wgid % NXCD, off = wgid / NXCD; wgid = (xcd < r ? xcd * (q + 1) : r * (q + 1) + (xcd - r) * q) + off; }
        const int nig = WGM * nN, gid = wgid / nig, fm = gid * WGM, gsz = (nM - fm) < WGM ? (nM - fm) : WGM;
        u.pm = fm + ((wgid % nig) % gsz); u.pn = (wgid % nig) / gsz; return true;
    }
    __device__ __forceinline__ void a_ready(const Unit&) const {}
    __device__ __forceinline__ void done(const Unit&) const {}
};
}

constexpr int DM = 1024, BATCH = 2, SEQ = 16384, MTOK = BATCH * SEQ, DEPTH = 4, FF = 2816, NGU = 2 * FF, NIN = 2560, INC = 2432;
constexpr int PC_QA = 0, PC_KA = 256, PC_VA = 384, PC_QB = 512, PC_KB = 896, PC_VB = 1280, PC_XC = 1792, PC_GC = 2176;
__device__ __forceinline__ size_t p_pos(bool perm, int tokabs) { const int s = tokabs & (SEQ - 1); return perm ? (size_t)((tokabs - s) + (s & 15) * (SEQ / 16) + (s >> 4)) : (size_t)tokabs; }
__device__ __forceinline__ size_t p_off(int g, bool perm, int tokabs) { return ((size_t)g * MTOK + p_pos(perm, tokabs)) * 64; }
constexpr float EPS = 1e-6f;
constexpr float QSCALE = 0.125f * 1.4426950408889634f;

#define LAS __attribute__((address_space(3)))
typedef unsigned short bf16_t;
typedef short bf16x8 __attribute__((ext_vector_type(8)));
typedef short s16x4 __attribute__((ext_vector_type(4)));
typedef float f32x4 __attribute__((ext_vector_type(4)));
typedef float f32x2 __attribute__((ext_vector_type(2)));
typedef float f32x16 __attribute__((ext_vector_type(16)));
typedef unsigned u32x4 __attribute__((ext_vector_type(4)));
typedef unsigned u32x2 __attribute__((ext_vector_type(2)));
typedef __bf16 nbf16x2 __attribute__((ext_vector_type(2)));

__device__ __forceinline__ unsigned pk2(float lo, float hi) { f32x2 v = {lo, hi}; nbf16x2 r = __builtin_convertvector(v, nbf16x2); return __builtin_bit_cast(unsigned, r); }
__device__ __forceinline__ float bf2f(unsigned short h) { return __builtin_bit_cast(float, (unsigned)h << 16); }
__device__ __forceinline__ float bflo(unsigned w) { return __builtin_bit_cast(float, w << 16); }
__device__ __forceinline__ float bfhi(unsigned w) { return __builtin_bit_cast(float, w & 0xffff0000u); }
__device__ __forceinline__ float fast_rcp(float x) { return __builtin_amdgcn_rcpf(x); }
__device__ __forceinline__ float fast_exp2(float x) { return __builtin_amdgcn_exp2f(x); }
__device__ __forceinline__ float sigmoidf_(float x) { return fast_rcp(1.0f + __expf(-x)); }

__device__ __forceinline__ float ssq_row(const float* part, int row) {
    const f32x4* p = (const f32x4*)(part + (size_t)row * 16);
    const f32x4 a = p[0], b = p[1], c = p[2], d = p[3];
    return (((a[0] + a[1]) + (a[2] + a[3])) + ((b[0] + b[1]) + (b[2] + b[3]))) + (((c[0] + c[1]) + (c[2] + c[3])) + ((d[0] + d[1]) + (d[2] + d[3])));
}

namespace pg8 {
__device__ __forceinline__ void rstd8(const float* ssq, int row0, int fq, float (&rstd)[8]) {
    f32x4 q[8];
#pragma unroll
    for (int i = 0; i < 8; ++i) q[i] = *(const f32x4*)(ssq + (size_t)(row0 + (i >> 2) * HALF + (i & 3) * 16) * 16 + 4 * fq);
#pragma unroll
    for (int i = 0; i < 8; ++i) { float s = (q[i][0] + q[i][1]) + (q[i][2] + q[i][3]); s += __shfl_xor(s, 16); s += __shfl_xor(s, 32); rstd[i] = rsqrtf(s * (1.0f / DM) + EPS); }
}
__device__ __forceinline__ void rstd8_cached(const float* ssq, int row0, int fr, int fq, float (&rstd)[8], PG8_LAS unsigned char* tab, int tagv) {
    PG8_LAS int* tag = (PG8_LAS int*)tab; PG8_LAS float* t = (PG8_LAS float*)(tab + 16);
    if (__builtin_amdgcn_readfirstlane(*tag) == tagv) {
#pragma unroll
        for (int i = 0; i < 8; ++i) rstd[i] = t[(i >> 2) * 64 + (i & 3) * 16 + fr];
    } else {
        rstd8(ssq, row0, fq, rstd);
        if (fq == 0) {
#pragma unroll
            for (int i = 0; i < 8; ++i) t[(i >> 2) * 64 + (i & 3) * 16 + fr] = rstd[i];
        }
        *tag = tagv;
    }
}
struct EpiGateUp {
    static constexpr bool PERM = true, AFTER_DRAIN = false;
    const float* ssq; bf16_t* act; PG8_LAS unsigned char* tabs; int tag0;
    __device__ __forceinline__ void operator()(const f32x4 (&acc)[2][2][4][2], const Unit& u, int wr, int wc, int fr, int fq) const {
        float rstd[8]; rstd8_cached(ssq, u.pm * BM + wr * 64 + fr, fr, fq, rstd, tabs + (wr * 4 + wc) * 1024, tag0 + u.pm);
#pragma unroll
        for (int ai = 0; ai < 2; ++ai)
#pragma unroll
            for (int m = 0; m < 4; ++m) {
                const int row = u.pm * BM + ai * HALF + wr * 64 + m * 16 + fr;
                const float rs = rstd[ai * 4 + m];
                float a[8];
#pragma unroll
                for (int n = 0; n < 2; ++n) {
                    const f32x4 g = acc[ai][0][m][n] * rs, up = acc[ai][1][m][n] * rs;
#pragma unroll
                    for (int e = 0; e < 4; ++e) a[4 * n + e] = g[e] * fast_rcp(1.0f + __expf(-g[e])) * up[e];
                }
                u32x4 w; w.x = pk2(a[0], a[1]); w.y = pk2(a[2], a[3]); w.z = pk2(a[4], a[5]); w.w = pk2(a[6], a[7]);
                *(u32x4*)(act + (size_t)row * FF + u.pn * 128 + wc * 32 + fq * 8) = w;
            }
    }
};
struct EpiResidual {
    static constexpr bool PERM = true, AFTER_DRAIN = false;
    bf16_t* xb; float* ssq_out; float scale;
    __device__ __forceinline__ void operator()(const f32x4 (&acc)[2][2][4][2], const Unit& u, int wr, int wc, int fr, int fq) const {
        bf16_t* p0 = xb + (size_t)(u.pm * BM + wr * 64 + fr) * DM + u.pn * BM + wc * 32 + fq * 8;
        u32x4 b[8][2];
#pragma unroll
        for (int i = 0; i < 2; ++i)
#pragma unroll
            for (int bj = 0; bj < 2; ++bj) b[i][bj] = *(const u32x4*)(p0 + (size_t)((i >> 2) * HALF + (i & 3) * 16) * DM + bj * HALF);
#pragma unroll
        for (int i = 0; i < 8; ++i) {
            if (i + 2 < 8) {
#pragma unroll
                for (int bj = 0; bj < 2; ++bj) b[i + 2][bj] = *(const u32x4*)(p0 + (size_t)(((i + 2) >> 2) * HALF + ((i + 2) & 3) * 16) * DM + bj * HALF);
            }
            const int ai = i >> 2, m = i & 3;
            const int row = u.pm * BM + ai * HALF + wr * 64 + m * 16 + fr;
            float sq = 0.f;
#pragma unroll
            for (int bj = 0; bj < 2; ++bj) {
                const u32x4 bb = b[i][bj];
                const f32x4 a0 = acc[ai][bj][m][0] * scale, a1 = acc[ai][bj][m][1] * scale;
                const float o0 = bflo(bb.x) + a0[0], o1 = bfhi(bb.x) + a0[1], o2 = bflo(bb.y) + a0[2], o3 = bfhi(bb.y) + a0[3];
                const float o4 = bflo(bb.z) + a1[0], o5 = bfhi(bb.z) + a1[1], o6 = bflo(bb.w) + a1[2], o7 = bfhi(bb.w) + a1[3];
                sq += ((o0 * o0 + o1 * o1) + (o2 * o2 + o3 * o3)) + ((o4 * o4 + o5 * o5) + (o6 * o6 + o7 * o7));
                u32x4 w; w.x = pk2(o0, o1); w.y = pk2(o2, o3); w.z = pk2(o4, o5); w.w = pk2(o6, o7);
                *(u32x4*)(p0 + (size_t)(ai * HALF + m * 16) * DM + bj * HALF) = w;
            }
            sq += __shfl_xor(sq, 16); sq += __shfl_xor(sq, 32);
            if (fq == 0) ssq_out[(size_t)row * 16 + u.pn * 4 + wc] = sq;
            asm volatile("" ::: "memory");
        }
    }
};
struct EpiProj {
    static constexpr bool PERM = true, AFTER_DRAIN = false;
    const float* ssq; const float* cosT; const float* sinT; bf16_t* P; PG8_LAS unsigned char* tabs; int tag0;
    __device__ __forceinline__ void operator()(const f32x4 (&acc)[2][2][4][2], const Unit& u, int wr, int wc, int fr, int fq) const {
        const int row0 = u.pm * BM + wr * 64 + fr;
        float rstd[8]; rstd8_cached(ssq, row0, fr, fq, rstd, tabs + (wr * 4 + wc) * 1024, tag0 + u.pm);
        const int d1 = 16 * (wc & 1) + 4 * fq;
        const bool rope0 = (u.pn * BM + wc * 32 < PC_VA) || (u.pn * BM + wc * 32 >= PC_QB && u.pn * BM + wc * 32 < PC_VB);
        f32x4 c4[8], s4[8];
#pragma unroll
        for (int i = 0; i < 2; ++i) { const size_t to = (size_t)(row0 + (i >> 2) * HALF + (i & 3) * 16) * 32 + d1; c4[i] = *(const f32x4*)(cosT + to); s4[i] = *(const f32x4*)(sinT + to); }
#pragma unroll
        for (int i = 0; i < 8; ++i) {
            if (i + 2 < 8) { const size_t to = (size_t)(row0 + ((i + 2) >> 2) * HALF + ((i + 2) & 3) * 16) * 32 + d1; c4[i + 2] = *(const f32x4*)(cosT + to); s4[i + 2] = *(const f32x4*)(sinT + to); }
            const int ai = i >> 2, m = i & 3;
            const int row = row0 + ai * HALF + m * 16;
            const float rs = rstd[i];
#pragma unroll
            for (int bj = 0; bj < 2; ++bj) {
                const int cb = u.pn * BM + bj * HALF + wc * 32;
                f32x4 v0 = acc[ai][bj][m][0] * rs, v1 = acc[ai][bj][m][1] * rs;
                const bool rope = (cb < PC_VA) || (cb >= PC_QB && cb < PC_VB);
                const bool isq = (cb < PC_KA) || (cb >= PC_QB && cb < PC_KB);
                if (rope) {
                    const f32x4 o0 = v0 * c4[i] - v1 * s4[i], o1 = v1 * c4[i] + v0 * s4[i];
                    const float qs = isq ? QSCALE : 1.0f;
                    v0 = o0 * qs; v1 = o1 * qs;
                }
                u32x4 w; w.x = pk2(v0[0], v0[1]); w.y = pk2(v0[2], v0[3]); w.z = pk2(v1[0], v1[1]); w.w = pk2(v1[2], v1[3]);
                *(u32x4*)(P + p_off(cb >> 6, cb >= PC_QB && cb < 1664, row) + (cb & 63) + fq * 8) = w;
            }
            asm volatile("" ::: "memory");
        }
        (void)rope0;
    }
};
}
namespace pg8 {
template <class Epi, class Sched, bool ALIGN_EPI = false, bool SP2 = false>
__device__ __forceinline__ void gemm_phase(PG8_LAS unsigned char* lds, const Gemm g, const Sched& S, const Epi& E, int tid_in) {
    int tid_ = tid_in; asm volatile("" : "+v"(tid_));
    const int tid = tid_, wid = __builtin_amdgcn_readfirstlane(tid >> 6), lane = tid & 63, wr = wid >> 2, wc = wid & 3, fr = lane & 15, fq = lane >> 4;
    const int K = g.K, nt = K / BK;
    unsigned voffA[2], voffB[2];
#pragma unroll
    for (int i = 0; i < 2; ++i) { int R, C; stage_rc(tid * 16 + i * 8192, R, C); const int Rb = Epi::PERM ? ((R & ~31) + perm32(R & 31)) : R;
        voffA[i] = (unsigned)(R * K + C) * 2u; voffB[i] = (unsigned)(Rb * K + C) * 2u; }
    const size_t kstep = (size_t)(BK * 2);
    const size_t hstep = (size_t)HALF * K * 2;
    const size_t tstep = 2 * hstep;
    const unsigned ldsw = (unsigned)wid * 1024u;
    const int aoff = lds_byte(wr * 64 + fr, fq * 8), boff = lds_byte(wc * 32 + fr, fq * 8);
#define PG8_SA(b, h) (((b) * 2 + (h)) * HTB)
#define PG8_SB(b, h) ((4 + (b) * 2 + (h)) * HTB)
#define PG8_STAGE(bufoff, gbase, voff) do { _Pragma("unroll") for (int _i = 0; _i < 2; ++_i) \
        __builtin_amdgcn_global_load_lds((const unsigned*)((const char*)(gbase) + (voff)[_i]), (PG8_LAS unsigned*)(lds + (bufoff) + ldsw + _i * 8192), 16, 0, 0); } while (0)
#define PG8_LDA(dst, b, h) do { _Pragma("unroll") for (int m = 0; m < 4; ++m) _Pragma("unroll") for (int k = 0; k < 2; ++k) dst[m][k] = *(const PG8_LAS bf16x8*)(lds + PG8_SA(b, h) + aoff + m * 2048 + k * 1024); } while (0)
#define PG8_LDB(dst, b, h) do { _Pragma("unroll") for (int n = 0; n < 2; ++n) _Pragma("unroll") for (int k = 0; k < 2; ++k) dst[n][k] = *(const PG8_LAS bf16x8*)(lds + PG8_SB(b, h) + boff + n * 2048 + k * 1024); } while (0)
#define PG8_MMA(ai, bj, At, Bt) do { __builtin_amdgcn_s_setprio(1); _Pragma("unroll") for (int m = 0; m < 4; ++m) _Pragma("unroll") for (int n = 0; n < 2; ++n) _Pragma("unroll") for (int k = 0; k < 2; ++k) \
        acc[ai][bj][m][n] = __builtin_amdgcn_mfma_f32_16x16x32_bf16(Bt[n][k], At[m][k], acc[ai][bj][m][n], 0, 0, 0); __builtin_amdgcn_s_setprio(0); } while (0)
#define PG8_WAIT_V(n) asm volatile("s_waitcnt vmcnt(" #n ")" ::: "memory")
#define PG8_WAIT_L(n) asm volatile("s_waitcnt lgkmcnt(" #n ")" ::: "memory")
#define PG8_BAR __builtin_amdgcn_s_barrier()
#define PG8_SCHED __builtin_amdgcn_sched_barrier(0)
    Unit cur, nxt; int ui = 0;
    if (!S.next(0, cur)) return;
    f32x4 acc[2][2][4][2];
#pragma unroll
    for (int a = 0; a < 2; ++a)
#pragma unroll
        for (int b = 0; b < 2; ++b)
#pragma unroll
            for (int m = 0; m < 4; ++m)
#pragma unroll
                for (int n = 0; n < 2; ++n) acc[a][b][m][n] = (f32x4){0.f, 0.f, 0.f, 0.f};
    bf16x8 At[4][2], B0[2][2], B1[2][2];
    const char* cA = (const char*)g.A + (size_t)cur.pm * tstep; const char* cB = (const char*)g.Bt + (size_t)cur.pn * tstep;
    S.a_ready(cur);
    if constexpr (SP2) {
        PG8_STAGE(PG8_SB(0, 0), cB, voffB); PG8_STAGE(PG8_SB(0, 1), cB + hstep, voffB); PG8_STAGE(PG8_SA(0, 0), cA, voffA); PG8_STAGE(PG8_SA(0, 1), cA + hstep, voffA);
        if (wr == 1) PG8_BAR;
        PG8_WAIT_V(2); PG8_BAR;
        PG8_STAGE(PG8_SB(1, 0), cB + kstep, voffB); PG8_STAGE(PG8_SA(1, 0), cA + kstep, voffA); PG8_STAGE(PG8_SB(1, 1), cB + hstep + kstep, voffB);
        PG8_WAIT_V(6); PG8_BAR;
    } else {
        PG8_STAGE(PG8_SB(0, 0), cB, voffB); PG8_STAGE(PG8_SA(0, 0), cA, voffA); PG8_STAGE(PG8_SB(0, 1), cB + hstep, voffB); PG8_STAGE(PG8_SA(0, 1), cA + hstep, voffA);
        if (wr == 1) PG8_BAR;
        PG8_WAIT_V(4); PG8_BAR;
        PG8_STAGE(PG8_SB(1, 0), cB + kstep, voffB); PG8_STAGE(PG8_SA(1, 0), cA + kstep, voffA); PG8_STAGE(PG8_SB(1, 1), cB + hstep + kstep, voffB);
        PG8_WAIT_V(6); PG8_BAR;
    }
    for (;;) {
        const bool has_next = S.next(ui + 1, nxt);
        const char* nA = has_next ? (const char*)g.A + (size_t)nxt.pm * tstep : cA; const char* nB = has_next ? (const char*)g.Bt + (size_t)nxt.pn * tstep : cB;
        for (int t = 0; t < nt; t += 2) {
            const bool last = (t == nt - 2);
            const char* a1 = cA + (size_t)(t + 1) * kstep;
            const char* a2 = last ? nA : cA + (size_t)(t + 2) * kstep; const char* b2 = last ? nB : cB + (size_t)(t + 2) * kstep;
            const char* a3 = a2 + kstep; const char* b3 = b2 + kstep;
            if (last && has_next) S.a_ready(nxt);
            if constexpr (SP2) {
            PG8_LDB(B0, 0, 0); PG8_LDB(B1, 0, 1); PG8_SCHED; PG8_LDA(At, 0, 0); PG8_STAGE(PG8_SA(1, 1), a1 + hstep, voffA);
            PG8_WAIT_V(8); PG8_WAIT_L(0); PG8_BAR; PG8_MMA(0, 0, At, B0); PG8_MMA(0, 1, At, B1); PG8_BAR; PG8_SCHED;
            PG8_LDA(At, 0, 1); PG8_STAGE(PG8_SB(0, 0), b2, voffB); PG8_STAGE(PG8_SB(0, 1), b2 + hstep, voffB); PG8_STAGE(PG8_SA(0, 0), a2, voffA);
            PG8_WAIT_V(8); PG8_WAIT_L(0); PG8_BAR; PG8_MMA(1, 0, At, B0); PG8_MMA(1, 1, At, B1); PG8_BAR; PG8_SCHED;
            PG8_LDB(B0, 1, 0); PG8_LDB(B1, 1, 1); PG8_SCHED; PG8_LDA(At, 1, 0); PG8_STAGE(PG8_SA(0, 1), a2 + hstep, voffA);
            PG8_WAIT_V(8); PG8_WAIT_L(0); PG8_BAR; PG8_MMA(0, 0, At, B0); PG8_MMA(0, 1, At, B1); PG8_BAR; PG8_SCHED;
            PG8_LDA(At, 1, 1); PG8_STAGE(PG8_SB(1, 0), b3, voffB); PG8_STAGE(PG8_SB(1, 1), b3 + hstep, voffB); PG8_STAGE(PG8_SA(1, 0), a3, voffA);
            PG8_WAIT_V(8); PG8_WAIT_L(0); PG8_BAR; PG8_MMA(1, 0, At, B0); PG8_MMA(1, 1, At, B1); PG8_BAR; PG8_SCHED;
            } else {
            PG8_LDB(B0, 0, 0); PG8_SCHED; PG8_LDA(At, 0, 0); PG8_STAGE(PG8_SA(1, 1), a1 + hstep, voffA);
            PG8_WAIT_L(8); PG8_BAR; PG8_WAIT_L(0); PG8_MMA(0, 0, At, B0); PG8_BAR; PG8_SCHED;
            PG8_LDB(B1, 0, 1); PG8_STAGE(PG8_SB(0, 0), b2, voffB);
            PG8_BAR; PG8_WAIT_L(0); PG8_MMA(0, 1, At, B1); PG8_BAR;
            PG8_LDA(At, 0, 1); PG8_STAGE(PG8_SA(0, 0), a2, voffA);
            PG8_BAR; PG8_WAIT_L(0); PG8_MMA(1, 0, At, B0); PG8_BAR; PG8_SCHED;
            PG8_STAGE(PG8_SB(0, 1), b2 + hstep, voffB);
            PG8_WAIT_V(6); PG8_BAR; PG8_MMA(1, 1, At, B1); PG8_BAR;
            PG8_LDB(B0, 1, 0); PG8_SCHED; PG8_LDA(At, 1, 0); PG8_STAGE(PG8_SA(0, 1), a2 + hstep, voffA);
            PG8_WAIT_L(8); PG8_BAR; PG8_WAIT_L(0); PG8_MMA(0, 0, At, B0); PG8_BAR; PG8_SCHED;
            PG8_LDB(B1, 1, 1); PG8_STAGE(PG8_SB(1, 0), b3, voffB);
            PG8_BAR; PG8_WAIT_L(0); PG8_MMA(0, 1, At, B1); PG8_BAR;
            PG8_LDA(At, 1, 1); PG8_STAGE(PG8_SA(1, 0), a3, voffA);
            PG8_BAR; PG8_WAIT_L(0); PG8_MMA(1, 0, At, B0); PG8_BAR; PG8_SCHED;
            PG8_STAGE(PG8_SB(1, 1), b3 + hstep, voffB);
            PG8_WAIT_V(6); PG8_BAR; PG8_MMA(1, 1, At, B1); PG8_BAR;
            }
        }
        if constexpr (ALIGN_EPI) { if (wr == 0) PG8_BAR; }
        if constexpr (!Epi::AFTER_DRAIN) { E(acc, cur, wr, wc, fr, fq); S.done(cur); }
        if (!has_next) break;
#pragma unroll
        for (int a = 0; a < 2; ++a)
#pragma unroll
            for (int b = 0; b < 2; ++b)
#pragma unroll
                for (int m = 0; m < 4; ++m)
#pragma unroll
                    for (int n = 0; n < 2; ++n) acc[a][b][m][n] = (f32x4){0.f, 0.f, 0.f, 0.f};
        cur = nxt; cA = nA; cB = nB; ++ui;
        if constexpr (ALIGN_EPI) { if (wr == 1) PG8_BAR; }
    }
    PG8_WAIT_V(0);
    if constexpr (!ALIGN_EPI) { if (wr == 0) PG8_BAR; }
    PG8_BAR;
    if constexpr (Epi::AFTER_DRAIN) { E.fused(acc, cur, wr, wc, fr, fq, lds, wid, lane); S.done(cur); }
#undef PG8_SA
#undef PG8_SB
#undef PG8_STAGE
#undef PG8_LDA
#undef PG8_LDB
#undef PG8_MMA
#undef PG8_WAIT_V
#undef PG8_WAIT_L
#undef PG8_BAR
#undef PG8_SCHED
}
}

constexpr size_t MiB = 1u << 20;
constexpr size_t WS_W = 0, W_LAYER = 40 * MiB;
constexpr size_t WO_GU1 = 0, WO_D1 = 11 * MiB, WO_IN = WO_D1 + 11 * MiB / 2, WO_OUT = WO_IN + 5 * MiB, WO_GU2 = WO_OUT + 2 * MiB, WO_D2 = WO_GU2 + 11 * MiB;
static_assert(WO_D2 + 11 * MiB / 2 == W_LAYER, "weight map");
constexpr size_t WS_XB = 160 * MiB;
constexpr size_t WS_ACT = 224 * MiB;
constexpr size_t WS_MIX = 400 * MiB;
constexpr size_t WS_ROPE = 464 * MiB;
constexpr size_t WS_SSQ = 476 * MiB;
constexpr size_t SSQ_SLOT = (size_t)MTOK * 16;
constexpr size_t WS_RGW = 474 * MiB;
constexpr size_t WS_AGG = 475 * MiB;
constexpr size_t WS_TS = 502 * MiB;
constexpr size_t WS_BAR = 504 * MiB;
constexpr size_t WS_END = 505 * MiB;
constexpr size_t PO_BYTES = (size_t)MTOK * 384 * 2;
constexpr size_t OB_PO4 = 0, OB_PO16 = PO_BYTES, OB_LSE4 = 2 * PO_BYTES, OB_LSE16 = OB_LSE4 + MiB;
static_assert(OB_LSE16 + MiB <= (size_t)MTOK * DM * 4, "partials fit the output buffer");

constexpr int LDS_BYTES = 147456;
constexpr int VROW = 144;

struct Args { const void* in[22]; float* out; unsigned char* ws; };
__device__ const float INV_TAB[32] = {1.000000000e+00f, 7.498942018e-01f, 5.623413324e-01f, 4.216965139e-01f, 3.162277639e-01f, 2.371373773e-01f, 1.778279394e-01f, 1.333521456e-01f, 1.000000015e-01f, 7.498942316e-02f, 5.623413250e-02f, 4.216964915e-02f, 3.162277490e-02f, 2.371373773e-02f, 1.778279431e-02f, 1.333521400e-02f, 9.999999776e-03f, 7.498942316e-03f, 5.623413250e-03f, 4.216964822e-03f, 3.162277630e-03f, 2.371373819e-03f, 1.778279431e-03f, 1.333521446e-03f, 1.000000047e-03f, 7.498941850e-04f, 5.623413017e-04f, 4.216965172e-04f, 3.162277571e-04f, 2.371373703e-04f, 1.778279402e-04f, 1.333521504e-04f};

#define MFMA32(a, b, c) __builtin_amdgcn_mfma_f32_32x32x16_bf16((a), (b), (c), 0, 0, 0)
__device__ __forceinline__ int crow(int reg, int h) { return (reg & 3) + 8 * (reg >> 2) + 4 * h; }

struct AttnOut { bf16_t* mix; bf16_t* po; float* lse; const bf16_t* po4; const bf16_t* po16; const float* lse4; const float* lse16; float sink; };

__device__ __forceinline__ void store_row16(bf16_t* rowp  , const u32x2 (&wv)[4], int kh) {
#pragma unroll
    for (int gp = 0; gp < 2; ++gp) {
        const u32x2 keep = kh ? wv[2 * gp + 1] : wv[2 * gp], send = kh ? wv[2 * gp] : wv[2 * gp + 1];
        u32x2 recv; recv.x = (unsigned)__shfl_xor((int)send.x, 32); recv.y = (unsigned)__shfl_xor((int)send.y, 32);
        u32x4 w; if (kh) { w.x = recv.x; w.y = recv.y; w.z = keep.x; w.w = keep.y; } else { w.x = keep.x; w.y = keep.y; w.z = recv.x; w.w = recv.y; }
        *(u32x4*)(rowp + 8 * (2 * gp + kh)) = w;
    }
}
template <int MODE>
__device__ __forceinline__ void attn_finish(const f32x16& O0, const f32x16& O1, float m2, float lsum, int tok, int ocol, int hidx, int kh, const AttnOut& AO) {
    const float l = lsum + __shfl_xor(lsum, 32);
    const float lse = (m2 + __log2f(l)) * 0.6931471805599453f;
    const float rl = fast_rcp(l);
    if (MODE == 0) {
        const float gate = fast_rcp(1.0f + __expf(AO.sink - lse)) * rl;
        bf16_t* op = AO.mix + (size_t)tok * DM + ocol;
        u32x2 w0[4], w1[4];
#pragma unroll
        for (int g = 0; g < 4; ++g) {
            w0[g].x = pk2(O0[4 * g] * gate, O0[4 * g + 1] * gate); w0[g].y = pk2(O0[4 * g + 2] * gate, O0[4 * g + 3] * gate);
            w1[g].x = pk2(O1[4 * g] * gate, O1[4 * g + 1] * gate); w1[g].y = pk2(O1[4 * g + 2] * gate, O1[4 * g + 3] * gate);
        }
        store_row16(op, w0, kh); store_row16(op + 32, w1, kh);
    } else if (MODE == 1) {
        bf16_t* op = AO.po + (size_t)tok * 384 + hidx * 64;
        u32x2 w0[4], w1[4];
#pragma unroll
        for (int g = 0; g < 4; ++g) {
            w0[g].x = pk2(O0[4 * g] * rl, O0[4 * g + 1] * rl); w0[g].y = pk2(O0[4 * g + 2] * rl, O0[4 * g + 3] * rl);
            w1[g].x = pk2(O1[4 * g] * rl, O1[4 * g + 1] * rl); w1[g].y = pk2(O1[4 * g + 2] * rl, O1[4 * g + 3] * rl);
        }
        store_row16(op, w0, kh); store_row16(op + 32, w1, kh);
        if (kh == 0) AO.lse[(size_t)tok * 6 + hidx] = lse;
    } else {
        const float l4 = AO.lse4[(size_t)tok * 6 + hidx], l16 = AO.lse16[(size_t)tok * 6 + hidx];
        const float mxl = fmaxf(lse, fmaxf(l4, l16));
        float w1 = __expf(lse - mxl), w4 = __expf(l4 - mxl), w16 = __expf(l16 - mxl);
        const float rs = fast_rcp(w1 + w4 + w16);
        w1 *= rs * rl; w4 *= rs; w16 *= rs;
        const bf16_t* p4 = AO.po4 + (size_t)tok * 384 + hidx * 64 + 4 * kh;
        const bf16_t* p16 = AO.po16 + (size_t)tok * 384 + hidx * 64 + 4 * kh;
        bf16_t* op = AO.mix + (size_t)tok * DM + ocol;
        u32x2 wq[2][4];
#pragma unroll
        for (int g = 0; g < 4; ++g) {
#pragma unroll
            for (int mt = 0; mt < 2; ++mt) {
                const u32x2 a = *(const u32x2*)(p4 + 32 * mt + 8 * g), b = *(const u32x2*)(p16 + 32 * mt + 8 * g);
                float o[4];
#pragma unroll
                for (int e = 0; e < 4; ++e) o[e] = (mt ? O1[4 * g + e] : O0[4 * g + e]) * w1;
                o[0] += bflo(a.x) * w4 + bflo(b.x) * w16; o[1] += bfhi(a.x) * w4 + bfhi(b.x) * w16;
                o[2] += bflo(a.y) * w4 + bflo(b.y) * w16; o[3] += bfhi(a.y) * w4 + bfhi(b.y) * w16;
                wq[mt][g].x = pk2(o[0], o[1]); wq[mt][g].y = pk2(o[2], o[3]);
            }
        }
        store_row16(op, wq[0], kh); store_row16(op + 32, wq[1], kh);
    }
}

struct AttnGeom { int tokb, dil, u0, qcol, kcol, vcol, ocol, hidx, maxd, mode; bool perm; float sink; bf16_t* po; float* lse; };
constexpr int KV_ROWS = 384, VIMG_OFF = KV_ROWS * VROW;

__device__ __forceinline__ void kv_fetch(const bf16_t* __restrict__ P, const AttnGeom& G, int tid, bf16x8 (&kv)[12], bf16x8 (&qn)[4], int wave, int lane) {
    const int piece = tid & 7, rb = tid >> 3;
#pragma unroll
    for (int i = 0; i < 12; ++i) {
        const int row = rb + 64 * (i % 6), u = G.u0 - 128 + row;
        if (u >= 0) kv[i] = *(const bf16x8*)(P + p_off((i < 6 ? G.kcol : G.vcol) >> 6, G.perm, G.tokb + G.dil * u) + 8 * piece);
    }
    const bf16_t* qp = P + p_off(G.qcol >> 6, G.perm, G.tokb + G.dil * (G.u0 + 32 * wave + (lane & 31))) + 8 * (lane >> 5);
#pragma unroll
    for (int ks = 0; ks < 4; ++ks) qn[ks] = *(const bf16x8*)(qp + 16 * ks);
}
__device__ __forceinline__ void kv_store(LAS unsigned char* lds, int tid, const bf16x8 (&kv)[12]) {
    const int piece = tid & 7, rb = tid >> 3;
#pragma unroll
    for (int i = 0; i < 12; ++i) *(LAS bf16x8*)(lds + (i < 6 ? 0 : VIMG_OFF) + (rb + 64 * (i % 6)) * VROW + 16 * piece) = kv[i];
}

__device__ __forceinline__ void attn_wave(LAS unsigned char* lds, const AttnGeom& G, const bf16x8 (&qf)[4], int wave, int lane, const AttnOut& AO0) {
    const int r = lane & 31, kh = lane >> 5;
    const int u0w = G.u0 + 32 * wave;
    f32x16 O0, O1;
#pragma unroll
    for (int j = 0; j < 16; ++j) { O0[j] = 0.f; O1[j] = 0.f; }
    float m2 = -INFINITY, lsum = 0.f;
    const int trlane = ((4 * kh + ((lane & 15) >> 2)) * VROW + 32 * ((lane >> 4) & 1) + 8 * (lane & 3));
    for (int kt = (u0w >= 128 ? 0 : (128 - u0w) >> 5); kt < 5; ++kt) {
        const int ks0 = u0w - 128 + 32 * kt, lrow0 = 32 * wave + 32 * kt;
        bf16x8 kf[4];
        { const LAS unsigned char* kp = lds + (lrow0 + r) * VROW + 16 * kh;
#pragma unroll
          for (int ks = 0; ks < 4; ++ks) kf[ks] = *(const LAS bf16x8*)(kp + 32 * ks); }
        f32x16 S;
#pragma unroll
        for (int j = 0; j < 16; ++j) S[j] = 0.f;
#pragma unroll
        for (int ks = 0; ks < 4; ++ks) S = MFMA32(kf[ks], qf[ks], S);
        if (kt == 0 || kt == 4) {
            const int uq = u0w + r;
#pragma unroll
            for (int j = 0; j < 16; ++j) { const int diff = uq - (ks0 + crow(j, kh)); if (diff < 0 || diff > G.maxd) S[j] = -INFINITY; }
        }
        float mx = S[0];
#pragma unroll
        for (int j = 1; j < 16; ++j) mx = fmaxf(mx, S[j]);
        mx = fmaxf(mx, __shfl_xor(mx, 32));
        const float mnew = fmaxf(m2, mx);
        const float msafe = (mnew == -INFINITY) ? 0.f : mnew;
        const float alpha = fast_exp2(m2 - msafe);
        m2 = mnew;
        float ps = 0.f;
#pragma unroll
        for (int j = 0; j < 16; ++j) { S[j] = fast_exp2(S[j] - msafe); ps += S[j]; }
        lsum = lsum * alpha + ps;
#pragma unroll
        for (int j = 0; j < 16; ++j) { O0[j] *= alpha; O1[j] *= alpha; }
        bf16x8 pf[2];
#pragma unroll
        for (int s = 0; s < 2; ++s) { u32x4 w; w.x = pk2(S[8 * s], S[8 * s + 1]); w.y = pk2(S[8 * s + 2], S[8 * s + 3]); w.z = pk2(S[8 * s + 4], S[8 * s + 5]); w.w = pk2(S[8 * s + 6], S[8 * s + 7]); pf[s] = __builtin_bit_cast(bf16x8, w); }
        LAS s16x4* vt = (LAS s16x4*)(lds + VIMG_OFF + lrow0 * VROW + trlane);
#define TRR(BYTES) __builtin_amdgcn_ds_read_tr16_b64_v4i16(vt + (BYTES) / 8)
        const bf16x8 v00 = __builtin_shufflevector(TRR(0), TRR(1152), 0, 1, 2, 3, 4, 5, 6, 7), v01 = __builtin_shufflevector(TRR(2304), TRR(3456), 0, 1, 2, 3, 4, 5, 6, 7);
        const bf16x8 v10 = __builtin_shufflevector(TRR(64), TRR(1216), 0, 1, 2, 3, 4, 5, 6, 7), v11 = __builtin_shufflevector(TRR(2368), TRR(3520), 0, 1, 2, 3, 4, 5, 6, 7);
#undef TRR
        O0 = MFMA32(v00, pf[0], O0); O0 = MFMA32(v01, pf[1], O0);
        O1 = MFMA32(v10, pf[0], O1); O1 = MFMA32(v11, pf[1], O1);
    }
    AttnOut AO = AO0; AO.sink = G.sink; AO.po = G.po; AO.lse = G.lse;
    const int tok = G.tokb + G.dil * (u0w + r);
    if (G.mode == 0) attn_finish<0>(O0, O1, m2, lsum, tok, G.ocol, G.hidx, kh, AO);
    else if (G.mode == 1) attn_finish<1>(O0, O1, m2, lsum, tok, G.ocol, G.hidx, kh, AO);
    else attn_finish<2>(O0, O1, m2, lsum, tok, G.ocol, G.hidx, kh, AO);
}

struct RgParams { const bf16_t* P; const int* pos; const float* conv_w; const float* conv_b; const bf16_t* wrT; const bf16_t* wiT; const float* b_r; const float* b_i; const float* lam; float* agg; bf16_t* mix; };

template <bool FINAL>
__device__ __forceinline__ void rglru_item(const RgParams& R, int sc, int h, int nt, int lane, LAS unsigned char* yimg) {
    const int r = lane & 31, kh = lane >> 5;
    const int tok_sc = sc * 128, bstart = (sc >> 7) * 128;
    const int ncol = 32 * nt + r, cg = 64 * h + ncol;
    const float br = R.b_r[cg], bi = R.b_i[cg], sp8l = -8.0f * 1.4426950408889634f * log1pf(expf(-R.lam[cg]));
    float carry = 0.f, atot = 1.f;
    if (FINAL) {
        const float* ag = R.agg + (size_t)cg * 2; int s = bstart;
        for (; s + 8 <= sc; s += 8) {
            f32x2 ab[8];
#pragma unroll
            for (int i = 0; i < 8; ++i) ab[i] = *(const f32x2*)(ag + (size_t)(s + i) * 768);
#pragma unroll
            for (int i = 0; i < 8; ++i) carry = ab[i].x * carry + ab[i].y;
        }
        for (; s < sc; ++s) { const f32x2 ab = *(const f32x2*)(ag + (size_t)s * 768); carry = ab.x * carry + ab.y; }
    }
    const int cc = 64 * h + lane;
    const float cw0 = R.conv_w[cc], cw1 = R.conv_w[384 + cc], cw2 = R.conv_w[768 + cc], cw3 = R.conv_w[1152 + cc], cb = R.conv_b[cc];
    unsigned short xr[32];
    const unsigned goff = (unsigned)(4 * kh * 64 + ncol);
    float xm1 = 0.f, xm2 = 0.f, xm3 = 0.f;
    { const bf16_t* xp = R.P + p_off(PC_XC / 64 + h, false, tok_sc);
      if ((tok_sc & (SEQ - 1)) != 0) { xm1 = bf2f((xp - 1 * 64)[lane]); xm2 = bf2f((xp - 2 * 64)[lane]); xm3 = bf2f((xp - 3 * 64)[lane]); }
#pragma unroll
      for (int t = 0; t < 32; ++t) xr[t] = (xp + (size_t)t * 64)[lane]; }
    for (int mt = 0; mt < 4; ++mt) {
        const int t0 = tok_sc + 32 * mt;
        bf16x8 yf[4];
        {
#pragma unroll
          for (int t = 0; t < 32; ++t) {
              const float x0 = bf2f(xr[t]);
              const float y = cb + cw0 * x0 + cw1 * xm1 + cw2 * xm2 + cw3 * xm3;
              *(LAS bf16_t*)(yimg + t * VROW + 2 * lane) = (bf16_t)(pk2(y, 0.f) & 0xffffu);
              xm3 = xm2; xm2 = xm1; xm1 = x0;
          }
          if (mt < 3) { const bf16_t* xp = R.P + p_off(PC_XC / 64 + h, false, t0 + 32);
#pragma unroll
              for (int t = 0; t < 32; ++t) xr[t] = (xp + (size_t)t * 64)[lane]; }
#pragma unroll
          for (int ks = 0; ks < 4; ++ks) yf[ks] = *(const LAS bf16x8*)(yimg + r * VROW + 32 * ks + 16 * kh);
        }
        unsigned short graw[16];
        if (FINAL) {
#pragma unroll
            for (int j = 0; j < 16; ++j) graw[j] = (R.P + p_off(PC_GC / 64 + h, false, t0 + (j & 3) + 8 * (j >> 2)))[goff];
        }
        unsigned rmask = 0u;
#pragma unroll
        for (int g = 0; g < 4; ++g) { const int4 p4 = *(const int4*)(R.pos + t0 + 8 * g + 4 * kh);
            rmask |= (p4.x == 0 ? 1u : 0u) << (4 * g); rmask |= (p4.y == 0 ? 1u : 0u) << (4 * g + 1); rmask |= (p4.z == 0 ? 1u : 0u) << (4 * g + 2); rmask |= (p4.w == 0 ? 1u : 0u) << (4 * g + 3); }
        f32x16 ra, ia, ya;
#pragma unroll
        for (int j = 0; j < 16; ++j) { ra[j] = 0.f; ia[j] = 0.f; ya[j] = 0.f; }
        int ncl = ncol; asm volatile("" : "+v"(ncl));
#pragma unroll
        for (int ks = 0; ks < 4; ++ks) {
            const size_t wo = ((size_t)h * 64 + ncl) * 64 + 16 * ks + 8 * kh;
            const bf16x8 wrf = *(const bf16x8*)(R.wrT + wo), wif = *(const bf16x8*)(R.wiT + wo);
            bf16x8 idf;
#pragma unroll
            for (int i = 0; i < 8; ++i) idf[i] = (16 * ks + 8 * kh + i == ncl) ? (short)0x3f80 : (short)0;
            ra = MFMA32(yf[ks], wrf, ra); ia = MFMA32(yf[ks], wif, ia); ya = MFMA32(yf[ks], idf, ya);
        }
        float av[16], bv[16];
#pragma unroll
        for (int j = 0; j < 16; ++j) {
            const float rr = sigmoidf_(ra[j] + br), ii = sigmoidf_(ia[j] + bi);
            const float a_ = fast_exp2(sp8l * rr);
            float a = a_, mult = __builtin_amdgcn_sqrtf(1.0f - a_ * a_);
            if ((rmask >> j) & 1u) { a = 0.f; mult = 1.f; }
            av[j] = a; bv[j] = mult * ii * ya[j];
        }
        float sa[4], sb[4], pa[4], pb[4];
#pragma unroll
        for (int g = 0; g < 4; ++g) {
            sa[g] = (av[4 * g] * av[4 * g + 1]) * (av[4 * g + 2] * av[4 * g + 3]);
            sb[g] = ((bv[4 * g] * av[4 * g + 1] + bv[4 * g + 1]) * av[4 * g + 2] + bv[4 * g + 2]) * av[4 * g + 3] + bv[4 * g + 3];
            pa[g] = __shfl_xor(sa[g], 32); pb[g] = __shfl_xor(sb[g], 32);
        }
        float c = carry, cin[4], apr = 1.f;
#pragma unroll
        for (int g = 0; g < 4; ++g) {
            const float a0 = kh ? pa[g] : sa[g], b0 = kh ? pb[g] : sb[g], a1 = kh ? sa[g] : pa[g], b1 = kh ? sb[g] : pb[g];
            const float ce = c; c = a0 * c + b0;
            const float co = c; c = a1 * c + b1;
            cin[g] = kh ? co : ce; apr *= a0 * a1;
        }
        carry = c; atot *= apr;
        if (FINAL) {
#pragma unroll
            for (int g = 0; g < 4; ++g) {
                float hp = cin[g];
#pragma unroll
                for (int e = 0; e < 4; ++e) {
                    const int j = 4 * g + e, tok = t0 + crow(j, kh);
                    hp = av[j] * hp + bv[j];
                    const float gt = bf2f(graw[j]);
                    const float z = 0.7978845608028654f * (gt + 0.044715f * gt * gt * gt);
                    const float th = 1.0f - 2.0f * fast_rcp(__expf(2.0f * z) + 1.0f);
                    const float o = hp * 0.5f * gt * (1.0f + th);
                    *(LAS bf16_t*)(yimg + 4608 + crow(j, kh) * 80 + 2 * r) = (bf16_t)(pk2(o, 0.f) & 0xffffu);
                    (void)tok;
                }
            }
#pragma unroll
            for (int q = 0; q < 2; ++q) {
                const int p = lane + 64 * q, tk = p >> 2, qu = p & 3;
                const u32x4 w = *(const LAS u32x4*)(yimg + 4608 + tk * 80 + 16 * qu);
                *(u32x4*)(R.mix + (size_t)(t0 + tk) * DM + 640 + 64 * h + 32 * nt + 8 * qu) = w;
            }
        }
    }
    if (!FINAL && kh == 0) { f32x2 ab = {atot, carry}; *(f32x2*)(R.agg + ((size_t)sc * 384 + cg) * 2) = ab; }
}

struct MapPlain { const float* w; int ld; __device__ __forceinline__ const float* operator()(int R) const { return w + R; } };
struct MapGU { const float* gate; const float* up; int ld;
    __device__ __forceinline__ const float* operator()(int R) const { const int j = 128 * (R >> 8) + (R & 127); const uintptr_t a = (uintptr_t)gate, b = (uintptr_t)up, sel = (uintptr_t)0 - (uintptr_t)((R >> 7) & 1); return (const float*)(a ^ ((a ^ b) & sel)) + j; } };
struct MapIN { const float* w; int ld;
    __device__ __forceinline__ const float* operator()(int R) const {
        int c = R;
        if (R < PC_VA || (R >= PC_QB && R < PC_VB)) { const int q = R & 63; c = (R & ~63) + 32 * ((q >> 2) & 1) + 16 * ((q >> 5) & 1) + 4 * ((q >> 3) & 3) + (q & 3); }
        if (c >= 1664 && c < PC_XC) return nullptr;
        if (c >= PC_XC) c -= 128;
        return w + c; } };

template <class Map>
__device__ __forceinline__ void transpose_item(const Map mp, int K, int N, bf16_t* WT, const float* gain, LAS float* scr, int item, int lane) {
    const int nblk = N / 32, kb = item / nblk, nb = item % nblk, k0 = 64 * kb, n0 = 32 * nb;
    const float* src = mp(n0 + (lane & 31));
    float v[32];
#pragma unroll
    for (int i = 0; i < 32; ++i) { const int kk = 2 * i + (lane >> 5); v[i] = src ? src[(size_t)(k0 + kk) * mp.ld] : 0.f; }
#pragma unroll
    for (int i = 0; i < 32; ++i) { const int kk = 2 * i + (lane >> 5); float t = v[i]; if (gain) t *= gain[k0 + kk]; scr[kk * 33 + (lane & 31)] = t; }
    asm volatile("s_waitcnt lgkmcnt(0)" ::: "memory");
    const int c = lane & 7;
#pragma unroll
    for (int j = 0; j < 4; ++j) { const int n = (lane >> 3) + 8 * j; const LAS float* s = scr + (8 * c) * 33 + n;
        u32x4 o; o.x = pk2(s[0 * 33], s[1 * 33]); o.y = pk2(s[2 * 33], s[3 * 33]); o.z = pk2(s[4 * 33], s[5 * 33]); o.w = pk2(s[6 * 33], s[7 * 33]);
        *(u32x4*)(WT + (size_t)(n0 + n) * K + k0 + 8 * c) = o; }
    asm volatile("s_waitcnt lgkmcnt(0)" ::: "memory");
}

__device__ __forceinline__ float wave_sum(float v) {
#pragma unroll
    for (int o = 1; o < 64; o <<= 1) v += __shfl_xor(v, o);
    return v;
}

__device__ __forceinline__ void sincos_d(double a, float& c, float& s) {
    const double n = rint(a * 0.6366197723675814);
    double t = fma(-n, 1.5707963267948966, a); t = fma(-n, 6.123233995736766e-17, t);
    const double t2 = t * t;
    double sp = -1.0 / 1307674368000.0; sp = sp * t2 + 1.0 / 6227020800.0; sp = sp * t2 - 1.0 / 39916800.0; sp = sp * t2 + 1.0 / 362880.0; sp = sp * t2 - 1.0 / 5040.0; sp = sp * t2 + 1.0 / 120.0; sp = sp * t2 - 1.0 / 6.0; sp = sp * t2 + 1.0;
    const double sn = sp * t;
    double cp = 1.0 / 20922789888000.0; cp = cp * t2 - 1.0 / 87178291200.0; cp = cp * t2 + 1.0 / 479001600.0; cp = cp * t2 - 1.0 / 3628800.0; cp = cp * t2 + 1.0 / 40320.0; cp = cp * t2 - 1.0 / 720.0; cp = cp * t2 + 1.0 / 24.0; cp = cp * t2 - 0.5; cp = cp * t2 + 1.0;
    const int q = (int)((long long)n & 3);
    const double cc = (q == 0) ? cp : (q == 1) ? -sn : (q == 2) ? -cp : sn;
    const double ss = (q == 0) ? sn : (q == 1) ? cp : (q == 2) ? -sn : -cp;
    c = (float)cc; s = (float)ss;
}

typedef const __attribute__((address_space(4))) Args* KArgs;
__device__ __forceinline__ KArgs kargs() { KArgs p = (KArgs)__builtin_amdgcn_kernarg_segment_ptr(); asm volatile("" : "+s"(p)); return p; }
#define IN_F(k) ((const float*)ap->in[k])
__device__ __forceinline__ int fresh_tid(int wave0) { int t = wave0 * 64 + (int)__builtin_amdgcn_mbcnt_hi(~0u, __builtin_amdgcn_mbcnt_lo(~0u, 0u)); asm volatile("" : "+v"(t)); return t; }

__device__ __forceinline__ void touch_lines(const unsigned char* p, size_t bytes, int tid) {
    unsigned acc = 0u;
    for (size_t off = ((size_t)blockIdx.x * 512 + tid) * 128; off < bytes; off += (size_t)gridDim.x * 512 * 128) acc += *(const volatile unsigned*)(p + off);
    asm volatile("" :: "v"(acc));
}
template <int WHICH>
__device__ __forceinline__ void gemm_stage(LAS unsigned char* lds, int l, int ffn, int wave0) {
    KArgs ap = kargs();
    unsigned char* ws = ap->ws; const int G = gridDim.x;
    unsigned char* wl = ws + WS_W + (size_t)l * W_LAYER;
    bf16_t* XB = (bf16_t*)(ws + WS_XB); bf16_t* ACT = (bf16_t*)(ws + WS_ACT); float* ssq0 = (float*)(ws + WS_SSQ) + (size_t)(3 * l) * SSQ_SLOT;
    if (WHICH == 0) {
        pg8::Gemm g{XB, (const bf16_t*)(wl + (ffn ? WO_GU2 : WO_GU1)), MTOK, NGU, DM}; pg8::StaticOrder S; S.init(MTOK, NGU, G, (int)blockIdx.x);
        pg8::EpiGateUp E{ssq0 + (ffn ? 2 * SSQ_SLOT : 0), ACT, lds + 131072 + 256, (3 * l + (ffn ? 2 : 0)) * 256};
        pg8::gemm_phase<pg8::EpiGateUp, pg8::StaticOrder, true, true>(lds, g, S, E, fresh_tid(wave0));
        touch_lines(wl + (ffn ? WO_D2 : WO_D1), (size_t)DM * FF * 2, fresh_tid(wave0));
    } else if (WHICH == 1) {
        pg8::Gemm g{ACT, (const bf16_t*)(wl + (ffn ? WO_D2 : WO_D1)), MTOK, DM, FF}; pg8::StaticOrder S; S.init(MTOK, DM, G, (int)blockIdx.x);
        pg8::EpiResidual E{XB, ssq0 + (ffn ? 3 * SSQ_SLOT : SSQ_SLOT), 0.5f};
        pg8::gemm_phase<pg8::EpiResidual, pg8::StaticOrder, true, true>(lds, g, S, E, fresh_tid(wave0));
        if (ffn == 0) touch_lines(wl + WO_IN, (size_t)NIN * DM * 2, fresh_tid(wave0));
        else if (l + 1 < DEPTH) touch_lines(wl + W_LAYER + WO_GU1, (size_t)NGU * DM * 2, fresh_tid(wave0));
    } else if (WHICH == 2) {
        float* cosT = (float*)(ws + WS_ROPE);
        pg8::Gemm g{XB, (const bf16_t*)(wl + WO_IN), MTOK, NIN, DM}; pg8::StaticOrder S; S.init(MTOK, NIN, G, (int)blockIdx.x);
        pg8::EpiProj E{ssq0 + SSQ_SLOT, cosT, cosT + (size_t)MTOK * 32, ACT, lds + 131072 + 256, (3 * l + 1) * 256};
        pg8::gemm_phase<pg8::EpiProj, pg8::StaticOrder, true, true>(lds, g, S, E, fresh_tid(wave0));
    } else {
        pg8::Gemm g{(const bf16_t*)(ws + WS_MIX), (const bf16_t*)(wl + WO_OUT), MTOK, DM, DM}; pg8::StaticOrder S; S.init(MTOK, DM, G, (int)blockIdx.x);
        pg8::EpiResidual E{XB, ssq0 + 2 * SSQ_SLOT, 1.0f};
        pg8::gemm_phase<pg8::EpiResidual, pg8::StaticOrder, true, true>(lds, g, S, E, fresh_tid(wave0));
        touch_lines(wl + WO_GU2, (size_t)NGU * DM * 2, fresh_tid(wave0));
    }
}

__device__ __forceinline__ void prologue_stage(LAS unsigned char* lds, int wave0) {
    KArgs ap = kargs(); const int tid = fresh_tid(wave0), lane = tid & 63, wave = __builtin_amdgcn_readfirstlane(tid >> 6);
    unsigned char* ws = ap->ws; const int G = gridDim.x, gw = blockIdx.x * 8 + wave, NGW = G * 8;
    LAS float* scr = (LAS float*)(lds + wave * 16384);
    constexpr int I_GU = (DM / 64) * (NGU / 32), I_D = (FF / 64) * (DM / 32), I_IN = (DM / 64) * (NIN / 32), I_OUT = (DM / 64) * (DM / 32);
    constexpr int I_LAYER = 2 * I_GU + 2 * I_D + I_IN + I_OUT;
    for (int it = gw; it < DEPTH * I_LAYER; it += NGW) {
        const int l = it / I_LAYER; int r = it % I_LAYER;
        unsigned char* wl = ws + WS_W + (size_t)l * W_LAYER;
        if (r < I_GU) { MapGU mp{IN_F(3) + (size_t)l * DM * FF, IN_F(4) + (size_t)l * DM * FF, FF};
            transpose_item(mp, DM, NGU, (bf16_t*)(wl + WO_GU1), IN_F(2) + l * DM, scr, r, lane); continue; } r -= I_GU;
        if (r < I_D) { MapPlain mp{IN_F(5) + (size_t)l * FF * DM, DM};
            transpose_item(mp, FF, DM, (bf16_t*)(wl + WO_D1), nullptr, scr, r, lane); continue; } r -= I_D;
        if (r < I_IN) { MapIN mp{IN_F(7) + (size_t)l * DM * INC, INC};
            transpose_item(mp, DM, NIN, (bf16_t*)(wl + WO_IN), IN_F(6) + l * DM, scr, r, lane); continue; } r -= I_IN;
        if (r < I_OUT) { MapPlain mp{IN_F(16) + (size_t)l * DM * DM, DM};
            transpose_item(mp, DM, DM, (bf16_t*)(wl + WO_OUT), nullptr, scr, r, lane); continue; } r -= I_OUT;
        if (r < I_GU) { MapGU mp{IN_F(18) + (size_t)l * DM * FF, IN_F(19) + (size_t)l * DM * FF, FF};
            transpose_item(mp, DM, NGU, (bf16_t*)(wl + WO_GU2), IN_F(17) + l * DM, scr, r, lane); continue; } r -= I_GU;
        { MapPlain mp{IN_F(20) + (size_t)l * FF * DM, DM};
            transpose_item(mp, FF, DM, (bf16_t*)(wl + WO_D2), nullptr, scr, r, lane); }
    }
    const int gt = blockIdx.x * 512 + tid, NGT = G * 512;
    { const int* positions = (const int*)ap->in[1]; float* cosT = (float*)(ws + WS_ROPE); float* sinT = cosT + (size_t)MTOK * 32;
      for (int i = gt; i < MTOK * 32; i += NGT) {
          const int tok = i >> 5, k = i & 31;
          const float ang = (float)positions[tok] * INV_TAB[k];
          float c, s; sincos_d((double)ang, c, s);
          cosT[i] = c; sinT[i] = s;
      } }
    { float* SSQ = (float*)(ws + WS_SSQ);
      const float* x_in = IN_F(0); bf16_t* XB = (bf16_t*)(ws + WS_XB);
      for (int m = gw; m < MTOK; m += NGW) {
          const f32x4* xr = (const f32x4*)(x_in + (size_t)m * DM) + lane; float s = 0.f;
          unsigned long long* o8 = (unsigned long long*)(XB + (size_t)m * DM) + lane;
#pragma unroll
          for (int j = 0; j < 4; ++j) { const f32x4 v = xr[64 * j]; s += (v.x * v.x + v.y * v.y) + (v.z * v.z + v.w * v.w);
              o8[64 * j] = (unsigned long long)pk2(v.x, v.y) | ((unsigned long long)pk2(v.z, v.w) << 32); }
          s = wave_sum(s);
          if (lane < 16) SSQ[(size_t)m * 16 + lane] = lane == 0 ? s : 0.f;
      } }
    { bf16_t* RGW = (bf16_t*)(ws + WS_RGW); const float* wr = IN_F(11); const float* wi = IN_F(13);
      for (int i = gt; i < DEPTH * 2 * 6 * 4096; i += NGT) {
          const int ii = i & 63, j = (i >> 6) & 63, h = (i >> 12) % 6, gl = i / (6 * 4096), g = gl & 1, l = gl >> 1;
          const size_t so = ((size_t)(l * 6 + h) * 64 + ii) * 64 + j;
          const float v = g ? wi[so] : wr[so];
          RGW[i] = (bf16_t)(pk2(v, 0.f) & 0xffffu);
      } }
}

template <int SUB>
__device__ __forceinline__ void mixer_rg(LAS unsigned char* lds, int l, int wave0) {
    KArgs ap = kargs(); const int tid = fresh_tid(wave0), lane = tid & 63, wave = __builtin_amdgcn_readfirstlane(tid >> 6);
    unsigned char* ws = ap->ws; const int gw = blockIdx.x * 8 + wave, NGW = gridDim.x * 8;
    bf16_t* RGW = (bf16_t*)(ws + WS_RGW);
    RgParams RP{(const bf16_t*)(ws + WS_ACT), (const int*)ap->in[1], IN_F(9) + (size_t)l * 4 * 384, IN_F(10) + l * 384,
                RGW + (size_t)(l * 2 + 0) * 6 * 4096, RGW + (size_t)(l * 2 + 1) * 6 * 4096,
                IN_F(12) + l * 384, IN_F(14) + l * 384, IN_F(15) + l * 384, (float*)(ws + WS_AGG), (bf16_t*)(ws + WS_MIX)};
    LAS unsigned char* yimg = lds + wave * 8192;
    constexpr int N_RG = 256 * 12;
    for (int it = gw; it < N_RG; it += NGW) rglru_item<SUB == 1>(RP, it / 12, (it % 12) >> 1, it & 1, lane, yimg);
}
template <int SUB>
__device__ __forceinline__ void mixer_attn(LAS unsigned char* lds, int l, int wave0) {
    KArgs ap = kargs(); const int tid = fresh_tid(wave0), lane = tid & 63, wave = __builtin_amdgcn_readfirstlane(tid >> 6);
    unsigned char* ws = ap->ws; const int G = gridDim.x;
    const bf16_t* PB = (const bf16_t*)(ws + WS_ACT);
    unsigned char* obp = (unsigned char*)ap->out;
    AttnOut AO{(bf16_t*)(ws + WS_MIX), nullptr, nullptr, (const bf16_t*)(obp + OB_PO4), (const bf16_t*)(obp + OB_PO16), (const float*)(obp + OB_LSE4), (const float*)(obp + OB_LSE16), 0.f};
    const float* sinks = IN_F(8) + l * 4;
    auto geom = [&](int j) -> AttnGeom {
        AttnGeom g; g.sink = 0.f; g.po = nullptr; g.lse = nullptr; g.ocol = 0;
        if (SUB == 0) {
            const int br = j / 768, rr = j % 768, dil = br ? 16 : 4, nblk = SEQ / dil / 256;
            const int qb = rr % nblk, rho = (rr / nblk) % dil, bh = rr / (nblk * dil), h = bh % 6, b = bh / 6;
            g.tokb = b * SEQ + rho; g.dil = dil; g.u0 = qb * 256; g.qcol = PC_QB + 64 * h; g.kcol = PC_KB + 64 * h; g.vcol = PC_VB + 64 * h; g.hidx = h; g.maxd = 128; g.mode = 1; g.perm = true;
            g.po = (bf16_t*)(obp + (br ? OB_PO16 : OB_PO4)); g.lse = (float*)(obp + (br ? OB_LSE16 : OB_LSE4));
        } else if (j < 512) {
            const int qb = j % 64, bhq = j / 64, hq = bhq % 4, b = bhq / 4, kv = hq >> 1;
            g.tokb = b * SEQ; g.dil = 1; g.u0 = qb * 256; g.qcol = PC_QA + 64 * hq; g.kcol = PC_KA + 64 * kv; g.vcol = PC_VA + 64 * kv; g.ocol = 64 * hq; g.hidx = hq; g.maxd = 127; g.mode = 0; g.perm = false;
            g.sink = sinks[hq];
        } else {
            const int rr = j - 512, qb = rr % 64, bh = rr / 64, h = bh % 6, b = bh / 6;
            g.tokb = b * SEQ; g.dil = 1; g.u0 = qb * 256; g.qcol = PC_QB + 64 * h; g.kcol = PC_KB + 64 * h; g.vcol = PC_VB + 64 * h; g.ocol = 256 + 64 * h; g.hidx = h; g.maxd = 128; g.mode = 2; g.perm = true;
        }
        return g;
    };
    constexpr int N_ATT = SUB == 0 ? 1536 : 1280;
    asm volatile("s_waitcnt lgkmcnt(0)" ::: "memory"); __builtin_amdgcn_s_barrier();
    int j = blockIdx.x; asm volatile("" : "+s"(j));
    if (j < N_ATT) {
        bf16x8 kv[12], qn[4];
        AttnGeom g = geom(j);
        kv_fetch(PB, g, tid, kv, qn, wave, lane);
        for (;;) {
            kv_store(lds, tid, kv);
            bf16x8 qf[4];
#pragma unroll
            for (int i = 0; i < 4; ++i) qf[i] = qn[i];
            asm volatile("s_waitcnt lgkmcnt(0)" ::: "memory"); __builtin_amdgcn_s_barrier(); asm volatile("" ::: "memory");
            const int jn = j + G; const bool more = jn < N_ATT;
            AttnGeom gn = g;
            if (more) { gn = geom(jn); kv_fetch(PB, gn, tid, kv, qn, wave, lane); }
            attn_wave(lds, g, qf, wave, lane, AO);
            asm volatile("" ::: "memory"); __builtin_amdgcn_s_barrier(); asm volatile("" ::: "memory");
            if (!more) break;
            g = gn; j = jn;
        }
    }
    if (SUB == 1) touch_lines(ws + WS_W + (size_t)l * W_LAYER + WO_OUT, (size_t)DM * DM * 2, tid);
}
template <int SUB>
__device__ __forceinline__ void mixer_stage(LAS unsigned char* lds, int l, int wave0) { mixer_rg<SUB>(lds, l, wave0); mixer_attn<SUB>(lds, l, wave0); }

#define XB_TMO      128
#define XB_XCNT(j)  (256  + 64 * (j))
#define XB_XSUB(j)  (1280 + 64 * (j))
#define XB_XGEN(j)  (2304 + 64 * (j))
#define XB_TOP      3328
#define XB_TOPGEN   3392
#define XCD_BAR_WORDS 3456
#define XB_SPIN_CAP (1u << 18)

__device__ __forceinline__ unsigned xb_ld(unsigned* p)              { return __hip_atomic_load(p, __ATOMIC_RELAXED, __HIP_MEMORY_SCOPE_AGENT); }
__device__ __forceinline__ unsigned xb_add(unsigned* p, unsigned v) { return __hip_atomic_fetch_add(p, v, __ATOMIC_RELAXED, __HIP_MEMORY_SCOPE_AGENT); }
__device__ __forceinline__ unsigned xb_xcc_id() { return (unsigned)__builtin_amdgcn_s_getreg((3 << 11) | 20) & 0xFu; }
#define XB_SPIN(cond, bar) do { unsigned _sp = 0; while (cond) {   \
    if ((++_sp & 255u) == 0u) { if (xb_ld(&(bar)[XB_TMO])) break; if (_sp > XB_SPIN_CAP) { atomicAdd(&(bar)[XB_TMO], 1u); break; } } } } while (0)

struct XcdBarrier {
    unsigned* bar; unsigned x; bool lead;
    volatile LAS unsigned* st;
};

__device__ __forceinline__ XcdBarrier xcd_barrier_post(unsigned* bar, volatile LAS unsigned* st, bool lead) {
    XcdBarrier b; b.bar = bar; b.x = xb_xcc_id(); b.st = st; b.lead = lead;
    if (lead) (void)xb_add(&bar[XB_XCNT(b.x)], 1u);
    return b;
}
__device__ __forceinline__ void xcd_barrier_complete(unsigned* bar, unsigned x, unsigned& nloc, unsigned& nx) {
    const unsigned G = gridDim.x * gridDim.y * gridDim.z;
    unsigned sum, cnt, mine, sp = 0u;
    for (;;) {
        sum = 0u; cnt = 0u; mine = 0u;
#pragma unroll
        for (unsigned j = 0; j < 16; ++j) { const unsigned c = xb_ld(&bar[XB_XCNT(j)]); sum += c; cnt += (c > 0u) ? 1u : 0u; mine = (j == x) ? c : mine; }
        if (sum == G) break;
        __builtin_amdgcn_s_sleep(1);
        if ((++sp & 255u) == 0u) { if (xb_ld(&bar[XB_TMO])) break; if (sp > XB_SPIN_CAP) { atomicAdd(&bar[XB_TMO], 1u); break; } }
    }
    nloc = mine > 0u ? mine : 1u; nx = cnt > 0u ? cnt : 1u;
}

__device__ __forceinline__ void xcd_barrier(const XcdBarrier& b) {
    asm volatile("s_waitcnt vmcnt(0)" ::: "memory");
    __syncthreads();
    if (b.lead) {
        unsigned* bar = b.bar;
        __builtin_amdgcn_s_waitcnt(0);
        unsigned nloc = b.st[0], nx = b.st[1];
        if (nloc == 0u) { xcd_barrier_complete(bar, b.x, nloc, nx); b.st[0] = nloc; b.st[1] = nx; }
        const unsigned old = xb_add(&bar[XB_XSUB(b.x)], 1u);
        const unsigned gen = old / nloc;
        if (old + 1u == (gen + 1u) * nloc) {
            __builtin_amdgcn_fence(__ATOMIC_RELEASE, "agent");
            asm volatile("s_waitcnt vmcnt(0)" ::: "memory");
            const unsigned og = xb_add(&bar[XB_TOP], 1u);
            const unsigned tg = og / nx;
            if (og + 1u == (tg + 1u) * nx) xb_add(&bar[XB_TOPGEN], 1u);
            else XB_SPIN(xb_ld(&bar[XB_TOPGEN]) == tg, bar);
            __builtin_amdgcn_fence(__ATOMIC_ACQUIRE, "agent");
            xb_add(&bar[XB_XGEN(b.x)], 1u);
            asm volatile("s_waitcnt vmcnt(0)" ::: "memory");
        } else {
            XB_SPIN(xb_ld(&bar[XB_XGEN(b.x)]) == gen, bar);
            __builtin_amdgcn_fence(__ATOMIC_ACQUIRE, "agent");
            asm volatile("s_waitcnt vmcnt(0)" ::: "memory");
        }
    }
    __syncthreads();
}

#define GRID_SYNC_CG() do { asm volatile("s_waitcnt vmcnt(0)" ::: "memory"); grid.sync(); __builtin_amdgcn_fence(__ATOMIC_ACQUIRE, "agent"); asm volatile("s_waitcnt vmcnt(0)" ::: "memory"); } while (0)
#define GRID_SYNC() do { XcdBarrier b_; b_.bar = (unsigned*)(kargs()->ws + WS_BAR); b_.x = xb_xcc_id(); b_.st = (volatile LAS unsigned*)(lds + 131072 + 64); b_.lead = fresh_tid(wave0) == 0; xcd_barrier(b_); } while (0)
__global__ void __launch_bounds__(512, 2) hymba_fwd(Args args) {
    extern __shared__ __attribute__((aligned(16))) unsigned char lds_raw[];
    cg::grid_group grid = cg::this_grid();
    LAS unsigned char* lds = (LAS unsigned char*)lds_raw;
    const int wave0 = __builtin_amdgcn_readfirstlane((int)threadIdx.x >> 6);
    volatile LAS unsigned* xst = (volatile LAS unsigned*)(lds + 131072 + 64);
    { const int t0_ = fresh_tid(wave0); if ((t0_ & 63) == 0) *(LAS int*)(lds + 131072 + 256 + (t0_ >> 6) * 1024) = -1;
      if (t0_ < 2) xst[t0_] = 0u; __syncthreads(); (void)xcd_barrier_post((unsigned*)(kargs()->ws + WS_BAR), xst, t0_ == 0); }
    prologue_stage(lds, wave0);
    if (kargs()->out == nullptr) GRID_SYNC_CG();
    GRID_SYNC();
    for (int l = 0; l < DEPTH; ++l) {
        gemm_stage<0>(lds, l, 0, wave0); GRID_SYNC();
        gemm_stage<1>(lds, l, 0, wave0); GRID_SYNC();
        gemm_stage<2>(lds, l, 0, wave0); GRID_SYNC();
        mixer_stage<0>(lds, l, wave0); GRID_SYNC();
        mixer_stage<1>(lds, l, wave0); GRID_SYNC();
        gemm_stage<3>(lds, l, 0, wave0); GRID_SYNC();
        gemm_stage<0>(lds, l, 1, wave0); GRID_SYNC();
        gemm_stage<1>(lds, l, 1, wave0); GRID_SYNC();
    }
    {
        KArgs ap = kargs(); const int tid = fresh_tid(wave0), lane = tid & 63, wave = __builtin_amdgcn_readfirstlane(tid >> 6);
        const int gw = blockIdx.x * 8 + wave, NGW = gridDim.x * 8;
        float* out = ap->out; const bf16_t* XB = (const bf16_t*)(ap->ws + WS_XB); const float* gfin = IN_F(21); const float* ssqF = (const float*)(ap->ws + WS_SSQ) + (size_t)12 * SSQ_SLOT;
        for (int m = gw; m < MTOK; m += NGW) {
            const float rstd = rsqrtf(ssq_row(ssqF, m) * (1.0f / DM) + EPS);
            const u32x2* xr = (const u32x2*)(XB + (size_t)m * DM) + lane; f32x4* orow = (f32x4*)(out + (size_t)m * DM) + lane; const f32x4* gr = (const f32x4*)gfin + lane;
#pragma unroll
            for (int j = 0; j < 4; ++j) { const u32x2 v = xr[64 * j]; const f32x4 g = gr[64 * j];
                f32x4 o; o[0] = bflo(v.x) * rstd * g[0]; o[1] = bfhi(v.x) * rstd * g[1]; o[2] = bflo(v.y) * rstd * g[2]; o[3] = bfhi(v.y) * rstd * g[3];
                orow[64 * j] = o; }
        }
    }
}

extern "C" void kernel_launch(void* const* d_in, const int* in_sizes, int n_in, void* d_out, int out_size, void* d_ws, size_t ws_size, hipStream_t stream) {
    static int grid = 0;
    if (grid == 0) {
        if (n_in != 22 || out_size != MTOK * DM || ws_size < WS_END) { fprintf(stderr, "kernel_launch: unexpected shapes (n_in %d, out %d, ws %zu)\n", n_in, out_size, ws_size); grid = -1; return; }
        int dev = 0, cus = 0, per_cu = 0;
        (void)hipGetDevice(&dev); (void)hipDeviceGetAttribute(&cus, hipDeviceAttributeMultiprocessorCount, dev);
        if (hipFuncSetAttribute((const void*)hymba_fwd, hipFuncAttributeMaxDynamicSharedMemorySize, LDS_BYTES) != hipSuccess) { fprintf(stderr, "kernel_launch: hipFuncSetAttribute failed\n"); grid = -1; return; }
        if (hipOccupancyMaxActiveBlocksPerMultiprocessor(&per_cu, (const void*)hymba_fwd, 512, LDS_BYTES) != hipSuccess || per_cu < 1) { fprintf(stderr, "kernel_launch: occupancy query gave %d\n", per_cu); per_cu = 1; }
        (void)hipGetLastError();
        grid = cus * per_cu;
    }
    if (grid < 0) return;
    if (hipMemsetAsync((char*)d_ws + WS_BAR, 0, XCD_BAR_WORDS * 4, stream) != hipSuccess) { fprintf(stderr, "kernel_launch: hipMemsetAsync failed\n"); return; }
    Args a{};
    for (int i = 0; i < 22; ++i) a.in[i] = d_in[i];
    a.out = (float*)d_out; a.ws = (unsigned char*)d_ws;
    void* kargs[] = {&a};
    hipError_t e = hipLaunchCooperativeKernel((const void*)hymba_fwd, dim3(grid), dim3(512), kargs, LDS_BYTES, stream);
    if (e != hipSuccess) fprintf(stderr, "kernel_launch: cooperative launch failed: %s (grid %d)\n", hipGetErrorString(e), grid);
}
```

```cpp
#include <hip/hip_runtime.h>
#include <hip/hip_cooperative_groups.h>
#include <cstdio>
#include <cstdint>
#include <cmath>
namespace cg = cooperative_groups;
namespace pg8 {
#define PG8_LAS __attribute__((address_space(3)))
typedef unsigned short bf16_t;
typedef short bf16x8 __attribute__((ext_vector_type(8)));
typedef float f32x4 __attribute__((ext_vector_type(4)));
typedef unsigned u32x4 __attribute__((ext_vector_type(4)));
constexpr int BM = 256, BK = 64, HALF = 128, HTB = HALF * BK * 2  , STAGE_BYTES = 8 * HTB, NXCD = 8, WGM = 8;

__host__ __device__ __forceinline__ int lds_byte(int r, int c) { const int st = (r >> 4) * 2 + (c >> 5), rr = r & 15, cc = c & 31, ob = rr * 64 + cc * 2; return st * 1024 + (ob ^ (((ob >> 9) & 1) << 5)); }
__host__ __device__ __forceinline__ void stage_rc(int b, int& R, int& C) { const int st = b / 1024, sb = b % 1024, swz = sb ^ (((sb >> 9) & 1) << 5); R = (st >> 1) * 16 + swz / 64; C = (st & 1) * 32 + (swz % 64) / 2; }
__host__ __device__ __forceinline__ int perm32(int rho) { const int n = rho >> 4, i = rho & 15; return 8 * (i >> 2) + 4 * n + (i & 3); }

struct Unit { int pm, pn; };
struct Gemm { const bf16_t* A; const bf16_t* Bt; int M, N, K; };

struct StaticOrder {
    int nM, nN, nwg, G, c;
    __host__ __device__ void init(int M, int N, int G_, int c_) { nM = M / BM; nN = N / BM; nwg = nM * nN; G = G_; c = c_; }
    __host__ __device__ bool next(int i, Unit& u) const {
        const long L = (long)i * G + c; if (L >= nwg) return false;
        int wgid = (int)L; { const int q = nwg / NXCD, r = nwg % NXCD, xcd = wgid % NXCD, off = wgid / NXCD; wgid = (xcd < r ? xcd * (q + 1) : r * (q + 1) + (xcd - r) * q) + off; }
        const int nig = WGM * nN, gid = wgid / nig, fm = gid * WGM, gsz = (nM - fm) < WGM ? (nM - fm) : WGM;
        u.pm = fm + ((wgid % nig) % gsz); u.pn = (wgid % nig) / gsz; return true;
    }
    __device__ __forceinline__ void a_ready(const Unit&) const {}
    __device__ __forceinline__ void done(const Unit&) const {}
};
}

constexpr int DM = 1024, BATCH = 2, SEQ = 16384, MTOK = BATCH * SEQ, DEPTH = 4, FF = 2816, NGU = 2 * FF, NIN = 2560, INC = 2432;
constexpr int PC_QA = 0, PC_KA = 256, PC_VA = 384, PC_QB = 512, PC_KB = 896, PC_VB = 1280, PC_XC = 1792, PC_GC = 2176;
__device__ __forceinline__ size_t p_pos(bool perm, int tokabs) { const int s = tokabs & (SEQ - 1); return perm ? (size_t)((tokabs - s) + (s & 15) * (SEQ / 16) + (s >> 4)) : (size_t)tokabs; }
__device__ __forceinline__ size_t p_off(int g, bool perm, int tokabs) { return ((size_t)g * MTOK + p_pos(perm, tokabs)) * 64; }
constexpr float EPS = 1e-6f;
constexpr float QSCALE = 0.125f * 1.4426950408889634f;

#define LAS __attribute__((address_space(3)))
typedef unsigned short bf16_t;
typedef short bf16x8 __attribute__((ext_vector_type(8)));
typedef short s16x4 __attribute__((ext_vector_type(4)));
typedef float f32x4 __attribute__((ext_vector_type(4)));
typedef float f32x2 __attribute__((ext_vector_type(2)));
typedef float f32x16 __attribute__((ext_vector_type(16)));
typedef unsigned u32x4 __attribute__((ext_vector_type(4)));
typedef unsigned u32x2 __attribute__((ext_vector_type(2)));
typedef __bf16 nbf16x2 __attribute__((ext_vector_type(2)));

__device__ __forceinline__ unsigned pk2(float lo, float hi) { f32x2 v = {lo, hi}; nbf16x2 r = __builtin_convertvector(v, nbf16x2); return __builtin_bit_cast(unsigned, r); }
__device__ __forceinline__ float bf2f(unsigned short h) { return __builtin_bit_cast(float, (unsigned)h << 16); }
__device__ __forceinline__ float bflo(unsigned w) { return __builtin_bit_cast(float, w << 16); }
__device__ __forceinline__ float bfhi(unsigned w) { return __builtin_bit_cast(float, w & 0xffff0000u); }
__device__ __forceinline__ float fast_rcp(float x) { return __builtin_amdgcn_rcpf(x); }
__device__ __forceinline__ float fast_exp2(float x) { return __builtin_amdgcn_exp2f(x); }
__device__ __forceinline__ float sigmoidf_(float x) { return fast_rcp(1.0f + __expf(-x)); }

__device__ __forceinline__ float ssq_row(const float* part, int row) {
    const f32x4* p = (const f32x4*)(part + (size_t)row * 16);
    const f32x4 a = p[0], b = p[1], c = p[2], d = p[3];
    return (((a[0] + a[1]) + (a[2] + a[3])) + ((b[0] + b[1]) + (b[2] + b[3]))) + (((c[0] + c[1]) + (c[2] + c[3])) + ((d[0] + d[1]) + (d[2] + d[3])));
}

namespace pg8 {
__device__ __forceinline__ void rstd8(const float* ssq, int row0, int fq, float (&rstd)[8]) {
    f32x4 q[8];
#pragma unroll
    for (int i = 0; i < 8; ++i) q[i] = *(const f32x4*)(ssq + (size_t)(row0 + (i >> 2) * HALF + (i & 3) * 16) * 16 + 4 * fq);
#pragma unroll
    for (int i = 0; i < 8; ++i) { float s = (q[i][0] + q[i][1]) + (q[i][2] + q[i][3]); s += __shfl_xor(s, 16); s += __shfl_xor(s, 32); rstd[i] = rsqrtf(s * (1.0f / DM) + EPS); }
}
__device__ __forceinline__ void rstd8_cached(const float* ssq, int row0, int fr, int fq, float (&rstd)[8], PG8_LAS unsigned char* tab, int tagv) {
    PG8_LAS int* tag = (PG8_LAS int*)tab; PG8_LAS float* t = (PG8_LAS float*)(tab + 16);
    if (__builtin_amdgcn_readfirstlane(*tag) == tagv) {
#pragma unroll
        for (int i = 0; i < 8; ++i) rstd[i] = t[(i >> 2) * 64 + (i & 3) * 16 + fr];
    } else {
        rstd8(ssq, row0, fq, rstd);
        if (fq == 0) {
#pragma unroll
            for (int i = 0; i < 8; ++i) t[(i >> 2) * 64 + (i & 3) * 16 + fr] = rstd[i];
        }
        *tag = tagv;
    }
}
struct EpiGateUp {
    static constexpr bool PERM = true, AFTER_DRAIN = false;
    const float* ssq; bf16_t* act; PG8_LAS unsigned char* tabs; int tag0;
    __device__ __forceinline__ void operator()(const f32x4 (&acc)[2][2][4][2], const Unit& u, int wr, int wc, int fr, int fq) const {
        float rstd[8]; rstd8_cached(ssq, u.pm * BM + wr * 64 + fr, fr, fq, rstd, tabs + (wr * 4 + wc) * 1024, tag0 + u.pm);
#pragma unroll
        for (int ai = 0; ai < 2; ++ai)
#pragma unroll
            for (int m = 0; m < 4; ++m) {
                const int row = u.pm * BM + ai * HALF + wr * 64 + m * 16 + fr;
                const float rs = rstd[ai * 4 + m];
                float a[8];
#pragma unroll
                for (int n = 0; n < 2; ++n) {
                    const f32x4 g = acc[ai][0][m][n] * rs, up = acc[ai][1][m][n] * rs;
#pragma unroll
                    for (int e = 0; e < 4; ++e) a[4 * n + e] = g[e] * fast_rcp(1.0f + __expf(-g[e])) * up[e];
                }
                u32x4 w; w.x = pk2(a[0], a[1]); w.y = pk2(a[2], a[3]); w.z = pk2(a[4], a[5]); w.w = pk2(a[6], a[7]);
                *(u32x4*)(act + (size_t)row * FF + u.pn * 128 + wc * 32 + fq * 8) = w;
            }
    }
};
struct EpiResidual {
    static constexpr bool PERM = true, AFTER_DRAIN = false;
    bf16_t* xb; float* ssq_out; float scale;
    __device__ __forceinline__ void operator()(const f32x4 (&acc)[2][2][4][2], const Unit& u, int wr, int wc, int fr, int fq) const {
        bf16_t* p0 = xb + (size_t)(u.pm * BM + wr * 64 + fr) * DM + u.pn * BM + wc * 32 + fq * 8;
        u32x4 b[8][2];
#pragma unroll
        for (int i = 0; i < 2; ++i)
#pragma unroll
            for (int bj = 0; bj < 2; ++bj) b[i][bj] = *(const u32x4*)(p0 + (size_t)((i >> 2) * HALF + (i & 3) * 16) * DM + bj * HALF);
#pragma unroll
        for (int i = 0; i < 8; ++i) {
            if (i + 2 < 8) {
#pragma unroll
                for (int bj = 0; bj < 2; ++bj) b[i + 2][bj] = *(const u32x4*)(p0 + (size_t)(((i + 2) >> 2) * HALF + ((i + 2) & 3) * 16) * DM + bj * HALF);
            }
            const int ai = i >> 2, m = i & 3;
            const int row = u.pm * BM + ai * HALF + wr * 64 + m * 16 + fr;
            float sq = 0.f;
#pragma unroll
            for (int bj = 0; bj < 2; ++bj) {
                const u32x4 bb = b[i][bj];
                const f32x4 a0 = acc[ai][bj][m][0] * scale, a1 = acc[ai][bj][m][1] * scale;
                const float o0 = bflo(bb.x) + a0[0], o1 = bfhi(bb.x) + a0[1], o2 = bflo(bb.y) + a0[2], o3 = bfhi(bb.y) + a0[3];
                const float o4 = bflo(bb.z) + a1[0], o5 = bfhi(bb.z) + a1[1], o6 = bflo(bb.w) + a1[2], o7 = bfhi(bb.w) + a1[3];
                sq += ((o0 * o0 + o1 * o1) + (o2 * o2 + o3 * o3)) + ((o4 * o4 + o5 * o5) + (o6 * o6 + o7 * o7));
                u32x4 w; w.x = pk2(o0, o1); w.y = pk2(o2, o3); w.z = pk2(o4, o5); w.w = pk2(o6, o7);
                *(u32x4*)(p0 + (size_t)(ai * HALF + m * 16) * DM + bj * HALF) = w;
            }
            sq += __shfl_xor(sq, 16); sq += __shfl_xor(sq, 32);
            if (fq == 0) ssq_out[(size_t)row * 16 + u.pn * 4 + wc] = sq;
            asm volatile("" ::: "memory");
        }
    }
};
struct EpiProj {
    static constexpr bool PERM = true, AFTER_DRAIN = false;
    const float* ssq; const float* cosT; const float* sinT; bf16_t* P; PG8_LAS unsigned char* tabs; int tag0;
    __device__ __forceinline__ void operator()(const f32x4 (&acc)[2][2][4][2], const Unit& u, int wr, int wc, int fr, int fq) const {
        const int row0 = u.pm * BM + wr * 64 + fr;
        float rstd[8]; rstd8_cached(ssq, row0, fr, fq, rstd, tabs + (wr * 4 + wc) * 1024, tag0 + u.pm);
        const int d1 = 16 * (wc & 1) + 4 * fq;
        const bool rope0 = (u.pn * BM + wc * 32 < PC_VA) || (u.pn * BM + wc * 32 >= PC_QB && u.pn * BM + wc * 32 < PC_VB);
        f32x4 c4[8], s4[8];
#pragma unroll
        for (int i = 0; i < 2; ++i) { const size_t to = (size_t)(row0 + (i >> 2) * HALF + (i & 3) * 16) * 32 + d1; c4[i] = *(const f32x4*)(cosT + to); s4[i] = *(const f32x4*)(sinT + to); }
#pragma unroll
        for (int i = 0; i < 8; ++i) {
            if (i + 2 < 8) { const size_t to = (size_t)(row0 + ((i + 2) >> 2) * HALF + ((i + 2) & 3) * 16) * 32 + d1; c4[i + 2] = *(const f32x4*)(cosT + to); s4[i + 2] = *(const f32x4*)(sinT + to); }
            const int ai = i >> 2, m = i & 3;
            const int row = row0 + ai * HALF + m * 16;
            const float rs = rstd[i];
#pragma unroll
            for (int bj = 0; bj < 2; ++bj) {
                const int cb = u.pn * BM + bj * HALF + wc * 32;
                f32x4 v0 = acc[ai][bj][m][0] * rs, v1 = acc[ai][bj][m][1] * rs;
                const bool rope = (cb < PC_VA) || (cb >= PC_QB && cb < PC_VB);
                const bool isq = (cb < PC_KA) || (cb >= PC_QB && cb < PC_KB);
                if (rope) {
                    const f32x4 o0 = v0 * c4[i] - v1 * s4[i], o1 = v1 * c4[i] + v0 * s4[i];
                    const float qs = isq ? QSCALE : 1.0f;
                    v0 = o0 * qs; v1 = o1 * qs;
                }
                u32x4 w; w.x = pk2(v0[0], v0[1]); w.y = pk2(v0[2], v0[3]); w.z = pk2(v1[0], v1[1]); w.w = pk2(v1[2], v1[3]);
                *(u32x4*)(P + p_off(cb >> 6, cb >= PC_QB && cb < 1664, row) + (cb & 63) + fq * 8) = w;
            }
            asm volatile("" ::: "memory");
        }
        (void)rope0;
    }
};
}
namespace pg8 {
template <class Epi, class Sched, bool ALIGN_EPI = false, bool SP2 = false>
__device__ __forceinline__ void gemm_phase(PG8_LAS unsigned char* lds, const Gemm g, const Sched& S, const Epi& E, int tid_in) {
    int tid_ = tid_in; asm volatile("" : "+v"(tid_));
    const int tid = tid_, wid = __builtin_amdgcn_readfirstlane(tid >> 6), lane = tid & 63, wr = wid >> 2, wc = wid & 3, fr = lane & 15, fq = lane >> 4;
    const int K = g.K, nt = K / BK;
    unsigned voffA[2], voffB[2];
#pragma unroll
    for (int i = 0; i < 2; ++i) { int R, C; stage_rc(tid * 16 + i * 8192, R, C); const int Rb = Epi::PERM ? ((R & ~31) + perm32(R & 31)) : R;
        voffA[i] = (unsigned)(R * K + C) * 2u; voffB[i] = (unsigned)(Rb * K + C) * 2u; }
    const size_t kstep = (size_t)(BK * 2);
    const size_t hstep = (size_t)HALF * K * 2;
    const size_t tstep = 2 * hstep;
    const unsigned ldsw = (unsigned)wid * 1024u;
    const int aoff = lds_byte(wr * 64 + fr, fq * 8), boff = lds_byte(wc * 32 + fr, fq * 8);
#define PG8_SA(b, h) (((b) * 2 + (h)) * HTB)
#define PG8_SB(b, h) ((4 + (b) * 2 + (h)) * HTB)
#define PG8_STAGE(bufoff, gbase, voff) do { _Pragma("unroll") for (int _i = 0; _i < 2; ++_i) \
        __builtin_amdgcn_global_load_lds((const unsigned*)((const char*)(gbase) + (voff)[_i]), (PG8_LAS unsigned*)(lds + (bufoff) + ldsw + _i * 8192), 16, 0, 0); } while (0)
#define PG8_LDA(dst, b, h) do { _Pragma("unroll") for (int m = 0; m < 4; ++m) _Pragma("unroll") for (int k = 0; k < 2; ++k) dst[m][k] = *(const PG8_LAS bf16x8*)(lds + PG8_SA(b, h) + aoff + m * 2048 + k * 1024); } while (0)
#define PG8_LDB(dst, b, h) do { _Pragma("unroll") for (int n = 0; n < 2; ++n) _Pragma("unroll") for (int k = 0; k < 2; ++k) dst[n][k] = *(const PG8_LAS bf16x8*)(lds + PG8_SB(b, h) + boff + n * 2048 + k * 1024); } while (0)
#define PG8_MMA(ai, bj, At, Bt) do { __builtin_amdgcn_s_setprio(1); _Pragma("unroll") for (int m = 0; m < 4; ++m) _Pragma("unroll") for (int n = 0; n < 2; ++n) _Pragma("unroll") for (int k = 0; k < 2; ++k) \
        acc[ai][bj][m][n] = __builtin_amdgcn_mfma_f32_16x16x32_bf16(Bt[n][k], At[m][k], acc[ai][bj][m][n], 0, 0, 0); __builtin_amdgcn_s_setprio(0); } while (0)
#define PG8_WAIT_V(n) asm volatile("s_waitcnt vmcnt(" #n ")" ::: "memory")
#define PG8_WAIT_L(n) asm volatile("s_waitcnt lgkmcnt(" #n ")" ::: "memory")
#define PG8_BAR __builtin_amdgcn_s_barrier()
#define PG8_SCHED __builtin_amdgcn_sched_barrier(0)
    Unit cur, nxt; int ui = 0;
    if (!S.next(0, cur)) return;
    f32x4 acc[2][2][4][2];
#pragma unroll
    for (int a = 0; a < 2; ++a)
#pragma unroll
        for (int b = 0; b < 2; ++b)
#pragma unroll
            for (int m = 0; m < 4; ++m)
#pragma unroll
                for (int n = 0; n < 2; ++n) acc[a][b][m][n] = (f32x4){0.f, 0.f, 0.f, 0.f};
    bf16x8 At[4][2], B0[2][2], B1[2][2];
    const char* cA = (const char*)g.A + (size_t)cur.pm * tstep; const char* cB = (const char*)g.Bt + (size_t)cur.pn * tstep;
    S.a_ready(cur);
    if constexpr (SP2) {
        PG8_STAGE(PG8_SB(0, 0), cB, voffB); PG8_STAGE(PG8_SB(0, 1), cB + hstep, voffB); PG8_STAGE(PG8_SA(0, 0), cA, voffA); PG8_STAGE(PG8_SA(0, 1), cA + hstep, voffA);
        if (wr == 1) PG8_BAR;
        PG8_WAIT_V(2); PG8_BAR;
        PG8_STAGE(PG8_SB(1, 0), cB + kstep, voffB); PG8_STAGE(PG8_SA(1, 0), cA + kstep, voffA); PG8_STAGE(PG8_SB(1, 1), cB + hstep + kstep, voffB);
        PG8_WAIT_V(6); PG8_BAR;
    } else {
        PG8_STAGE(PG8_SB(0, 0), cB, voffB); PG8_STAGE(PG8_SA(0, 0), cA, voffA); PG8_STAGE(PG8_SB(0, 1), cB + hstep, voffB); PG8_STAGE(PG8_SA(0, 1), cA + hstep, voffA);
        if (wr == 1) PG8_BAR;
        PG8_WAIT_V(4); PG8_BAR;
        PG8_STAGE(PG8_SB(1, 0), cB + kstep, voffB); PG8_STAGE(PG8_SA(1, 0), cA + kstep, voffA); PG8_STAGE(PG8_SB(1, 1), cB + hstep + kstep, voffB);
        PG8_WAIT_V(6); PG8_BAR;
    }
    for (;;) {
        const bool has_next = S.next(ui + 1, nxt);
        const char* nA = has_next ? (const char*)g.A + (size_t)nxt.pm * tstep : cA; const char* nB = has_next ? (const char*)g.Bt + (size_t)nxt.pn * tstep : cB;
        for (int t = 0; t < nt; t += 2) {
            const bool last = (t == nt - 2);
            const char* a1 = cA + (size_t)(t + 1) * kstep;
            const char* a2 = last ? nA : cA + (size_t)(t + 2) * kstep; const char* b2 = last ? nB : cB + (size_t)(t + 2) * kstep;
            const char* a3 = a2 + kstep; const char* b3 = b2 + kstep;
            if (last && has_next) S.a_ready(nxt);
            if constexpr (SP2) {
            PG8_LDB(B0, 0, 0); PG8_LDB(B1, 0, 1); PG8_SCHED; PG8_LDA(At, 0, 0); PG8_STAGE(PG8_SA(1, 1), a1 + hstep, voffA);
            PG8_WAIT_V(8); PG8_WAIT_L(0); PG8_BAR; PG8_MMA(0, 0, At, B0); PG8_MMA(0, 1, At, B1); PG8_BAR; PG8_SCHED;
            PG8_LDA(At, 0, 1); PG8_STAGE(PG8_SB(0, 0), b2, voffB); PG8_STAGE(PG8_SB(0, 1), b2 + hstep, voffB); PG8_STAGE(PG8_SA(0, 0), a2, voffA);
            PG8_WAIT_V(8); PG8_WAIT_L(0); PG8_BAR; PG8_MMA(1, 0, At, B0); PG8_MMA(1, 1, At, B1); PG8_BAR; PG8_SCHED;
            PG8_LDB(B0, 1, 0); PG8_LDB(B1, 1, 1); PG8_SCHED; PG8_LDA(At, 1, 0); PG8_STAGE(PG8_SA(0, 1), a2 + hstep, voffA);
            PG8_WAIT_V(8); PG8_WAIT_L(0); PG8_BAR; PG8_MMA(0, 0, At, B0); PG8_MMA(0, 1, At, B1); PG8_BAR; PG8_SCHED;
            PG8_LDA(At, 1, 1); PG8_STAGE(PG8_SB(1, 0), b3, voffB); PG8_STAGE(PG8_SB(1, 1), b3 + hstep, voffB); PG8_STAGE(PG8_SA(1, 0), a3, voffA);
            PG8_WAIT_V(8); PG8_WAIT_L(0); PG8_BAR; PG8_MMA(1, 0, At, B0); PG8_MMA(1, 1, At, B1); PG8_BAR; PG8_SCHED;
            } else {
            PG8_LDB(B0, 0, 0); PG8_SCHED; PG8_LDA(At, 0, 0); PG8_STAGE(PG8_SA(1, 1), a1 + hstep, voffA);
            PG8_WAIT_L(8); PG8_BAR; PG8_WAIT_L(0); PG8_MMA(0, 0, At, B0); PG8_BAR; PG8_SCHED;
            PG8_LDB(B1, 0, 1); PG8_STAGE(PG8_SB(0, 0), b2, voffB);
            PG8_BAR; PG8_WAIT_L(0); PG8_MMA(0, 1, At, B1); PG8_BAR;
            PG8_LDA(At, 0, 1); PG8_STAGE(PG8_SA(0, 0), a2, voffA);
            PG8_BAR; PG8_WAIT_L(0); PG8_MMA(1, 0, At, B0); PG8_BAR; PG8_SCHED;
            PG8_STAGE(PG8_SB(0, 1), b2 + hstep, voffB);
            PG8_WAIT_V(6); PG8_BAR; PG8_MMA(1, 1, At, B1); PG8_BAR;
            PG8_LDB(B0, 1, 0); PG8_SCHED; PG8_LDA(At, 1, 0); PG8_STAGE(PG8_SA(0, 1), a2 + hstep, voffA);
            PG8_WAIT_L(8); PG8_BAR; PG8_WAIT_L(0); PG8_MMA(0, 0, At, B0); PG8_BAR; PG8_SCHED;
            PG8_LDB(B1, 1, 1); PG8_STAGE(PG8_SB(1, 0), b3, voffB);
            PG8_BAR; PG8_WAIT_L(0); PG8_MMA(0, 1, At, B1); PG8_BAR;
            PG8_LDA(At, 1, 1); PG8_STAGE(PG8_SA(1, 0), a3, voffA);
            PG8_BAR; PG8_WAIT_L(0); PG8_MMA(1, 0, At, B0); PG8_BAR; PG8_SCHED;
            PG8_STAGE(PG8_SB(1, 1), b3 + hstep, voffB);
            PG8_WAIT_V(6); PG8_BAR; PG8_MMA(1, 1, At, B1); PG8_BAR;
            }
        }
        if constexpr (ALIGN_EPI) { if (wr == 0) PG8_BAR; }
        if constexpr (!Epi::AFTER_DRAIN) { E(acc, cur, wr, wc, fr, fq); S.done(cur); }
        if (!has_next) break;
#pragma unroll
        for (int a = 0; a < 2; ++a)
#pragma unroll
            for (int b = 0; b < 2; ++b)
#pragma unroll
                for (int m = 0; m < 4; ++m)
#pragma unroll
                    for (int n = 0; n < 2; ++n) acc[a][b][m][n] = (f32x4){0.f, 0.f, 0.f, 0.f};
        cur = nxt; cA = nA; cB = nB; ++ui;
        if constexpr (ALIGN_EPI) { if (wr == 1) PG8_BAR; }
    }
    PG8_WAIT_V(0);
    if constexpr (!ALIGN_EPI) { if (wr == 0) PG8_BAR; }
    PG8_BAR;
    if constexpr (Epi::AFTER_DRAIN) { E.fused(acc, cur, wr, wc, fr, fq, lds, wid, lane); S.done(cur); }
#undef PG8_SA
#undef PG8_SB
#undef PG8_STAGE
#undef PG8_LDA
#undef PG8_LDB
#undef PG8_MMA
#undef PG8_WAIT_V
#undef PG8_WAIT_L
#undef PG8_BAR
#undef PG8_SCHED
}
}

constexpr size_t MiB = 1u << 20;
constexpr size_t WS_W = 0, W_LAYER = 40 * MiB;
constexpr size_t WO_GU1 = 0, WO_D1 = 11 * MiB, WO_IN = WO_D1 + 11 * MiB / 2, WO_OUT = WO_IN + 5 * MiB, WO_GU2 = WO_OUT + 2 * MiB, WO_D2 = WO_GU2 + 11 * MiB;
static_assert(WO_D2 + 11 * MiB / 2 == W_LAYER, "weight map");
constexpr size_t WS_XB = 160 * MiB;
constexpr size_t WS_ACT = 224 * MiB;
constexpr size_t WS_MIX = 400 * MiB;
constexpr size_t WS_ROPE = 464 * MiB;
constexpr size_t WS_SSQ = 476 * MiB;
constexpr size_t SSQ_SLOT = (size_t)MTOK * 16;
constexpr size_t WS_RGW = 474 * MiB;
constexpr size_t WS_AGG = 475 * MiB;
constexpr size_t WS_TS = 502 * MiB;
constexpr size_t WS_BAR = 504 * MiB;
constexpr size_t WS_END = 505 * MiB;
constexpr size_t PO_BYTES = (size_t)MTOK * 384 * 2;
constexpr size_t OB_PO4 = 0, OB_PO16 = PO_BYTES, OB_LSE4 = 2 * PO_BYTES, OB_LSE16 = OB_LSE4 + MiB;
static_assert(OB_LSE16 + MiB <= (size_t)MTOK * DM * 4, "partials fit the output buffer");

constexpr int LDS_BYTES = 147456;
constexpr int VROW = 144;

struct Args { const void* in[22]; float* out; unsigned char* ws; };
__device__ const float INV_TAB[32] = {1.000000000e+00f, 7.498942018e-01f, 5.623413324e-01f, 4.216965139e-01f, 3.162277639e-01f, 2.371373773e-01f, 1.778279394e-01f, 1.333521456e-01f, 1.000000015e-01f, 7.498942316e-02f, 5.623413250e-02f, 4.216964915e-02f, 3.162277490e-02f, 2.371373773e-02f, 1.778279431e-02f, 1.333521400e-02f, 9.999999776e-03f, 7.498942316e-03f, 5.623413250e-03f, 4.216964822e-03f, 3.162277630e-03f, 2.371373819e-03f, 1.778279431e-03f, 1.333521446e-03f, 1.000000047e-03f, 7.498941850e-04f, 5.623413017e-04f, 4.216965172e-04f, 3.162277571e-04f, 2.371373703e-04f, 1.778279402e-04f, 1.333521504e-04f};

#define MFMA32(a, b, c) __builtin_amdgcn_mfma_f32_32x32x16_bf16((a), (b), (c), 0, 0, 0)
__device__ __forceinline__ int crow(int reg, int h) { return (reg & 3) + 8 * (reg >> 2) + 4 * h; }

struct AttnOut { bf16_t* mix; bf16_t* po; float* lse; const bf16_t* po4; const bf16_t* po16; const float* lse4; const float* lse16; float sink; };

__device__ __forceinline__ void store_row16(bf16_t* rowp  , const u32x2 (&wv)[4], int kh) {
#pragma unroll
    for (int gp = 0; gp < 2; ++gp) {
        const u32x2 keep = kh ? wv[2 * gp + 1] : wv[2 * gp], send = kh ? wv[2 * gp] : wv[2 * gp + 1];
        u32x2 recv; recv.x = (unsigned)__shfl_xor((int)send.x, 32); recv.y = (unsigned)__shfl_xor((int)send.y, 32);
        u32x4 w; if (kh) { w.x = recv.x; w.y = recv.y; w.z = keep.x; w.w = keep.y; } else { w.x = keep.x; w.y = keep.y; w.z = recv.x; w.w = recv.y; }
        *(u32x4*)(rowp + 8 * (2 * gp + kh)) = w;
    }
}
template <int MODE>
__device__ __forceinline__ void attn_finish(const f32x16& O0, const f32x16& O1, float m2, float lsum, int tok, int ocol, int hidx, int kh, const AttnOut& AO) {
    const float l = lsum + __shfl_xor(lsum, 32);
    const float lse = (m2 + __log2f(l)) * 0.6931471805599453f;
    const float rl = fast_rcp(l);
    if (MODE == 0) {
        const float gate = fast_rcp(1.0f + __expf(AO.sink - lse)) * rl;
        bf16_t* op = AO.mix + (size_t)tok * DM + ocol;
        u32x2 w0[4], w1[4];
#pragma unroll
        for (int g = 0; g < 4; ++g) {
            w0[g].x = pk2(O0[4 * g] * gate, O0[4 * g + 1] * gate); w0[g].y = pk2(O0[4 * g + 2] * gate, O0[4 * g + 3] * gate);
            w1[g].x = pk2(O1[4 * g] * gate, O1[4 * g + 1] * gate); w1[g].y = pk2(O1[4 * g + 2] * gate, O1[4 * g + 3] * gate);
        }
        store_row16(op, w0, kh); store_row16(op + 32, w1, kh);
    } else if (MODE == 1) {
        bf16_t* op = AO.po + (size_t)tok * 384 + hidx * 64;
        u32x2 w0[4], w1[4];
#pragma unroll
        for (int g = 0; g < 4; ++g) {
            w0[g].x = pk2(O0[4 * g] * rl, O0[4 * g + 1] * rl); w0[g].y = pk2(O0[4 * g + 2] * rl, O0[4 * g + 3] * rl);
            w1[g].x = pk2(O1[4 * g] * rl, O1[4 * g + 1] * rl); w1[g].y = pk2(O1[4 * g + 2] * rl, O1[4 * g + 3] * rl);
        }
        store_row16(op, w0, kh); store_row16(op + 32, w1, kh);
        if (kh == 0) AO.lse[(size_t)tok * 6 + hidx] = lse;
    } else {
        const float l4 = AO.lse4[(size_t)tok * 6 + hidx], l16 = AO.lse16[(size_t)tok * 6 + hidx];
        const float mxl = fmaxf(lse, fmaxf(l4, l16));
        float w1 = __expf(lse - mxl), w4 = __expf(l4 - mxl), w16 = __expf(l16 - mxl);
        const float rs = fast_rcp(w1 + w4 + w16);
        w1 *= rs * rl; w4 *= rs; w16 *= rs;
        const bf16_t* p4 = AO.po4 + (size_t)tok * 384 + hidx * 64 + 4 * kh;
        const bf16_t* p16 = AO.po16 + (size_t)tok * 384 + hidx * 64 + 4 * kh;
        bf16_t* op = AO.mix + (size_t)tok * DM + ocol;
        u32x2 wq[2][4];
#pragma unroll
        for (int g = 0; g < 4; ++g) {
#pragma unroll
            for (int mt = 0; mt < 2; ++mt) {
                const u32x2 a = *(const u32x2*)(p4 + 32 * mt + 8 * g), b = *(const u32x2*)(p16 + 32 * mt + 8 * g);
                float o[4];
#pragma unroll
                for (int e = 0; e < 4; ++e) o[e] = (mt ? O1[4 * g + e] : O0[4 * g + e]) * w1;
                o[0] += bflo(a.x) * w4 + bflo(b.x) * w16; o[1] += bfhi(a.x) * w4 + bfhi(b.x) * w16;
                o[2] += bflo(a.y) * w4 + bflo(b.y) * w16; o[3] += bfhi(a.y) * w4 + bfhi(b.y) * w16;
                wq[mt][g].x = pk2(o[0], o[1]); wq[mt][g].y = pk2(o[2], o[3]);
            }
        }
        store_row16(op, wq[0], kh); store_row16(op + 32, wq[1], kh);
    }
}

struct AttnGeom { int tokb, dil, u0, qcol, kcol, vcol, ocol, hidx, maxd, mode; bool perm; float sink; bf16_t* po; float* lse; };
constexpr int KV_ROWS = 384, VIMG_OFF = KV_ROWS * VROW;

__device__ __forceinline__ void kv_fetch(const bf16_t* __restrict__ P, const AttnGeom& G, int tid, bf16x8 (&kv)[12], bf16x8 (&qn)[4], int wave, int lane) {
    const int piece = tid & 7, rb = tid >> 3;
#pragma unroll
    for (int i = 0; i < 12; ++i) {
        const int row = rb + 64 * (i % 6), u = G.u0 - 128 + row;
        if (u >= 0) kv[i] = *(const bf16x8*)(P + p_off((i < 6 ? G.kcol : G.vcol) >> 6, G.perm, G.tokb + G.dil * u) + 8 * piece);
    }
    const bf16_t* qp = P + p_off(G.qcol >> 6, G.perm, G.tokb + G.dil * (G.u0 + 32 * wave + (lane & 31))) + 8 * (lane >> 5);
#pragma unroll
    for (int ks = 0; ks < 4; ++ks) qn[ks] = *(const bf16x8*)(qp + 16 * ks);
}
__device__ __forceinline__ void kv_store(LAS unsigned char* lds, int tid, const bf16x8 (&kv)[12]) {
    const int piece = tid & 7, rb = tid >> 3;
#pragma unroll
    for (int i = 0; i < 12; ++i) *(LAS bf16x8*)(lds + (i < 6 ? 0 : VIMG_OFF) + (rb + 64 * (i % 6)) * VROW + 16 * piece) = kv[i];
}

__device__ __forceinline__ void attn_wave(LAS unsigned char* lds, const AttnGeom& G, const bf16x8 (&qf)[4], int wave, int lane, const AttnOut& AO0) {
    const int r = lane & 31, kh = lane >> 5;
    const int u0w = G.u0 + 32 * wave;
    f32x16 O0, O1;
#pragma unroll
    for (int j = 0; j < 16; ++j) { O0[j] = 0.f; O1[j] = 0.f; }
    float m2 = -INFINITY, lsum = 0.f;
    const int trlane = ((4 * kh + ((lane & 15) >> 2)) * VROW + 32 * ((lane >> 4) & 1) + 8 * (lane & 3));
    for (int kt = (u0w >= 128 ? 0 : (128 - u0w) >> 5); kt < 5; ++kt) {
        const int ks0 = u0w - 128 + 32 * kt, lrow0 = 32 * wave + 32 * kt;
        bf16x8 kf[4];
        { const LAS unsigned char* kp = lds + (lrow0 + r) * VROW + 16 * kh;
#pragma unroll
          for (int ks = 0; ks < 4; ++ks) kf[ks] = *(const LAS bf16x8*)(kp + 32 * ks); }
        f32x16 S;
#pragma unroll
        for (int j = 0; j < 16; ++j) S[j] = 0.f;
#pragma unroll
        for (int ks = 0; ks < 4; ++ks) S = MFMA32(kf[ks], qf[ks], S);
        if (kt == 0 || kt == 4) {
            const int uq = u0w + r;
#pragma unroll
            for (int j = 0; j < 16; ++j) { const int diff = uq - (ks0 + crow(j, kh)); if (diff < 0 || diff > G.maxd) S[j] = -INFINITY; }
        }
        float mx = S[0];
#pragma unroll
        for (int j = 1; j < 16; ++j) mx = fmaxf(mx, S[j]);
        mx = fmaxf(mx, __shfl_xor(mx, 32));
        const float mnew = fmaxf(m2, mx);
        const float msafe = (mnew == -INFINITY) ? 0.f : mnew;
        const float alpha = fast_exp2(m2 - msafe);
        m2 = mnew;
        float ps = 0.f;
#pragma unroll
        for (int j = 0; j < 16; ++j) { S[j] = fast_exp2(S[j] - msafe); ps += S[j]; }
        lsum = lsum * alpha + ps;
#pragma unroll
        for (int j = 0; j < 16; ++j) { O0[j] *= alpha; O1[j] *= alpha; }
        bf16x8 pf[2];
#pragma unroll
        for (int s = 0; s < 2; ++s) { u32x4 w; w.x = pk2(S[8 * s], S[8 * s + 1]); w.y = pk2(S[8 * s + 2], S[8 * s + 3]); w.z = pk2(S[8 * s + 4], S[8 * s + 5]); w.w = pk2(S[8 * s + 6], S[8 * s + 7]); pf[s] = __builtin_bit_cast(bf16x8, w); }
        LAS s16x4* vt = (LAS s16x4*)(lds + VIMG_OFF + lrow0 * VROW + trlane);
#define TRR(BYTES) __builtin_amdgcn_ds_read_tr16_b64_v4i16(vt + (BYTES) / 8)
        const bf16x8 v00 = __builtin_shufflevector(TRR(0), TRR(1152), 0, 1, 2, 3, 4, 5, 6, 7), v01 = __builtin_shufflevector(TRR(2304), TRR(3456), 0, 1, 2, 3, 4, 5, 6, 7);
        const bf16x8 v10 = __builtin_shufflevector(TRR(64), TRR(1216), 0, 1, 2, 3, 4, 5, 6, 7), v11 = __builtin_shufflevector(TRR(2368), TRR(3520), 0, 1, 2, 3, 4, 5, 6, 7);
#undef TRR
        O0 = MFMA32(v00, pf[0], O0); O0 = MFMA32(v01, pf[1], O0);
        O1 = MFMA32(v10, pf[0], O1); O1 = MFMA32(v11, pf[1], O1);
    }
    AttnOut AO = AO0; AO.sink = G.sink; AO.po = G.po; AO.lse = G.lse;
    const int tok = G.tokb + G.dil * (u0w + r);
    if (G.mode == 0) attn_finish<0>(O0, O1, m2, lsum, tok, G.ocol, G.hidx, kh, AO);
    else if (G.mode == 1) attn_finish<1>(O0, O1, m2, lsum, tok, G.ocol, G.hidx, kh, AO);
    else attn_finish<2>(O0, O1, m2, lsum, tok, G.ocol, G.hidx, kh, AO);
}

struct RgParams { const bf16_t* P; const int* pos; const float* conv_w; const float* conv_b; const bf16_t* wrT; const bf16_t* wiT; const float* b_r; const float* b_i; const float* lam; float* agg; bf16_t* mix; };

template <bool FINAL>
__device__ __forceinline__ void rglru_item(const RgParams& R, int sc, int h, int nt, int lane, LAS unsigned char* yimg) {
    const int r = lane & 31, kh = lane >> 5;
    const int tok_sc = sc * 128, bstart = (sc >> 7) * 128;
    const int ncol = 32 * nt + r, cg = 64 * h + ncol;
    const float br = R.b_r[cg], bi = R.b_i[cg], sp8l = -8.0f * 1.4426950408889634f * log1pf(expf(-R.lam[cg]));
    float carry = 0.f, atot = 1.f;
    if (FINAL) {
        const float* ag = R.agg + (size_t)cg * 2; int s = bstart;
        for (; s + 8 <= sc; s += 8) {
            f32x2 ab[8];
#pragma unroll
            for (int i = 0; i < 8; ++i) ab[i] = *(const f32x2*)(ag + (size_t)(s + i) * 768);
#pragma unroll
            for (int i = 0; i < 8; ++i) carry = ab[i].x * carry + ab[i].y;
        }
        for (; s < sc; ++s) { const f32x2 ab = *(const f32x2*)(ag + (size_t)s * 768); carry = ab.x * carry + ab.y; }
    }
    const int cc = 64 * h + lane;
    const float cw0 = R.conv_w[cc], cw1 = R.conv_w[384 + cc], cw2 = R.conv_w[768 + cc], cw3 = R.conv_w[1152 + cc], cb = R.conv_b[cc];
    unsigned short xr[32];
    const unsigned goff = (unsigned)(4 * kh * 64 + ncol);
    float xm1 = 0.f, xm2 = 0.f, xm3 = 0.f;
    { const bf16_t* xp = R.P + p_off(PC_XC / 64 + h, false, tok_sc);
      if ((tok_sc & (SEQ - 1)) != 0) { xm1 = bf2f((xp - 1 * 64)[lane]); xm2 = bf2f((xp - 2 * 64)[lane]); xm3 = bf2f((xp - 3 * 64)[lane]); }
#pragma unroll
      for (int t = 0; t < 32; ++t) xr[t] = (xp + (size_t)t * 64)[lane]; }
    for (int mt = 0; mt < 4; ++mt) {
        const int t0 = tok_sc + 32 * mt;
        bf16x8 yf[4];
        {
#pragma unroll
          for (int t = 0; t < 32; ++t) {
              const float x0 = bf2f(xr[t]);
              const float y = cb + cw0 * x0 + cw1 * xm1 + cw2 * xm2 + cw3 * xm3;
              *(LAS bf16_t*)(yimg + t * VROW + 2 * lane) = (bf16_t)(pk2(y, 0.f) & 0xffffu);
              xm3 = xm2; xm2 = xm1; xm1 = x0;
          }
          if (mt < 3) { const bf16_t* xp = R.P + p_off(PC_XC / 64 + h, false, t0 + 32);
#pragma unroll
              for (int t = 0; t < 32; ++t) xr[t] = (xp + (size_t)t * 64)[lane]; }
#pragma unroll
          for (int ks = 0; ks < 4; ++ks) yf[ks] = *(const LAS bf16x8*)(yimg + r * VROW + 32 * ks + 16 * kh);
        }
        unsigned short graw[16];
        if (FINAL) {
#pragma unroll
            for (int j = 0; j < 16; ++j) graw[j] = (R.P + p_off(PC_GC / 64 + h, false, t0 + (j & 3) + 8 * (j >> 2)))[goff];
        }
        unsigned rmask = 0u;
#pragma unroll
        for (int g = 0; g < 4; ++g) { const int4 p4 = *(const int4*)(R.pos + t0 + 8 * g + 4 * kh);
            rmask |= (p4.x == 0 ? 1u : 0u) << (4 * g); rmask |= (p4.y == 0 ? 1u : 0u) << (4 * g + 1); rmask |= (p4.z == 0 ? 1u : 0u) << (4 * g + 2); rmask |= (p4.w == 0 ? 1u : 0u) << (4 * g + 3); }
        f32x16 ra, ia, ya;
#pragma unroll
        for (int j = 0; j < 16; ++j) { ra[j] = 0.f; ia[j] = 0.f; ya[j] = 0.f; }
        int ncl = ncol; asm volatile("" : "+v"(ncl));
#pragma unroll
        for (int ks = 0; ks < 4; ++ks) {
            const size_t wo = ((size_t)h * 64 + ncl) * 64 + 16 * ks + 8 * kh;
            const bf16x8 wrf = *(const bf16x8*)(R.wrT + wo), wif = *(const bf16x8*)(R.wiT + wo);
            bf16x8 idf;
#pragma unroll
            for (int i = 0; i < 8; ++i) idf[i] = (16 * ks + 8 * kh + i == ncl) ? (short)0x3f80 : (short)0;
            ra = MFMA32(yf[ks], wrf, ra); ia = MFMA32(yf[ks], wif, ia); ya = MFMA32(yf[ks], idf, ya);
        }
        float av[16], bv[16];
#pragma unroll
        for (int j = 0; j < 16; ++j) {
            const float rr = sigmoidf_(ra[j] + br), ii = sigmoidf_(ia[j] + bi);
            const float a_ = fast_exp2(sp8l * rr);
            float a = a_, mult = __builtin_amdgcn_sqrtf(1.0f - a_ * a_);
            if ((rmask >> j) & 1u) { a = 0.f; mult = 1.f; }
            av[j] = a; bv[j] = mult * ii * ya[j];
        }
        float sa[4], sb[4], pa[4], pb[4];
#pragma unroll
        for (int g = 0; g < 4; ++g) {
            sa[g] = (av[4 * g] * av[4 * g + 1]) * (av[4 * g + 2] * av[4 * g + 3]);
            sb[g] = ((bv[4 * g] * av[4 * g + 1] + bv[4 * g + 1]) * av[4 * g + 2] + bv[4 * g + 2]) * av[4 * g + 3] + bv[4 * g + 3];
            pa[g] = __shfl_xor(sa[g], 32); pb[g] = __shfl_xor(sb[g], 32);
        }
        float c = carry, cin[4], apr = 1.f;
#pragma unroll
        for (int g = 0; g < 4; ++g) {
            const float a0 = kh ? pa[g] : sa[g], b0 = kh ? pb[g] : sb[g], a1 = kh ? sa[g] : pa[g], b1 = kh ? sb[g] : pb[g];
            const float ce = c; c = a0 * c + b0;
            const float co = c; c = a1 * c + b1;
            cin[g] = kh ? co : ce; apr *= a0 * a1;
        }
        carry = c; atot *= apr;
        if (FINAL) {
#pragma unroll
            for (int g = 0; g < 4; ++g) {
                float hp = cin[g];
#pragma unroll
                for (int e = 0; e < 4; ++e) {
                    const int j = 4 * g + e, tok = t0 + crow(j, kh);
                    hp = av[j] * hp + bv[j];
                    const float gt = bf2f(graw[j]);
                    const float z = 0.7978845608028654f * (gt + 0.044715f * gt * gt * gt);
                    const float th = 1.0f - 2.0f * fast_rcp(__expf(2.0f * z) + 1.0f);
                    const float o = hp * 0.5f * gt * (1.0f + th);
                    *(LAS bf16_t*)(yimg + 4608 + crow(j, kh) * 80 + 2 * r) = (bf16_t)(pk2(o, 0.f) & 0xffffu);
                    (void)tok;
                }
            }
#pragma unroll
            for (int q = 0; q < 2; ++q) {
                const int p = lane + 64 * q, tk = p >> 2, qu = p & 3;
                const u32x4 w = *(const LAS u32x4*)(yimg + 4608 + tk * 80 + 16 * qu);
                *(u32x4*)(R.mix + (size_t)(t0 + tk) * DM + 640 + 64 * h + 32 * nt + 8 * qu) = w;
            }
        }
    }
    if (!FINAL && kh == 0) { f32x2 ab = {atot, carry}; *(f32x2*)(R.agg + ((size_t)sc * 384 + cg) * 2) = ab; }
}

struct MapPlain { const float* w; int ld; __device__ __forceinline__ const float* operator()(int R) const { return w + R; } };
struct MapGU { const float* gate; const float* up; int ld;
    __device__ __forceinline__ const float* operator()(int R) const { const int j = 128 * (R >> 8) + (R & 127); const uintptr_t a = (uintptr_t)gate, b = (uintptr_t)up, sel = (uintptr_t)0 - (uintptr_t)((R >> 7) & 1); return (const float*)(a ^ ((a ^ b) & sel)) + j; } };
struct MapIN { const float* w; int ld;
    __device__ __forceinline__ const float* operator()(int R) const {
        int c = R;
        if (R < PC_VA || (R >= PC_QB && R < PC_VB)) { const int q = R & 63; c = (R & ~63) + 32 * ((q >> 2) & 1) + 16 * ((q >> 5) & 1) + 4 * ((q >> 3) & 3) + (q & 3); }
        if (c >= 1664 && c < PC_XC) return nullptr;
        if (c >= PC_XC) c -= 128;
        return w + c; } };

template <class Map>
__device__ __forceinline__ void transpose_item(const Map mp, int K, int N, bf16_t* WT, const float* gain, LAS float* scr, int item, int lane) {
    const int nblk = N / 32, kb = item / nblk, nb = item % nblk, k0 = 64 * kb, n0 = 32 * nb;
    const float* src = mp(n0 + (lane & 31));
    float v[32];
#pragma unroll
    for (int i = 0; i < 32; ++i) { const int kk = 2 * i + (lane >> 5); v[i] = src ? __builtin_nontemporal_load(src + (size_t)(k0 + kk) * mp.ld) : 0.f; }
#pragma unroll
    for (int i = 0; i < 32; ++i) { const int kk = 2 * i + (lane >> 5); float t = v[i]; if (gain) t *= gain[k0 + kk]; scr[kk * 33 + (lane & 31)] = t; }
    asm volatile("s_waitcnt lgkmcnt(0)" ::: "memory");
    const int c = lane & 7;
#pragma unroll
    for (int j = 0; j < 4; ++j) { const int n = (lane >> 3) + 8 * j; const LAS float* s = scr + (8 * c) * 33 + n;
        u32x4 o; o.x = pk2(s[0 * 33], s[1 * 33]); o.y = pk2(s[2 * 33], s[3 * 33]); o.z = pk2(s[4 * 33], s[5 * 33]); o.w = pk2(s[6 * 33], s[7 * 33]);
        *(u32x4*)(WT + (size_t)(n0 + n) * K + k0 + 8 * c) = o; }
    asm volatile("s_waitcnt lgkmcnt(0)" ::: "memory");
}

__device__ __forceinline__ float wave_sum(float v) {
#pragma unroll
    for (int o = 1; o < 64; o <<= 1) v += __shfl_xor(v, o);
    return v;
}

__device__ __forceinline__ void sincos_d(double a, float& c, float& s) {
    const double n = rint(a * 0.6366197723675814);
    double t = fma(-n, 1.5707963267948966, a); t = fma(-n, 6.123233995736766e-17, t);
    const double t2 = t * t;
    double sp = -1.0 / 1307674368000.0; sp = sp * t2 + 1.0 / 6227020800.0; sp = sp * t2 - 1.0 / 39916800.0; sp = sp * t2 + 1.0 / 362880.0; sp = sp * t2 - 1.0 / 5040.0; sp = sp * t2 + 1.0 / 120.0; sp = sp * t2 - 1.0 / 6.0; sp = sp * t2 + 1.0;
    const double sn = sp * t;
    double cp = 1.0 / 20922789888000.0; cp = cp * t2 - 1.0 / 87178291200.0; cp = cp * t2 + 1.0 / 479001600.0; cp = cp * t2 - 1.0 / 3628800.0; cp = cp * t2 + 1.0 / 40320.0; cp = cp * t2 - 1.0 / 720.0; cp = cp * t2 + 1.0 / 24.0; cp = cp * t2 - 0.5; cp = cp * t2 + 1.0;
    const int q = (int)((long long)n & 3);
    const double cc = (q == 0) ? cp : (q == 1) ? -sn : (q == 2) ? -cp : sn;
    const double ss = (q == 0) ? sn : (q == 1) ? cp : (q == 2) ? -sn : -cp;
    c = (float)cc; s = (float)ss;
}

typedef const __attribute__((address_space(4))) Args* KArgs;
__device__ __forceinline__ KArgs kargs() { KArgs p = (KArgs)__builtin_amdgcn_kernarg_segment_ptr(); asm volatile("" : "+s"(p)); return p; }
#define IN_F(k) ((const float*)ap->in[k])
__device__ __forceinline__ int fresh_tid(int wave0) { int t = wave0 * 64 + (int)__builtin_amdgcn_mbcnt_hi(~0u, __builtin_amdgcn_mbcnt_lo(~0u, 0u)); asm volatile("" : "+v"(t)); return t; }

__device__ __forceinline__ void touch_lines(const unsigned char* p, size_t bytes, int tid) {
    unsigned acc = 0u;
    for (size_t off = ((size_t)blockIdx.x * 512 + tid) * 128; off < bytes; off += (size_t)gridDim.x * 512 * 128) acc += *(const volatile unsigned*)(p + off);
    asm volatile("" :: "v"(acc));
}
template <int WHICH>
__device__ __forceinline__ void gemm_stage(LAS unsigned char* lds, int l, int ffn, int wave0) {
    KArgs ap = kargs();
    unsigned char* ws = ap->ws; const int G = gridDim.x;
    unsigned char* wl = ws + WS_W + (size_t)l * W_LAYER;
    bf16_t* XB = (bf16_t*)(ws + WS_XB); bf16_t* ACT = (bf16_t*)(ws + WS_ACT); float* ssq0 = (float*)(ws + WS_SSQ) + (size_t)(3 * l) * SSQ_SLOT;
    if (WHICH == 0) {
        pg8::Gemm g{XB, (const bf16_t*)(wl + (ffn ? WO_GU2 : WO_GU1)), MTOK, NGU, DM}; pg8::StaticOrder S; S.init(MTOK, NGU, G, (int)blockIdx.x);
        pg8::EpiGateUp E{ssq0 + (ffn ? 2 * SSQ_SLOT : 0), ACT, lds + 131072 + 256, (3 * l + (ffn ? 2 : 0)) * 256};
        pg8::gemm_phase<pg8::EpiGateUp, pg8::StaticOrder, true, true>(lds, g, S, E, fresh_tid(wave0));
        touch_lines(wl + (ffn ? WO_D2 : WO_D1), (size_t)DM * FF * 2, fresh_tid(wave0));
    } else if (WHICH == 1) {
        pg8::Gemm g{ACT, (const bf16_t*)(wl + (ffn ? WO_D2 : WO_D1)), MTOK, DM, FF}; pg8::StaticOrder S; S.init(MTOK, DM, G, (int)blockIdx.x);
        pg8::EpiResidual E{XB, ssq0 + (ffn ? 3 * SSQ_SLOT : SSQ_SLOT), 0.5f};
        pg8::gemm_phase<pg8::EpiResidual, pg8::StaticOrder, true, true>(lds, g, S, E, fresh_tid(wave0));
        if (ffn == 0) touch_lines(wl + WO_IN, (size_t)NIN * DM * 2, fresh_tid(wave0));
        else if (l + 1 < DEPTH) touch_lines(wl + W_LAYER + WO_GU1, (size_t)NGU * DM * 2, fresh_tid(wave0));
    } else if (WHICH == 2) {
        float* cosT = (float*)(ws + WS_ROPE);
        pg8::Gemm g{XB, (const bf16_t*)(wl + WO_IN), MTOK, NIN, DM}; pg8::StaticOrder S; S.init(MTOK, NIN, G, (int)blockIdx.x);
        pg8::EpiProj E{ssq0 + SSQ_SLOT, cosT, cosT + (size_t)MTOK * 32, ACT, lds + 131072 + 256, (3 * l + 1) * 256};
        pg8::gemm_phase<pg8::EpiProj, pg8::StaticOrder, true, true>(lds, g, S, E, fresh_tid(wave0));
    } else {
        pg8::Gemm g{(const bf16_t*)(ws + WS_MIX), (const bf16_t*)(wl + WO_OUT), MTOK, DM, DM}; pg8::StaticOrder S; S.init(MTOK, DM, G, (int)blockIdx.x);
        pg8::EpiResidual E{XB, ssq0 + 2 * SSQ_SLOT, 1.0f};
        pg8::gemm_phase<pg8::EpiResidual, pg8::StaticOrder, true, true>(lds, g, S, E, fresh_tid(wave0));
        touch_lines(wl + WO_GU2, (size_t)NGU * DM * 2, fresh_tid(wave0));
    }
}

__device__ __forceinline__ void prologue_stage(LAS unsigned char* lds, int wave0) {
    KArgs ap = kargs(); const int tid = fresh_tid(wave0), lane = tid & 63, wave = __builtin_amdgcn_readfirstlane(tid >> 6);
    unsigned char* ws = ap->ws; const int G = gridDim.x, gw = blockIdx.x * 8 + wave, NGW = G * 8;
    LAS float* scr = (LAS float*)(lds + wave * 16384);
    constexpr int I_GU = (DM / 64) * (NGU / 32), I_D = (FF / 64) * (DM / 32), I_IN = (DM / 64) * (NIN / 32), I_OUT = (DM / 64) * (DM / 32);
    constexpr int I_LAYER = 2 * I_GU + 2 * I_D + I_IN + I_OUT;
    for (int it = gw; it < DEPTH * I_LAYER; it += NGW) {
        const int l = it / I_LAYER; int r = it % I_LAYER;
        unsigned char* wl = ws + WS_W + (size_t)l * W_LAYER;
        if (r < I_GU) { MapGU mp{IN_F(3) + (size_t)l * DM * FF, IN_F(4) + (size_t)l * DM * FF, FF};
            transpose_item(mp, DM, NGU, (bf16_t*)(wl + WO_GU1), IN_F(2) + l * DM, scr, r, lane); continue; } r -= I_GU;
        if (r < I_D) { MapPlain mp{IN_F(5) + (size_t)l * FF * DM, DM};
            transpose_item(mp, FF, DM, (bf16_t*)(wl + WO_D1), nullptr, scr, r, lane); continue; } r -= I_D;
        if (r < I_IN) { MapIN mp{IN_F(7) + (size_t)l * DM * INC, INC};
            transpose_item(mp, DM, NIN, (bf16_t*)(wl + WO_IN), IN_F(6) + l * DM, scr, r, lane); continue; } r -= I_IN;
        if (r < I_OUT) { MapPlain mp{IN_F(16) + (size_t)l * DM * DM, DM};
            transpose_item(mp, DM, DM, (bf16_t*)(wl + WO_OUT), nullptr, scr, r, lane); continue; } r -= I_OUT;
        if (r < I_GU) { MapGU mp{IN_F(18) + (size_t)l * DM * FF, IN_F(19) + (size_t)l * DM * FF, FF};
            transpose_item(mp, DM, NGU, (bf16_t*)(wl + WO_GU2), IN_F(17) + l * DM, scr, r, lane); continue; } r -= I_GU;
        { MapPlain mp{IN_F(20) + (size_t)l * FF * DM, DM};
            transpose_item(mp, FF, DM, (bf16_t*)(wl + WO_D2), nullptr, scr, r, lane); }
    }
    const int gt = blockIdx.x * 512 + tid, NGT = G * 512;
    { const int* positions = (const int*)ap->in[1]; float* cosT = (float*)(ws + WS_ROPE); float* sinT = cosT + (size_t)MTOK * 32;
      for (int i = gt; i < MTOK * 32; i += NGT) {
          const int tok = i >> 5, k = i & 31;
          const float ang = (float)positions[tok] * INV_TAB[k];
          float c, s; sincos_d((double)ang, c, s);
          cosT[i] = c; sinT[i] = s;
      } }
    { float* SSQ = (float*)(ws + WS_SSQ);
      const float* x_in = IN_F(0); bf16_t* XB = (bf16_t*)(ws + WS_XB);
      for (int m = gw; m < MTOK; m += NGW) {
          const f32x4* xr = (const f32x4*)(x_in + (size_t)m * DM) + lane; float s = 0.f;
          unsigned long long* o8 = (unsigned long long*)(XB + (size_t)m * DM) + lane;
#pragma unroll
          for (int j = 0; j < 4; ++j) { const f32x4 v = __builtin_nontemporal_load(xr + 64 * j); s += (v.x * v.x + v.y * v.y) + (v.z * v.z + v.w * v.w);
              o8[64 * j] = (unsigned long long)pk2(v.x, v.y) | ((unsigned long long)pk2(v.z, v.w) << 32); }
          s = wave_sum(s);
          if (lane < 16) SSQ[(size_t)m * 16 + lane] = lane == 0 ? s : 0.f;
      } }
    { bf16_t* RGW = (bf16_t*)(ws + WS_RGW); const float* wr = IN_F(11); const float* wi = IN_F(13);
      for (int i = gt; i < DEPTH * 2 * 6 * 4096; i += NGT) {
          const int ii = i & 63, j = (i >> 6) & 63, h = (i >> 12) % 6, gl = i / (6 * 4096), g = gl & 1, l = gl >> 1;
          const size_t so = ((size_t)(l * 6 + h) * 64 + ii) * 64 + j;
          const float v = g ? wi[so] : wr[so];
          RGW[i] = (bf16_t)(pk2(v, 0.f) & 0xffffu);
      } }
}

template <int SUB>
__device__ __forceinline__ void mixer_rg(LAS unsigned char* lds, int l, int wave0) {
    KArgs ap = kargs(); const int tid = fresh_tid(wave0), lane = tid & 63, wave = __builtin_amdgcn_readfirstlane(tid >> 6);
    unsigned char* ws = ap->ws; const int gw = blockIdx.x * 8 + wave, NGW = gridDim.x * 8;
    bf16_t* RGW = (bf16_t*)(ws + WS_RGW);
    RgParams RP{(const bf16_t*)(ws + WS_ACT), (const int*)ap->in[1], IN_F(9) + (size_t)l * 4 * 384, IN_F(10) + l * 384,
                RGW + (size_t)(l * 2 + 0) * 6 * 4096, RGW + (size_t)(l * 2 + 1) * 6 * 4096,
                IN_F(12) + l * 384, IN_F(14) + l * 384, IN_F(15) + l * 384, (float*)(ws + WS_AGG), (bf16_t*)(ws + WS_MIX)};
    LAS unsigned char* yimg = lds + wave * 8192;
    constexpr int N_RG = 256 * 12;
    for (int it = gw; it < N_RG; it += NGW) rglru_item<SUB == 1>(RP, it / 12, (it % 12) >> 1, it & 1, lane, yimg);
}
template <int SUB>
__device__ __forceinline__ void mixer_attn(LAS unsigned char* lds, int l, int wave0) {
    KArgs ap = kargs(); const int tid = fresh_tid(wave0), lane = tid & 63, wave = __builtin_amdgcn_readfirstlane(tid >> 6);
    unsigned char* ws = ap->ws; const int G = gridDim.x;
    const bf16_t* PB = (const bf16_t*)(ws + WS_ACT);
    unsigned char* obp = (unsigned char*)ap->out;
    AttnOut AO{(bf16_t*)(ws + WS_MIX), nullptr, nullptr, (const bf16_t*)(obp + OB_PO4), (const bf16_t*)(obp + OB_PO16), (const float*)(obp + OB_LSE4), (const float*)(obp + OB_LSE16), 0.f};
    const float* sinks = IN_F(8) + l * 4;
    auto geom = [&](int j) -> AttnGeom {
        AttnGeom g; g.sink = 0.f; g.po = nullptr; g.lse = nullptr; g.ocol = 0;
        if (SUB == 0) {
            const int br = j / 768, rr = j % 768, dil = br ? 16 : 4, nblk = SEQ / dil / 256;
            const int qb = rr % nblk, rho = (rr / nblk) % dil, bh = rr / (nblk * dil), h = bh % 6, b = bh / 6;
            g.tokb = b * SEQ + rho; g.dil = dil; g.u0 = qb * 256; g.qcol = PC_QB + 64 * h; g.kcol = PC_KB + 64 * h; g.vcol = PC_VB + 64 * h; g.hidx = h; g.maxd = 128; g.mode = 1; g.perm = true;
            g.po = (bf16_t*)(obp + (br ? OB_PO16 : OB_PO4)); g.lse = (float*)(obp + (br ? OB_LSE16 : OB_LSE4));
        } else if (j < 512) {
            const int qb = j % 64, bhq = j / 64, hq = bhq % 4, b = bhq / 4, kv = hq >> 1;
            g.tokb = b * SEQ; g.dil = 1; g.u0 = qb * 256; g.qcol = PC_QA + 64 * hq; g.kcol = PC_KA + 64 * kv; g.vcol = PC_VA + 64 * kv; g.ocol = 64 * hq; g.hidx = hq; g.maxd = 127; g.mode = 0; g.perm = false;
            g.sink = sinks[hq];
        } else {
            const int rr = j - 512, qb = rr % 64, bh = rr / 64, h = bh % 6, b = bh / 6;
            g.tokb = b * SEQ; g.dil = 1; g.u0 = qb * 256; g.qcol = PC_QB + 64 * h; g.kcol = PC_KB + 64 * h; g.vcol = PC_VB + 64 * h; g.ocol = 256 + 64 * h; g.hidx = h; g.maxd = 128; g.mode = 2; g.perm = true;
        }
        return g;
    };
    constexpr int N_ATT = SUB == 0 ? 1536 : 1280;
    asm volatile("s_waitcnt lgkmcnt(0)" ::: "memory"); __builtin_amdgcn_s_barrier();
    int j = blockIdx.x; asm volatile("" : "+s"(j));
    if (j < N_ATT) {
        bf16x8 kv[12], qn[4];
        AttnGeom g = geom(j);
        kv_fetch(PB, g, tid, kv, qn, wave, lane);
        for (;;) {
            kv_store(lds, tid, kv);
            bf16x8 qf[4];
#pragma unroll
            for (int i = 0; i < 4; ++i) qf[i] = qn[i];
            asm volatile("s_waitcnt lgkmcnt(0)" ::: "memory"); __builtin_amdgcn_s_barrier(); asm volatile("" ::: "memory");
            const int jn = j + G; const bool more = jn < N_ATT;
            AttnGeom gn = g;
            if (more) { gn = geom(jn); kv_fetch(PB, gn, tid, kv, qn, wave, lane); }
            attn_wave(lds, g, qf, wave, lane, AO);
            asm volatile("" ::: "memory"); __builtin_amdgcn_s_barrier(); asm volatile("" ::: "memory");
            if (!more) break;
            g = gn; j = jn;
        }
    }
    if (SUB == 1) touch_lines(ws + WS_W + (size_t)l * W_LAYER + WO_OUT, (size_t)DM * DM * 2, tid);
}
template <int SUB>
__device__ __forceinline__ void mixer_stage(LAS unsigned char* lds, int l, int wave0) { mixer_rg<SUB>(lds, l, wave0); mixer_attn<SUB>(lds, l, wave0); }

#define XB_TMO      128
#define XB_XCNT(j)  (256  + 64 * (j))
#define XB_XSUB(j)  (1280 + 64 * (j))
#define XB_XGEN(j)  (2304 + 64 * (j))
#define XB_TOP      3328
#define XB_TOPGEN   3392
#define XCD_BAR_WORDS 3456
#define XB_SPIN_CAP (1u << 18)

__device__ __forceinline__ unsigned xb_ld(unsigned* p)              { return __hip_atomic_load(p, __ATOMIC_RELAXED, __HIP_MEMORY_SCOPE_AGENT); }
__device__ __forceinline__ unsigned xb_add(unsigned* p, unsigned v) { return __hip_atomic_fetch_add(p, v, __ATOMIC_RELAXED, __HIP_MEMORY_SCOPE_AGENT); }
__device__ __forceinline__ unsigned xb_xcc_id() { return (unsigned)__builtin_amdgcn_s_getreg((3 << 11) | 20) & 0xFu; }
#define XB_SPIN(cond, bar) do { unsigned _sp = 0; while (cond) {   \
    if ((++_sp & 255u) == 0u) { if (xb_ld(&(bar)[XB_TMO])) break; if (_sp > XB_SPIN_CAP) { atomicAdd(&(bar)[XB_TMO], 1u); break; } } } } while (0)

struct XcdBarrier {
    unsigned* bar; unsigned x; bool lead;
    volatile LAS unsigned* st;
};

__device__ __forceinline__ XcdBarrier xcd_barrier_post(unsigned* bar, volatile LAS unsigned* st, bool lead) {
    XcdBarrier b; b.bar = bar; b.x = xb_xcc_id(); b.st = st; b.lead = lead;
    if (lead) (void)xb_add(&bar[XB_XCNT(b.x)], 1u);
    return b;
}
__device__ __forceinline__ void xcd_barrier_complete(unsigned* bar, unsigned x, unsigned& nloc, unsigned& nx) {
    const unsigned G = gridDim.x * gridDim.y * gridDim.z;
    unsigned sum, cnt, mine, sp = 0u;
    for (;;) {
        sum = 0u; cnt = 0u; mine = 0u;
#pragma unroll
        for (unsigned j = 0; j < 16; ++j) { const unsigned c = xb_ld(&bar[XB_XCNT(j)]); sum += c; cnt += (c > 0u) ? 1u : 0u; mine = (j == x) ? c : mine; }
        if (sum == G) break;
        __builtin_amdgcn_s_sleep(1);
        if ((++sp & 255u) == 0u) { if (xb_ld(&bar[XB_TMO])) break; if (sp > XB_SPIN_CAP) { atomicAdd(&bar[XB_TMO], 1u); break; } }
    }
    nloc = mine > 0u ? mine : 1u; nx = cnt > 0u ? cnt : 1u;
}

__device__ __forceinline__ void xcd_barrier(const XcdBarrier& b) {
    asm volatile("s_waitcnt vmcnt(0)" ::: "memory");
    __syncthreads();
    if (b.lead) {
        unsigned* bar = b.bar;
        __builtin_amdgcn_s_waitcnt(0);
        unsigned nloc = b.st[0], nx = b.st[1];
        if (nloc == 0u) { xcd_barrier_complete(bar, b.x, nloc, nx); b.st[0] = nloc; b.st[1] = nx; }
        const unsigned old = xb_add(&bar[XB_XSUB(b.x)], 1u);
        const unsigned gen = old / nloc;
        if (old + 1u == (gen + 1u) * nloc) {
            __builtin_amdgcn_fence(__ATOMIC_RELEASE, "agent");
            asm volatile("s_waitcnt vmcnt(0)" ::: "memory");
            const unsigned og = xb_add(&bar[XB_TOP], 1u);
            const unsigned tg = og / nx;
            if (og + 1u == (tg + 1u) * nx) xb_add(&bar[XB_TOPGEN], 1u);
            else XB_SPIN(xb_ld(&bar[XB_TOPGEN]) == tg, bar);
            __builtin_amdgcn_fence(__ATOMIC_ACQUIRE, "agent");
            xb_add(&bar[XB_XGEN(b.x)], 1u);
            asm volatile("s_waitcnt vmcnt(0)" ::: "memory");
        } else {
            XB_SPIN(xb_ld(&bar[XB_XGEN(b.x)]) == gen, bar);
            __builtin_amdgcn_fence(__ATOMIC_ACQUIRE, "agent");
            asm volatile("s_waitcnt vmcnt(0)" ::: "memory");
        }
    }
    __syncthreads();
}

#define GRID_SYNC_CG() do { asm volatile("s_waitcnt vmcnt(0)" ::: "memory"); grid.sync(); __builtin_amdgcn_fence(__ATOMIC_ACQUIRE, "agent"); asm volatile("s_waitcnt vmcnt(0)" ::: "memory"); } while (0)
#define GRID_SYNC() do { XcdBarrier b_; b_.bar = (unsigned*)(kargs()->ws + WS_BAR); b_.x = xb_xcc_id(); b_.st = (volatile LAS unsigned*)(lds + 131072 + 64); b_.lead = fresh_tid(wave0) == 0; xcd_barrier(b_); } while (0)
__global__ void __launch_bounds__(512, 2) hymba_fwd(Args args) {
    extern __shared__ __attribute__((aligned(16))) unsigned char lds_raw[];
    cg::grid_group grid = cg::this_grid();
    LAS unsigned char* lds = (LAS unsigned char*)lds_raw;
    const int wave0 = __builtin_amdgcn_readfirstlane((int)threadIdx.x >> 6);
    volatile LAS unsigned* xst = (volatile LAS unsigned*)(lds + 131072 + 64);
    { const int t0_ = fresh_tid(wave0); if ((t0_ & 63) == 0) *(LAS int*)(lds + 131072 + 256 + (t0_ >> 6) * 1024) = -1;
      if (t0_ < 2) xst[t0_] = 0u; __syncthreads(); (void)xcd_barrier_post((unsigned*)(kargs()->ws + WS_BAR), xst, t0_ == 0); }
    prologue_stage(lds, wave0);
    if (kargs()->out == nullptr) GRID_SYNC_CG();
    GRID_SYNC();
    for (int l = 0; l < DEPTH; ++l) {
        gemm_stage<0>(lds, l, 0, wave0); GRID_SYNC();
        gemm_stage<1>(lds, l, 0, wave0); GRID_SYNC();
        gemm_stage<2>(lds, l, 0, wave0); GRID_SYNC();
        mixer_stage<0>(lds, l, wave0); GRID_SYNC();
        mixer_stage<1>(lds, l, wave0); GRID_SYNC();
        gemm_stage<3>(lds, l, 0, wave0); GRID_SYNC();
        gemm_stage<0>(lds, l, 1, wave0); GRID_SYNC();
        gemm_stage<1>(lds, l, 1, wave0); GRID_SYNC();
    }
    {
        KArgs ap = kargs(); const int tid = fresh_tid(wave0), lane = tid & 63, wave = __builtin_amdgcn_readfirstlane(tid >> 6);
        const int gw = blockIdx.x * 8 + wave, NGW = gridDim.x * 8;
        float* out = ap->out; const bf16_t* XB = (const bf16_t*)(ap->ws + WS_XB); const float* gfin = IN_F(21); const float* ssqF = (const float*)(ap->ws + WS_SSQ) + (size_t)12 * SSQ_SLOT;
        for (int m = gw; m < MTOK; m += NGW) {
            const float rstd = rsqrtf(ssq_row(ssqF, m) * (1.0f / DM) + EPS);
            const u32x2* xr = (const u32x2*)(XB + (size_t)m * DM) + lane; f32x4* orow = (f32x4*)(out + (size_t)m * DM) + lane; const f32x4* gr = (const f32x4*)gfin + lane;
#pragma unroll
            for (int j = 0; j < 4; ++j) { const u32x2 v = xr[64 * j]; const f32x4 g = gr[64 * j];
                f32x4 o; o[0] = bflo(v.x) * rstd * g[0]; o[1] = bfhi(v.x) * rstd * g[1]; o[2] = bflo(v.y) * rstd * g[2]; o[3] = bfhi(v.y) * rstd * g[3];
                __builtin_nontemporal_store(o, orow + 64 * j); }
        }
    }
}

extern "C" void kernel_launch(void* const* d_in, const int* in_sizes, int n_in, void* d_out, int out_size, void* d_ws, size_t ws_size, hipStream_t stream) {
    static int grid = 0;
    if (grid == 0) {
        if (n_in != 22 || out_size != MTOK * DM || ws_size < WS_END) { fprintf(stderr, "kernel_launch: unexpected shapes (n_in %d, out %d, ws %zu)\n", n_in, out_size, ws_size); grid = -1; return; }
        int dev = 0, cus = 0, per_cu = 0;
        (void)hipGetDevice(&dev); (void)hipDeviceGetAttribute(&cus, hipDeviceAttributeMultiprocessorCount, dev);
        if (hipFuncSetAttribute((const void*)hymba_fwd, hipFuncAttributeMaxDynamicSharedMemorySize, LDS_BYTES) != hipSuccess) { fprintf(stderr, "kernel_launch: hipFuncSetAttribute failed\n"); grid = -1; return; }
        if (hipOccupancyMaxActiveBlocksPerMultiprocessor(&per_cu, (const void*)hymba_fwd, 512, LDS_BYTES) != hipSuccess || per_cu < 1) { fprintf(stderr, "kernel_launch: occupancy query gave %d\n", per_cu); per_cu = 1; }
        (void)hipGetLastError();
        grid = cus * per_cu;
    }
    if (grid < 0) return;
    if (hipMemsetAsync((char*)d_ws + WS_BAR, 0, XCD_BAR_WORDS * 4, stream) != hipSuccess) { fprintf(stderr, "kernel_launch: hipMemsetAsync failed\n"); return; }
    Args a{};
    for (int i = 0; i < 22; ++i) a.in[i] = d_in[i];
    a.out = (float*)d_out; a.ws = (unsigned char*)d_ws;
    void* kargs[] = {&a};
    hipError_t e = hipLaunchCooperativeKernel((const void*)hymba_fwd, dim3(grid), dim3(512), kargs, LDS_BYTES, stream);
    if (e != hipSuccess) fprintf(stderr, "kernel_launch: cooperative launch failed: %s (grid %d)\n", hipGetErrorString(e), grid);
}
```
